# Optimizing an MI355X kernel written in HIP

```python
import jax, jax.numpy as jnp
from jax import lax
import numpy as np

D_MODEL = 4096
BATCH = 1
SEQ = 8192
DEPTH = 2

CHUNK = 64
N_MEM = 256
EPS = 1e-6

ML_HEADS = 4
ML_DV = D_MODEL // (2 * ML_HEADS)
ML_DQK = ML_DV // 2
GATE_CAP = 15.0
GLA_HEADS = 4
GLA_DV = D_MODEL // (2 * GLA_HEADS)
GLA_DK = GLA_DV // 2
GLA_RANK = 16
GLA_TAU = 16.0
ML_QK = ML_HEADS * ML_DQK
ML_V = ML_HEADS * ML_DV
GLA_QK = GLA_HEADS * GLA_DK
GLA_V = GLA_HEADS * GLA_DV
AB_IN_SIZES = (ML_QK, ML_QK, ML_V, ML_V, ML_HEADS, ML_HEADS,
               GLA_QK, GLA_QK, GLA_V, GLA_V, GLA_RANK)
AB_IN = 2 * ML_QK + 2 * ML_V + 2 * ML_HEADS + 2 * GLA_QK + 2 * GLA_V + GLA_RANK

SB_HEADS = 32
SB_DH = D_MODEL // SB_HEADS
SB_BLOCK = 128

XA_HEADS = 4
XA_DH = 256
XA_W = XA_HEADS * XA_DH

D_FF = 11008
CONV_W = 3

kernel_name = "hybrid_mlstm_gla_stickbreak_convffn"


def rmsnorm(x, g):
    xf = x.astype(jnp.float32)
    y = xf * lax.rsqrt(jnp.mean(xf * xf, axis=-1, keepdims=True) + EPS)
    return (y * g.astype(jnp.float32)).astype(x.dtype)


def softcap(x):
    return GATE_CAP * jnp.tanh(x / GATE_CAP)


def split_cols(t, sizes):
    outs, start = [], 0
    for n in sizes:
        outs.append(t[..., start:start + n])
        start += n
    return outs


def to_chunks(t, h, d):
    b, s, _ = t.shape
    return t.reshape(b, s // CHUNK, CHUNK, h, d).transpose(1, 0, 3, 2, 4)


def gates_to_chunks(t):
    b, s, h = t.shape
    return t.reshape(b, s // CHUNK, CHUNK, h).transpose(1, 0, 3, 2)


def from_chunks(t):
    nc, b, h, l, d = t.shape
    return t.transpose(1, 0, 3, 2, 4).reshape(b, nc * l, h, d)


def mlstm_chunkwise(q, k, v, i_pre, f_pre):
    f32 = jnp.float32
    q, v = q.astype(f32), v.astype(f32)
    k = k.astype(f32) * (q.shape[-1] ** -0.5)
    li = i_pre.astype(f32)
    lf = jax.nn.log_sigmoid(f_pre.astype(f32))
    _, b, h, l, dk = q.shape
    dv = v.shape[-1]
    causal = jnp.tril(jnp.ones((l, l), bool))

    def step(carry, inp):
        c, n, m = carry
        qc, kc, vc, lic, lfc = inp
        bcum = jnp.cumsum(lfc, axis=-1)
        log_d = bcum[..., :, None] - bcum[..., None, :] + lic[..., None, :]
        log_d = jnp.where(causal, log_d, -jnp.inf)
        log_inter = bcum + m[..., None]
        m_t = jnp.maximum(jnp.max(log_d, axis=-1), log_inter)
        d_mat = jnp.exp(log_d - m_t[..., None])
        inter = jnp.exp(log_inter - m_t)
        s_qk = jnp.einsum('bhtd,bhsd->bhts', qc, kc) * d_mat
        num = (jnp.einsum('bhts,bhsv->bhtv', s_qk, vc)
               + inter[..., None] * jnp.einsum('bhtd,bhdv->bhtv', qc, c))
        den = jnp.sum(s_qk, axis=-1) + inter * jnp.einsum('bhtd,bhd->bht', qc, n)
        hc = num / jnp.maximum(jnp.abs(den), jnp.exp(-m_t))[..., None]
        b_last = bcum[..., -1]
        log_w = b_last[..., None] - bcum + lic
        m_new = jnp.maximum(b_last + m, jnp.max(log_w, axis=-1))
        w = jnp.exp(log_w - m_new[..., None])
        decay = jnp.exp(b_last + m - m_new)
        c = decay[..., None, None] * c + jnp.einsum('bhs,bhsd,bhsv->bhdv', w, kc, vc)
        n = decay[..., None] * n + jnp.einsum('bhs,bhsd->bhd', w, kc)
        return (c, n, m_new), hc

    init = (jnp.zeros((b, h, dk, dv), f32), jnp.zeros((b, h, dk), f32),
            jnp.zeros((b, h), f32))
    _, hs = lax.scan(step, init, (q, k, v, li, lf))
    return hs


def gla_chunked(q, k, v, log_a):
    f32 = jnp.float32
    q = q.astype(f32) * (q.shape[-1] ** -0.5)
    k, v, log_a = k.astype(f32), v.astype(f32), log_a.astype(f32)
    _, b, h, l, dk = q.shape
    dv = v.shape[-1]
    causal = jnp.tril(jnp.ones((l, l), bool))[..., None]

    def step(s, inp):
        qc, kc, vc, lac = inp
        g = jnp.cumsum(lac, axis=-2)
        o_inter = jnp.einsum('bhtd,bhdv->bhtv', qc * jnp.exp(g), s)
        diff = jnp.where(causal, g[..., :, None, :] - g[..., None, :, :], -jnp.inf)
        a = jnp.einsum('bhtd,bhsd,bhtsd->bhts', qc, kc, jnp.exp(diff))
        o = o_inter + jnp.einsum('bhts,bhsv->bhtv', a, vc)
        g_last = g[..., -1, :]
        s = (jnp.exp(g_last)[..., None] * s
             + jnp.einsum('bhsd,bhsv->bhdv', kc * jnp.exp(g_last[..., None, :] - g), vc))
        return s, o

    _, os_ = lax.scan(step, jnp.zeros((b, h, dk, dv), f32), (q, k, v, log_a))
    return os_


def stick_breaking(q, k, v):
    b, s, h, dh = q.shape
    scale = dh ** -0.5
    outs = []
    for blk in range(s // SB_BLOCK):
        t0, t1 = blk * SB_BLOCK, (blk + 1) * SB_BLOCK
        z = jnp.einsum('bqhd,bkhd->bhqk', q[:, t0:t1], k[:, :t1]).astype(jnp.float32) * scale
        strict = jnp.arange(t1)[None, :] < jnp.arange(t0, t1)[:, None]
        log_beta = jax.nn.log_sigmoid(z)
        log_1m = jnp.where(strict, jax.nn.log_sigmoid(-z), 0.0)
        between = lax.cumsum(log_1m, axis=3, reverse=True) - log_1m
        att = jnp.exp(jnp.where(strict, log_beta + between, -jnp.inf))
        outs.append(jnp.einsum('bhqk,bkhd->bqhd', att.astype(v.dtype), v[:, :t1]))
    return jnp.concatenate(outs, axis=1)


def ab_mixer(xn, w_in, ml_i_bias, ml_f_bias, ml_head_norm, gla_w_gate, gla_gate_bias,
             gla_head_norm, w_out):
    b, s, _ = xn.shape
    mq, mk, mv, mo, mi, mf, gq, gk, gv, gg, gr = split_cols(xn @ w_in, AB_IN_SIZES)
    i_pre = softcap(mi + ml_i_bias)
    f_pre = softcap(mf + ml_f_bias)
    h_ml = mlstm_chunkwise(to_chunks(mq, ML_HEADS, ML_DQK), to_chunks(mk, ML_HEADS, ML_DQK),
                           to_chunks(mv, ML_HEADS, ML_DV), gates_to_chunks(i_pre),
                           gates_to_chunks(f_pre))
    h_ml = rmsnorm(from_chunks(h_ml).astype(xn.dtype), ml_head_norm)
    h_ml = h_ml * jax.nn.sigmoid(mo.reshape(b, s, ML_HEADS, ML_DV))
    log_a = jax.nn.log_sigmoid((gr @ gla_w_gate + gla_gate_bias).astype(jnp.float32)) / GLA_TAU
    h_gla = gla_chunked(to_chunks(gq, GLA_HEADS, GLA_DK), to_chunks(gk, GLA_HEADS, GLA_DK),
                        to_chunks(gv, GLA_HEADS, GLA_DV), to_chunks(log_a, GLA_HEADS, GLA_DK))
    h_gla = rmsnorm(from_chunks(h_gla).astype(xn.dtype), gla_head_norm)
    h_gla = h_gla * jax.nn.silu(gg.reshape(b, s, GLA_HEADS, GLA_DV))
    h = jnp.concatenate([h_ml.reshape(b, s, ML_V), h_gla.reshape(b, s, GLA_V)], axis=-1)
    return h @ w_out


def sb_mixer(xn, w_qkv, w_out):
    b, s, _ = xn.shape
    q, k, v = split_cols(xn @ w_qkv, (D_MODEL, D_MODEL, D_MODEL))
    o = stick_breaking(q.reshape(b, s, SB_HEADS, SB_DH), k.reshape(b, s, SB_HEADS, SB_DH),
                       v.reshape(b, s, SB_HEADS, SB_DH))
    return o.reshape(b, s, D_MODEL) @ w_out


def cross_attn(xn, memn, wq, wk, wv, wo):
    b, s, _ = xn.shape
    nm = memn.shape[1]
    q = (xn @ wq).reshape(b, s, XA_HEADS, XA_DH)
    k = (memn @ wk).reshape(b, nm, XA_HEADS, XA_DH)
    v = (memn @ wv).reshape(b, nm, XA_HEADS, XA_DH)
    scores = jnp.einsum('bqhd,bkhd->bhqk', q, k).astype(jnp.float32) * (XA_DH ** -0.5)
    p = jax.nn.softmax(scores, axis=-1).astype(v.dtype)
    o = jnp.einsum('bhqk,bkhd->bqhd', p, v).reshape(b, s, XA_W)
    return o @ wo


def conv_ffn(xn, w_gate, w_up, conv_w, conv_b, w_down):
    s = xn.shape[1]
    g = xn @ w_gate
    gp = jnp.pad(g, ((0, 0), (CONV_W - 1, 0), (0, 0)))
    conv = conv_b
    for j in range(CONV_W):
        conv = conv + gp[:, j:j + s] * conv_w[j]
    h = jax.nn.gelu(conv, approximate=True) * (xn @ w_up)
    return h @ w_down


def setup_inputs(seed: int = 0) -> dict:
    key = jax.random.key(seed)
    ks = iter(jax.random.split(key, 32))
    f32 = jnp.float32
    n_even = (DEPTH + 1) // 2
    n_odd = DEPTH // 2

    def nrm(shape, scale):
        return jax.random.normal(next(ks), shape, f32) * scale

    def gain(shape):
        return 1.0 + nrm(shape, 0.02)

    return {
        "x": nrm((BATCH, SEQ, D_MODEL), 1.0),
        "mem": nrm((BATCH, N_MEM, D_MODEL), 1.0),
        "mix_norm_pre": gain((DEPTH, D_MODEL)),
        "mix_norm_post": gain((DEPTH, D_MODEL)),
        "ab_w_in": nrm((n_even, D_MODEL, AB_IN), D_MODEL ** -0.5),
        "ml_i_bias": nrm((n_even, ML_HEADS), 0.1),
        "ml_f_bias": 3.0 + nrm((n_even, ML_HEADS), 0.5),
        "ml_head_norm": gain((n_even, ML_HEADS, ML_DV)),
        "gla_w_gate": nrm((n_even, GLA_RANK, GLA_QK), GLA_RANK ** -0.5),
        "gla_gate_bias": nrm((n_even, GLA_QK), 0.1),
        "gla_head_norm": gain((n_even, GLA_HEADS, GLA_DV)),
        "ab_w_out": nrm((n_even, D_MODEL, D_MODEL), D_MODEL ** -0.5),
        "sb_w_qkv": nrm((n_odd, D_MODEL, 3 * D_MODEL), D_MODEL ** -0.5),
        "sb_w_out": nrm((n_odd, D_MODEL, D_MODEL), D_MODEL ** -0.5),
        "xa_norm_pre": gain((DEPTH, D_MODEL)),
        "xa_norm_post": gain((DEPTH, D_MODEL)),
        "mem_norm": gain((DEPTH, D_MODEL)),
        "xa_wq": nrm((DEPTH, D_MODEL, XA_W), D_MODEL ** -0.5),
        "xa_wk": nrm((DEPTH, D_MODEL, XA_W), D_MODEL ** -0.5),
        "xa_wv": nrm((DEPTH, D_MODEL, XA_W), D_MODEL ** -0.5),
        "xa_wo": nrm((DEPTH, XA_W, D_MODEL), XA_W ** -0.5),
        "ffn_norm_pre": gain((DEPTH, D_MODEL)),
        "ffn_norm_post": gain((DEPTH, D_MODEL)),
        "ffn_w_gate": nrm((DEPTH, D_MODEL, D_FF), D_MODEL ** -0.5),
        "ffn_w_up": nrm((DEPTH, D_MODEL, D_FF), D_MODEL ** -0.5),
        "ffn_conv_w": nrm((DEPTH, CONV_W, D_FF), CONV_W ** -0.5),
        "ffn_conv_b": nrm((DEPTH, D_FF), 0.02),
        "ffn_w_down": nrm((DEPTH, D_FF, D_MODEL), D_FF ** -0.5),
    }


def reference(x, mem, mix_norm_pre, mix_norm_post, ab_w_in, ml_i_bias, ml_f_bias, ml_head_norm,
              gla_w_gate, gla_gate_bias, gla_head_norm, ab_w_out, sb_w_qkv, sb_w_out,
              xa_norm_pre, xa_norm_post, mem_norm, xa_wq, xa_wk, xa_wv, xa_wo,
              ffn_norm_pre, ffn_norm_post, ffn_w_gate, ffn_w_up, ffn_conv_w, ffn_conv_b,
              ffn_w_down):
    for layer in range(DEPTH):
        e = layer // 2
        h = rmsnorm(x, mix_norm_pre[layer])
        if layer % 2 == 0:
            h = ab_mixer(h, ab_w_in[e], ml_i_bias[e], ml_f_bias[e], ml_head_norm[e],
                         gla_w_gate[e], gla_gate_bias[e], gla_head_norm[e], ab_w_out[e])
        else:
            h = sb_mixer(h, sb_w_qkv[e], sb_w_out[e])
        x = x + rmsnorm(h, mix_norm_post[layer])
        h = cross_attn(rmsnorm(x, xa_norm_pre[layer]), rmsnorm(mem, mem_norm[layer]),
                       xa_wq[layer], xa_wk[layer], xa_wv[layer], xa_wo[layer])
        x = x + rmsnorm(h, xa_norm_post[layer])
        h = conv_ffn(rmsnorm(x, ffn_norm_pre[layer]), ffn_w_gate[layer], ffn_w_up[layer],
                     ffn_conv_w[layer], ffn_conv_b[layer], ffn_w_down[layer])
        x = x + rmsnorm(h, ffn_norm_post[layer])
    return x
```

```cpp
#include <hip/hip_runtime.h>
#include <cstdio>
#include <cstdint>
#define MK_SINGLE 1
namespace pg8 {
#define PG8_LAS __attribute__((address_space(3)))
typedef unsigned short bf16_t;
typedef short bf16x8 __attribute__((ext_vector_type(8)));
typedef float f32x4 __attribute__((ext_vector_type(4)));
typedef unsigned u32x4 __attribute__((ext_vector_type(4)));
constexpr int BM = 256, BK = 64, HALF = 128, HTB = HALF * BK * 2  , STAGE_BYTES = 8 * HTB, NXCD = 8, WGM = 8;

__host__ __device__ __forceinline__ int lds_byte(int r, int c) { const int st = (r >> 4) * 2 + (c >> 5), rr = r & 15, cc = c & 31, ob = rr * 64 + cc * 2; return st * 1024 + (ob ^ (((ob >> 9) & 1) << 5)); }
__host__ __device__ __forceinline__ void stage_rc(int b, int& R, int& C) { const int st = b / 1024, sb = b % 1024, swz = sb ^ (((sb >> 9) & 1) << 5); R = (st >> 1) * 16 + swz / 64; C = (st & 1) * 32 + (swz % 64) / 2; }
__host__ __device__ __forceinline__ int perm32(int rho) { const int n = rho >> 4, i = rho & 15; return 8 * (i >> 2) + 4 * n + (i & 3); }

struct Unit { int pm, pn; };
struct Gemm { const bf16_t* A; const bf16_t* Bt; int M, N, K, lda, ldb; };

struct StaticOrder {
    int nM, nN, nwg, G, c;
    __host__ __device__ void init(int M, int N, int G_, int c_) { nM = M / BM; nN = N / BM; nwg = nM * nN; G = G_; c = c_; }
    __host__ __device__ bool next(int i, Unit& u) const {
        const long L = (long)i * G + c; if (L >= nwg) return false;
        int wgid = (int)L; { const int q = nwg / NXCD, r = nwg % NXCD, xcd = wgid % NXCD, off = wgid / NXCD; wgid = (xcd < r ? xcd * (q + 1) : r * (q + 1) + (xcd - r) * q) + off; }
        const int nig = WGM * nN, gid = wgid / nig, fm = gid * WGM, gsz = (nM - fm) < WGM ? (nM - fm) : WGM;
        u.pm = fm + ((wgid % nig) % gsz); u.pn = (wgid % nig) / gsz; return true;
    }
    __device__ __forceinline__ void a_ready(const Unit&) const {}
    __device__ __forceinline__ void done(const Unit&) const {}
};

__device__ __forceinline__ unsigned cvt_pk_bf16(float lo, float hi) { unsigned r; asm volatile("v_cvt_pk_bf16_f32 %0, %1, %2" : "=v"(r) : "v"(lo), "v"(hi)); return r; }

struct EpiStore {
    static constexpr bool PERM = true, AFTER_DRAIN = false;
    bf16_t* O; int ldc; float* gates; int gate_pn;
    __device__ __forceinline__ void operator()(const f32x4 (&acc)[2][2][4][2], const Unit& u, int wr, int wc, int fr, int fq) const {
        const int row0 = u.pm * BM + wr * 64 + fr;
        if (u.pn == gate_pn) {
            if (wc == 0) {
#pragma unroll
                for (int ai = 0; ai < 2; ++ai)
#pragma unroll
                    for (int m = 0; m < 4; ++m) { float* gp = gates + (size_t)(row0 + ai * HALF + m * 16) * 32 + 8 * fq;
                        *(f32x4*)(gp) = acc[ai][0][m][0]; *(f32x4*)(gp + 4) = acc[ai][0][m][1]; }
            }
            return;
        }
        const int col0 = u.pn * BM + wc * 32 + 8 * fq;
#pragma unroll
        for (int ai = 0; ai < 2; ++ai)
#pragma unroll
            for (int m = 0; m < 4; ++m) { bf16_t* rowp = O + (size_t)(row0 + ai * HALF + m * 16) * ldc + col0;
#pragma unroll
                for (int bj = 0; bj < 2; ++bj) { const f32x4 v0 = acc[ai][bj][m][0], v1 = acc[ai][bj][m][1];
                    u32x4 w; w.x = cvt_pk_bf16(v0[0], v0[1]); w.y = cvt_pk_bf16(v0[2], v0[3]); w.z = cvt_pk_bf16(v1[0], v1[1]); w.w = cvt_pk_bf16(v1[2], v1[3]);
                    *(u32x4*)(rowp + bj * HALF) = w; } }
    }
};

__device__ __forceinline__ float gelu_tanh_f(float x) { const float y = -2.3022081983651455f * (x + 0.044715f * x * x * x); return x * __builtin_amdgcn_rcpf(1.f + __builtin_amdgcn_exp2f(y)); }
struct EpiConvGelu {
    static constexpr bool PERM = true, AFTER_DRAIN = false;
    bf16_t* H; int ldh; const float* cw; const float* cb; int ff; float* halo; PG8_LAS float* X;
    __device__ __forceinline__ void operator()(const f32x4 (&acc)[2][2][4][2], const Unit& u, int wr, int wc, int fr, int fq) const {
        const int cl = 32 * wc + 8 * fq;
        const int f0 = 128 * u.pn + cl;
        if (fr >= 14) {
#pragma unroll
            for (int ai = 0; ai < 2; ++ai) { PG8_LAS float* xp = X + ((2 * ai + wr) * 2 + (fr - 14)) * 128 + cl;
                *(PG8_LAS f32x4*)xp = acc[ai][0][3][0]; *(PG8_LAS f32x4*)(xp + 4) = acc[ai][0][3][1]; }
        }
        asm volatile("s_waitcnt lgkmcnt(0)" ::: "memory"); __builtin_amdgcn_s_barrier(); asm volatile("" ::: "memory");
        float w0[8], w1[8], w2[8], bb[8];
#pragma unroll
        for (int h = 0; h < 2; ++h) { const f32x4 a = *(const f32x4*)(cw + f0 + 4 * h), b = *(const f32x4*)(cw + ff + f0 + 4 * h), c = *(const f32x4*)(cw + 2 * ff + f0 + 4 * h), d = *(const f32x4*)(cb + f0 + 4 * h);
#pragma unroll
            for (int j = 0; j < 4; ++j) { w0[4 * h + j] = a[j]; w1[4 * h + j] = b[j]; w2[4 * h + j] = c[j]; bb[4 * h + j] = d[j]; } }
        float* hp = halo + (size_t)u.pm * 6 * ff + f0;
#pragma unroll
        for (int ai = 0; ai < 2; ++ai) {
            const int slab = 2 * ai + wr;
            unsigned l14[4], l15[4];
            if (slab > 0) { const PG8_LAS float* xp = X + ((slab - 1) * 2) * 128 + cl;
                const f32x4 a0 = *(const PG8_LAS f32x4*)xp, a1 = *(const PG8_LAS f32x4*)(xp + 4), b0 = *(const PG8_LAS f32x4*)(xp + 128), b1 = *(const PG8_LAS f32x4*)(xp + 132);
                l14[0] = cvt_pk_bf16(a0[0], a0[1]); l14[1] = cvt_pk_bf16(a0[2], a0[3]); l14[2] = cvt_pk_bf16(a1[0], a1[1]); l14[3] = cvt_pk_bf16(a1[2], a1[3]);
                l15[0] = cvt_pk_bf16(b0[0], b0[1]); l15[1] = cvt_pk_bf16(b0[2], b0[3]); l15[2] = cvt_pk_bf16(b1[0], b1[1]); l15[3] = cvt_pk_bf16(b1[2], b1[3]); }
            else { l14[0] = l14[1] = l14[2] = l14[3] = 0u; l15[0] = l15[1] = l15[2] = l15[3] = 0u; }
#pragma unroll
            for (int m = 0; m < 4; ++m) {
                const int row = u.pm * BM + ai * HALF + wr * 64 + m * 16 + fr;
                unsigned pk[4];
                pk[0] = cvt_pk_bf16(acc[ai][0][m][0][0], acc[ai][0][m][0][1]); pk[1] = cvt_pk_bf16(acc[ai][0][m][0][2], acc[ai][0][m][0][3]);
                pk[2] = cvt_pk_bf16(acc[ai][0][m][1][0], acc[ai][0][m][1][1]); pk[3] = cvt_pk_bf16(acc[ai][0][m][1][2], acc[ai][0][m][1][3]);
                float hv[8];
#pragma unroll
                for (int q = 0; q < 4; ++q) {
                    unsigned g1 = (unsigned)__shfl_up((int)pk[q], 1, 16), g2 = (unsigned)__shfl_up((int)pk[q], 2, 16);
                    if (fr == 0) { g1 = l15[q]; g2 = l14[q]; } else if (fr == 1) { g2 = l15[q]; }
                    const unsigned n14 = (unsigned)__shfl((int)pk[q], 14, 16), n15 = (unsigned)__shfl((int)pk[q], 15, 16);
                    l14[q] = n14; l15[q] = n15;
                    const int n = q >> 1, j = (q & 1) * 2, e = 2 * q;
                    const float x0 = bb[e] + w0[e] * __uint_as_float(g2 << 16) + w1[e] * __uint_as_float(g1 << 16) + w2[e] * acc[ai][0][m][n][j];
                    const float x1 = bb[e + 1] + w0[e + 1] * __uint_as_float(g2 & 0xffff0000u) + w1[e + 1] * __uint_as_float(g1 & 0xffff0000u) + w2[e + 1] * acc[ai][0][m][n][j + 1];
                    hv[e] = gelu_tanh_f(x0) * acc[ai][1][m][n][j]; hv[e + 1] = gelu_tanh_f(x1) * acc[ai][1][m][n][j + 1];
                }
                const bool first2 = (slab == 0 && m == 0 && fr < 2);
                if (!first2) { u32x4 w; w.x = cvt_pk_bf16(hv[0], hv[1]); w.y = cvt_pk_bf16(hv[2], hv[3]); w.z = cvt_pk_bf16(hv[4], hv[5]); w.w = cvt_pk_bf16(hv[6], hv[7]);
                    *(u32x4*)(H + (size_t)row * ldh + f0) = w; }
                else { float* p = hp + (size_t)fr * ff; *(f32x4*)p = acc[0][0][0][0]; *(f32x4*)(p + 4) = acc[0][0][0][1];
                    float* pu = hp + (size_t)(4 + fr) * ff; *(f32x4*)pu = acc[0][1][0][0]; *(f32x4*)(pu + 4) = acc[0][1][0][1]; }
                if (slab == 3 && m == 3 && fr >= 14) { float* p = hp + (size_t)(2 + fr - 14) * ff; *(f32x4*)p = acc[1][0][3][0]; *(f32x4*)(p + 4) = acc[1][0][3][1]; }
            }
        }
    }
};
template <class Epi, class Sched, bool ALIGN_EPI = false, bool SP2 = false>
__device__ __forceinline__ void gemm_phase(PG8_LAS unsigned char* lds, const Gemm g, const Sched& S, const Epi& E, const int wv  ) {
    int tid_o; asm volatile("v_mbcnt_lo_u32_b32 %0, -1, 0\n\tv_mbcnt_hi_u32_b32 %0, -1, %0" : "=v"(tid_o)); tid_o += wv * 64;
    const int tid = tid_o, wid = __builtin_amdgcn_readfirstlane(tid >> 6), lane = tid & 63, wr = wid >> 2, wc = wid & 3, fr = lane & 15, fq = lane >> 4;
    const int K = g.K, nt = K / BK;
    unsigned voffA[2], voffB[2];
#pragma unroll
    for (int i = 0; i < 2; ++i) { int R, C; stage_rc(tid * 16 + i * 8192, R, C); const int Rb = Epi::PERM ? ((R & ~31) + perm32(R & 31)) : R;
        voffA[i] = (unsigned)(R * g.lda + C) * 2u; voffB[i] = (unsigned)(Rb * g.ldb + C) * 2u; }
    const size_t kstep = (size_t)(BK * 2);
    const size_t hstepA = (size_t)HALF * g.lda * 2, hstepB = (size_t)HALF * g.ldb * 2;
    const size_t tstepA = 2 * hstepA, tstepB = 2 * hstepB;
    const unsigned ldsw = (unsigned)wid * 1024u;
    const int aoff = lds_byte(wr * 64 + fr, fq * 8), boff = lds_byte(wc * 32 + fr, fq * 8);
#define PG8_SA(b, h) (((b) * 2 + (h)) * HTB)
#define PG8_SB(b, h) ((4 + (b) * 2 + (h)) * HTB)
#define PG8_STAGE(bufoff, gbase, voff) do { _Pragma("unroll") for (int _i = 0; _i < 2; ++_i) \
        __builtin_amdgcn_global_load_lds((const unsigned*)((const char*)(gbase) + (voff)[_i]), (PG8_LAS unsigned*)(lds + (bufoff) + ldsw + _i * 8192), 16, 0, 0); } while (0)
#define PG8_LDA(dst, b, h) do { _Pragma("unroll") for (int m = 0; m < 4; ++m) _Pragma("unroll") for (int k = 0; k < 2; ++k) dst[m][k] = *(const PG8_LAS bf16x8*)(lds + PG8_SA(b, h) + aoff + m * 2048 + k * 1024); } while (0)
#define PG8_LDB(dst, b, h) do { _Pragma("unroll") for (int n = 0; n < 2; ++n) _Pragma("unroll") for (int k = 0; k < 2; ++k) dst[n][k] = *(const PG8_LAS bf16x8*)(lds + PG8_SB(b, h) + boff + n * 2048 + k * 1024); } while (0)
#define PG8_MMA(ai, bj, At, Bt) do { __builtin_amdgcn_s_setprio(1); _Pragma("unroll") for (int m = 0; m < 4; ++m) _Pragma("unroll") for (int n = 0; n < 2; ++n) _Pragma("unroll") for (int k = 0; k < 2; ++k) \
        acc[ai][bj][m][n] = __builtin_amdgcn_mfma_f32_16x16x32_bf16(Bt[n][k], At[m][k], acc[ai][bj][m][n], 0, 0, 0); __builtin_amdgcn_s_setprio(0); } while (0)
#define PG8_WAIT_V(n) asm volatile("s_waitcnt vmcnt(" #n ")" ::: "memory")
#define PG8_WAIT_L(n) asm volatile("s_waitcnt lgkmcnt(" #n ")" ::: "memory")
#define PG8_BAR __builtin_amdgcn_s_barrier()
#define PG8_SCHED __builtin_amdgcn_sched_barrier(0)
    Unit cur, nxt; int ui = 0;
    if (!S.next(0, cur)) return;
    f32x4 acc[2][2][4][2];
#pragma unroll
    for (int a = 0; a < 2; ++a)
#pragma unroll
        for (int b = 0; b < 2; ++b)
#pragma unroll
            for (int m = 0; m < 4; ++m)
#pragma unroll
                for (int n = 0; n < 2; ++n) acc[a][b][m][n] = (f32x4){0.f, 0.f, 0.f, 0.f};
    bf16x8 At[4][2], B0[2][2], B1[2][2];
    const char* cA = (const char*)g.A + (size_t)cur.pm * tstepA; const char* cB = (const char*)g.Bt + (size_t)cur.pn * tstepB;
    S.a_ready(cur);
    if constexpr (SP2) {
        PG8_STAGE(PG8_SB(0, 0), cB, voffB); PG8_STAGE(PG8_SB(0, 1), cB + hstepB, voffB); PG8_STAGE(PG8_SA(0, 0), cA, voffA); PG8_STAGE(PG8_SA(0, 1), cA + hstepA, voffA);
        if (wr == 1) PG8_BAR;
        PG8_WAIT_V(2); PG8_BAR;
        PG8_STAGE(PG8_SB(1, 0), cB + kstep, voffB); PG8_STAGE(PG8_SA(1, 0), cA + kstep, voffA); PG8_STAGE(PG8_SB(1, 1), cB + hstepB + kstep, voffB);
        PG8_WAIT_V(6); PG8_BAR;
    } else {
        PG8_STAGE(PG8_SB(0, 0), cB, voffB); PG8_STAGE(PG8_SA(0, 0), cA, voffA); PG8_STAGE(PG8_SB(0, 1), cB + hstepB, voffB); PG8_STAGE(PG8_SA(0, 1), cA + hstepA, voffA);
        if (wr == 1) PG8_BAR;
        PG8_WAIT_V(4); PG8_BAR;
        PG8_STAGE(PG8_SB(1, 0), cB + kstep, voffB); PG8_STAGE(PG8_SA(1, 0), cA + kstep, voffA); PG8_STAGE(PG8_SB(1, 1), cB + hstepB + kstep, voffB);
        PG8_WAIT_V(6); PG8_BAR;
    }
    for (;;) {
        const bool has_next = S.next(ui + 1, nxt);
        const char* nA = has_next ? (const char*)g.A + (size_t)nxt.pm * tstepA : cA; const char* nB = has_next ? (const char*)g.Bt + (size_t)nxt.pn * tstepB : cB;
        for (int t = 0; t < nt; t += 2) {
            const bool last = (t == nt - 2);
            const char* a1 = cA + (size_t)(t + 1) * kstep;
            const char* a2 = last ? nA : cA + (size_t)(t + 2) * kstep; const char* b2 = last ? nB : cB + (size_t)(t + 2) * kstep;
            const char* a3 = a2 + kstep; const char* b3 = b2 + kstep;
            if (last && has_next) S.a_ready(nxt);
            if constexpr (SP2) {
            PG8_LDB(B0, 0, 0); PG8_LDB(B1, 0, 1); PG8_SCHED; PG8_LDA(At, 0, 0); PG8_STAGE(PG8_SA(1, 1), a1 + hstepA, voffA);
            PG8_WAIT_V(8); PG8_WAIT_L(0); PG8_BAR; PG8_MMA(0, 0, At, B0); PG8_MMA(0, 1, At, B1); PG8_BAR; PG8_SCHED;
            PG8_LDA(At, 0, 1); PG8_STAGE(PG8_SB(0, 0), b2, voffB); PG8_STAGE(PG8_SB(0, 1), b2 + hstepB, voffB); PG8_STAGE(PG8_SA(0, 0), a2, voffA);
            PG8_WAIT_V(8); PG8_WAIT_L(0); PG8_BAR; PG8_MMA(1, 0, At, B0); PG8_MMA(1, 1, At, B1); PG8_BAR; PG8_SCHED;
            PG8_LDB(B0, 1, 0); PG8_LDB(B1, 1, 1); PG8_SCHED; PG8_LDA(At, 1, 0); PG8_STAGE(PG8_SA(0, 1), a2 + hstepA, voffA);
            PG8_WAIT_V(8); PG8_WAIT_L(0); PG8_BAR; PG8_MMA(0, 0, At, B0); PG8_MMA(0, 1, At, B1); PG8_BAR; PG8_SCHED;
            PG8_LDA(At, 1, 1); PG8_STAGE(PG8_SB(1, 0), b3, voffB); PG8_STAGE(PG8_SB(1, 1), b3 + hstepB, voffB); PG8_STAGE(PG8_SA(1, 0), a3, voffA);
            PG8_WAIT_V(8); PG8_WAIT_L(0); PG8_BAR; PG8_MMA(1, 0, At, B0); PG8_MMA(1, 1, At, B1); PG8_BAR; PG8_SCHED;
            } else {
            PG8_LDB(B0, 0, 0); PG8_SCHED; PG8_LDA(At, 0, 0); PG8_STAGE(PG8_SA(1, 1), a1 + hstepA, voffA);
            PG8_WAIT_L(8); PG8_BAR; PG8_WAIT_L(0); PG8_MMA(0, 0, At, B0); PG8_BAR; PG8_SCHED;
            PG8_LDB(B1, 0, 1); PG8_STAGE(PG8_SB(0, 0), b2, voffB);
            PG8_BAR; PG8_WAIT_L(0); PG8_MMA(0, 1, At, B1); PG8_BAR;
            PG8_LDA(At, 0, 1); PG8_STAGE(PG8_SA(0, 0), a2, voffA);
            PG8_BAR; PG8_WAIT_L(0); PG8_MMA(1, 0, At, B0); PG8_BAR; PG8_SCHED;
            PG8_STAGE(PG8_SB(0, 1), b2 + hstepB, voffB);
            PG8_WAIT_V(6); PG8_BAR; PG8_MMA(1, 1, At, B1); PG8_BAR;
            PG8_LDB(B0, 1, 0); PG8_SCHED; PG8_LDA(At, 1, 0); PG8_STAGE(PG8_SA(0, 1), a2 + hstepA, voffA);
            PG8_WAIT_L(8); PG8_BAR; PG8_WAIT_L(0); PG8_MMA(0, 0, At, B0); PG8_BAR; PG8_SCHED;
            PG8_LDB(B1, 1, 1); PG8_STAGE(PG8_SB(1, 0), b3, voffB);
            PG8_BAR; PG8_WAIT_L(0); PG8_MMA(0, 1, At, B1); PG8_BAR;
            PG8_LDA(At, 1, 1); PG8_STAGE(PG8_SA(1, 0), a3, voffA);
            PG8_BAR; PG8_WAIT_L(0); PG8_MMA(1, 0, At, B0); PG8_BAR; PG8_SCHED;
            PG8_STAGE(PG8_SB(1, 1), b3 + hstepB, voffB);
            PG8_WAIT_V(6); PG8_BAR; PG8_MMA(1, 1, At, B1); PG8_BAR;
            }
        }
        if constexpr (ALIGN_EPI) { if (wr == 0) PG8_BAR; }
        if constexpr (!Epi::AFTER_DRAIN) { E(acc, cur, wr, wc, fr, fq); S.done(cur); }
        if (!has_next) break;
#pragma unroll
        for (int a = 0; a < 2; ++a)
#pragma unroll
            for (int b = 0; b < 2; ++b)
#pragma unroll
                for (int m = 0; m < 4; ++m)
#pragma unroll
                    for (int n = 0; n < 2; ++n) acc[a][b][m][n] = (f32x4){0.f, 0.f, 0.f, 0.f};
        cur = nxt; cA = nA; cB = nB; ++ui;
        if constexpr (ALIGN_EPI) { if (wr == 1) PG8_BAR; }
    }
    PG8_WAIT_V(0);
    if constexpr (!ALIGN_EPI) { if (wr == 0) PG8_BAR; }
    PG8_BAR;
    if constexpr (Epi::AFTER_DRAIN) { E.fused(acc, cur, wr, wc, fr, fq, lds, wid, lane); S.done(cur); }
#undef PG8_SA
#undef PG8_SB
#undef PG8_STAGE
#undef PG8_LDA
#undef PG8_LDB
#undef PG8_MMA
#undef PG8_WAIT_V
#undef PG8_WAIT_L
#undef PG8_BAR
#undef PG8_SCHED
}
}

constexpr int SEQ = 8192, DM = 4096, NMEM = 256, FF = 11008, XAW = 1024, ABIN = 12312;
constexpr int NCH = 128;
constexpr float EPS = 1e-6f;
constexpr int NWAVES = 8, NTHREADS = 512;
#ifndef MK_SINGLE
#define MK_SINGLE 1
#endif
constexpr int N_STEPS = 27;

constexpr size_t MiB = 1u << 20;
constexpr size_t WS_CTL = 0, CTL_ZERO_BYTES = 1 * MiB;
constexpr size_t WS_GATES = 1 * MiB;
constexpr size_t WS_MLS = 2 * MiB;
constexpr size_t WS_RS = 2 * MiB + 768 * 1024;
constexpr size_t WS_NST = 3 * MiB;
constexpr size_t WS_MEMN = 4 * MiB;
constexpr size_t WS_KMEM = 8 * MiB;
constexpr size_t WS_VTMEM = 8 * MiB + 512 * 1024;
constexpr size_t WS_XQ = 16 * MiB;
constexpr size_t WS_XO = 32 * MiB;
constexpr size_t WS_XN = 48 * MiB;
constexpr size_t WS_HB = 112 * MiB;
constexpr size_t WS_HC = 176 * MiB;
constexpr size_t WS_GG = 240 * MiB;
constexpr size_t WS_BIG = 272 * MiB;
constexpr size_t WS_PROJ = WS_BIG;
constexpr size_t WS_VT = WS_BIG + 132 * MiB;
constexpr size_t WS_STATE = WS_BIG + 196 * MiB;
constexpr size_t WS_H = WS_BIG;
constexpr size_t WS_HALO = WS_GG;
constexpr size_t WS_W = 724 * MiB;
constexpr size_t LAYER_W = 420 * MiB;
constexpr size_t WO_MAIN = 0, WO_V = 66 * MiB, WO_OUT = 98 * MiB, WO_XQ = 130 * MiB, WO_XK = 138 * MiB, WO_XV = 146 * MiB, WO_XO = 154 * MiB, WO_GU = 162 * MiB, WO_DOWN = 334 * MiB;
constexpr size_t WS_END = WS_W + 2 * LAYER_W;
constexpr int CW_TMO = 0, CW_CODE = 1, CW_BAR = 4096;
constexpr int MLS_A = 0, MLS_PM = 4 * SEQ, MLS_BC = 8 * SEQ, MLS_CHB = 12 * SEQ, MLS_CHP = 12 * SEQ + 4 * NCH, MLS_MC = 12 * SEQ + 8 * NCH;

constexpr int SCR_BYTES = 143360;
constexpr int LDSCTL_OFF = SCR_BYTES, MISC_OFF = LDSCTL_OFF + 320;
constexpr int LDS_BYTES = 147456;

#define GAS __attribute__((address_space(1)))
#define LAS __attribute__((address_space(3)))
typedef unsigned short bf16;
typedef unsigned v4u __attribute__((ext_vector_type(4)));
typedef unsigned v2u __attribute__((ext_vector_type(2)));
typedef float f32x4 __attribute__((ext_vector_type(4)));
typedef short bf16x8 __attribute__((ext_vector_type(8)));
typedef short s16x4 __attribute__((ext_vector_type(4)));
typedef GAS unsigned gu32;
#define RLX_AGENT __ATOMIC_RELAXED, __HIP_MEMORY_SCOPE_AGENT
#define LDS_WAIT() asm volatile("s_waitcnt lgkmcnt(0)" ::: "memory")
#define VM_WAIT() asm volatile("s_waitcnt vmcnt(0)" ::: "memory")
__device__ __forceinline__ unsigned f2bf(float f) { unsigned u = __builtin_bit_cast(unsigned, f); return (u + 0x7fffu + ((u >> 16) & 1u)) >> 16; }
__device__ __forceinline__ unsigned pk2(float lo, float hi) { return f2bf(lo) | (f2bf(hi) << 16); }
__device__ __forceinline__ float bflo(unsigned w) { return __uint_as_float(w << 16); }
__device__ __forceinline__ float bfhi(unsigned w) { return __uint_as_float(w & 0xffff0000u); }
__device__ __forceinline__ f32x4 mma(bf16x8 a, bf16x8 b, f32x4 c) { return __builtin_amdgcn_mfma_f32_16x16x32_bf16(a, b, c, 0, 0, 0); }
__device__ __forceinline__ bf16x8 cat8(s16x4 lo, s16x4 hi) { return __builtin_shufflevector(lo, hi, 0, 1, 2, 3, 4, 5, 6, 7); }
__device__ __forceinline__ bf16x8 u4_as_frag(v4u w) { return __builtin_bit_cast(bf16x8, w); }
__device__ __forceinline__ float wave_sum(float v) {
#pragma unroll
    for (int o = 1; o < 64; o <<= 1) v += __shfl_xor(v, o);
    return v;
}
__device__ __forceinline__ float logsig_acc(float x) { return fminf(x, 0.f) - log1pf(expf(-fabsf(x))); }
__device__ __forceinline__ float logsig_fast(float x) { return fminf(x, 0.f) - __logf(1.f + __expf(-fabsf(x))); }
__device__ __forceinline__ float fexp2(float x) { return __builtin_amdgcn_exp2f(x); }
__device__ __forceinline__ float flog2(float x) { return __builtin_amdgcn_logf(x); }
__device__ __forceinline__ float frcp(float x) { return __builtin_amdgcn_rcpf(x); }
__device__ __forceinline__ float sigmoid_fast(float x) { return frcp(1.f + fexp2(-1.4426950408889634f * x)); }
__device__ __forceinline__ float xor16f(float x, int fq) { const unsigned u = __float_as_uint(x); const auto r = __builtin_amdgcn_permlane16_swap(u, u, false, false); return __uint_as_float((fq & 1) ? r[0] : r[1]); }
__device__ __forceinline__ float xor32f(float x, int fq) { const unsigned u = __float_as_uint(x); const auto r = __builtin_amdgcn_permlane32_swap(u, u, false, false); return __uint_as_float((fq & 2) ? r[0] : r[1]); }
__device__ __forceinline__ bf16x8 tr_frag(const LAS bf16* tile, int ld, int lane) {
    const int g = lane >> 4, li = lane & 15, q = li >> 2, p = li & 3;
    const LAS bf16* a = tile + (8 * g + q) * ld + 4 * p;
    const s16x4 lo = __builtin_amdgcn_ds_read_tr16_b64_v4i16((LAS s16x4*)a);
    const s16x4 hi = __builtin_amdgcn_ds_read_tr16_b64_v4i16((LAS s16x4*)(a + 4 * ld));
    return cat8(lo, hi);
}
struct Args { const float* in[28]; float* out; unsigned char* ws; int ph_lo, ph_hi; };
#define XB_TMO      128
#define XB_XCNT(j)  (256  + 64 * (j))
#define XB_XSUB(j)  (1280 + 64 * (j))
#define XB_XGEN(j)  (2304 + 64 * (j))
#define XB_TOP      3328
#define XB_TOPGEN   3392
#define XCD_BAR_WORDS 3456
#define XB_SPIN_CAP (1u << 18)

__device__ __forceinline__ unsigned xb_ld(unsigned* p)              { return __hip_atomic_load(p, __ATOMIC_RELAXED, __HIP_MEMORY_SCOPE_AGENT); }
__device__ __forceinline__ unsigned xb_add(unsigned* p, unsigned v) { return __hip_atomic_fetch_add(p, v, __ATOMIC_RELAXED, __HIP_MEMORY_SCOPE_AGENT); }
__device__ __forceinline__ unsigned xb_xcc_id() { return (unsigned)__builtin_amdgcn_s_getreg((3 << 11) | 20) & 0xFu; }
#define XB_SPIN(cond, bar) do { unsigned _sp = 0; while (cond) { __builtin_amdgcn_s_sleep(1); \
    if ((++_sp & 255u) == 0u) { if (xb_ld(&(bar)[XB_TMO])) break; if (_sp > XB_SPIN_CAP) { atomicAdd(&(bar)[XB_TMO], 1u); break; } } } } while (0)

struct XcdBarrier {
    unsigned* bar; unsigned x;
    volatile LAS unsigned* st;
};

__device__ __forceinline__ XcdBarrier xcd_barrier_post(unsigned* bar, volatile LAS unsigned* st) {
    XcdBarrier b; b.bar = bar; b.x = xb_xcc_id(); b.st = st;
    if (threadIdx.x == 0) (void)xb_add(&bar[XB_XCNT(b.x)], 1u);
    return b;
}
__device__ __forceinline__ void xcd_barrier_complete(unsigned* bar, unsigned x, unsigned& nloc, unsigned& nx) {
    const unsigned G = gridDim.x * gridDim.y * gridDim.z;
    unsigned sum, cnt, mine, sp = 0u;
    for (;;) {
        sum = 0u; cnt = 0u; mine = 0u;
#pragma unroll
        for (unsigned j = 0; j < 16; ++j) { const unsigned c = xb_ld(&bar[XB_XCNT(j)]); sum += c; cnt += (c > 0u) ? 1u : 0u; mine = (j == x) ? c : mine; }
        if (sum == G) break;
        __builtin_amdgcn_s_sleep(1);
        if ((++sp & 255u) == 0u) { if (xb_ld(&bar[XB_TMO])) break; if (sp > XB_SPIN_CAP) { atomicAdd(&bar[XB_TMO], 1u); break; } }
    }
    nloc = mine > 0u ? mine : 1u; nx = cnt > 0u ? cnt : 1u;
}

__device__ __forceinline__ void xcd_barrier(const XcdBarrier& b) {
    asm volatile("s_waitcnt vmcnt(0)" ::: "memory");
    __syncthreads();
    if (threadIdx.x == 0) {
        unsigned* bar = b.bar;
        __builtin_amdgcn_s_waitcnt(0);
        unsigned nloc = b.st[0], nx = b.st[1];
        if (nloc == 0u) { xcd_barrier_complete(bar, b.x, nloc, nx); b.st[0] = nloc; b.st[1] = nx; }
        const unsigned old = xb_add(&bar[XB_XSUB(b.x)], 1u);
        const unsigned gen = old / nloc;
        if (old + 1u == (gen + 1u) * nloc) {
            __builtin_amdgcn_fence(__ATOMIC_RELEASE, "agent");
            asm volatile("s_waitcnt vmcnt(0)" ::: "memory");
            const unsigned og = xb_add(&bar[XB_TOP], 1u);
            const unsigned tg = og / nx;
            if (og + 1u == (tg + 1u) * nx) xb_add(&bar[XB_TOPGEN], 1u);
            else XB_SPIN(xb_ld(&bar[XB_TOPGEN]) == tg, bar);
            __builtin_amdgcn_fence(__ATOMIC_ACQUIRE, "agent");
            xb_add(&bar[XB_XGEN(b.x)], 1u);
            asm volatile("s_waitcnt vmcnt(0)" ::: "memory");
        } else {
            XB_SPIN(xb_ld(&bar[XB_XGEN(b.x)]) == gen, bar);
            __builtin_amdgcn_fence(__ATOMIC_ACQUIRE, "agent");
            asm volatile("s_waitcnt vmcnt(0)" ::: "memory");
        }
    }
    __syncthreads();
}


__device__ __forceinline__ void tr_load(const float* src, int N, f32x4 (&v)[16], int lane) {
    const int r4 = lane >> 4, c4 = (lane & 15) * 4;
#pragma unroll
    for (int i = 0; i < 16; ++i) v[i] = *(const f32x4*)(src + (size_t)(4 * i + r4) * N + c4);
}
__device__ __forceinline__ void tr_to_lds(const f32x4 (&v)[16], LAS float* scr, int lane) {
    const int r4 = lane >> 4, c4 = (lane & 15) * 4;
#pragma unroll
    for (int i = 0; i < 16; ++i) { LAS float* s = scr + (4 * i + r4) * 65 + c4; s[0] = v[i].x; s[1] = v[i].y; s[2] = v[i].z; s[3] = v[i].w; }
    LDS_WAIT(); asm volatile("" ::: "memory");
}
__device__ __forceinline__ void tr_store(bf16* dst, int K, const LAS float* scr, int lane) {
    const int c = lane & 7;
#pragma unroll
    for (int j = 0; j < 8; ++j) { const int n = (lane >> 3) + 8 * j; const LAS float* s = scr + (8 * c) * 65 + n;
        v4u o; o.x = pk2(s[0], s[65]); o.y = pk2(s[130], s[195]); o.z = pk2(s[260], s[325]); o.w = pk2(s[390], s[455]);
        *(v4u*)(dst + (size_t)n * K + 8 * c) = o; }
    LDS_WAIT(); asm volatile("" ::: "memory");
}
struct Seg { int in_idx, src_l, N, K, scol, ncols, layer, wsub_mib, drow, ilv; };
__device__ __forceinline__ Seg seg_at(int i) {
    constexpr Seg segs[26] = {
        {4, 0, ABIN, DM, 0, 1024, 0, 0, 0, 0}, {4, 0, ABIN, DM, 1024, 1024, 0, 0, 1024, 0}, {4, 0, ABIN, DM, 4096, 2048, 0, 0, 2048, 0},
        {4, 0, ABIN, DM, 6152, 1024, 0, 0, 4096, 0}, {4, 0, ABIN, DM, 7176, 1024, 0, 0, 5120, 0}, {4, 0, ABIN, DM, 10248, 2048, 0, 0, 6144, 0},
        {4, 0, ABIN, DM, 2048, 2048, 0, 66, 0, 0}, {4, 0, ABIN, DM, 8200, 2048, 0, 66, 2048, 0},
        {11, 0, DM, DM, 0, DM, 0, 98, 0, 0},
        {17, 0, XAW, DM, 0, XAW, 0, 130, 0, 0}, {18, 0, XAW, DM, 0, XAW, 0, 138, 0, 0}, {19, 0, XAW, DM, 0, XAW, 0, 146, 0, 0}, {20, 0, DM, XAW, 0, DM, 0, 154, 0, 0},
        {23, 0, FF, DM, 0, FF, 0, 162, 0, 1}, {24, 0, FF, DM, 0, FF, 0, 162, 128, 1}, {27, 0, DM, FF, 0, DM, 0, 334, 0, 0},
        {12, 0, 3 * DM, DM, 0, 2 * DM, 1, 0, 0, 0}, {12, 0, 3 * DM, DM, 2 * DM, DM, 1, 66, 0, 0},
        {13, 0, DM, DM, 0, DM, 1, 98, 0, 0},
        {17, 1, XAW, DM, 0, XAW, 1, 130, 0, 0}, {18, 1, XAW, DM, 0, XAW, 1, 138, 0, 0}, {19, 1, XAW, DM, 0, XAW, 1, 146, 0, 0}, {20, 1, DM, XAW, 0, DM, 1, 154, 0, 0},
        {23, 1, FF, DM, 0, FF, 1, 162, 0, 1}, {24, 1, FF, DM, 0, FF, 1, 162, 128, 1}, {27, 1, DM, FF, 0, DM, 1, 334, 0, 0}};
    return segs[i];
}
__device__ __forceinline__ void convert_segments(const Args& args, unsigned char* ws, LAS unsigned char* lds, int seg_lo, int seg_hi, int part_lo, int part_hi, int nparts, int wid, int nw, int wave, int lane) {
    LAS float* scr = (LAS float*)(lds + wave * 16640);
#pragma unroll 1
    for (int sI = seg_lo; sI < seg_hi; ++sI) {
        const Seg sg = seg_at(sI);
        const int nblk = sg.ncols / 64, nit = (sg.K / 64) * nblk;
        const float* W = args.in[sg.in_idx] + (size_t)sg.src_l * sg.K * sg.N;
        bf16* WT = (bf16*)(ws + WS_W + (size_t)sg.layer * LAYER_W + (size_t)sg.wsub_mib * MiB);
        const int it_lo = (int)((long)nit * part_lo / nparts), it_hi = (int)((long)nit * part_hi / nparts);
        int it = it_lo + wid;
        f32x4 v[16];
        if (it < it_hi) { const int kb = it / nblk, nb = it - kb * nblk; tr_load(W + (size_t)(64 * kb) * sg.N + sg.scol + 64 * nb, sg.N, v, lane); }
#pragma unroll 1
        for (; it < it_hi; it += nw) {
            const int kb = it / nblk, nb = it - kb * nblk;
            const int drow = sg.ilv ? (256 * (nb >> 1) + 64 * (nb & 1) + sg.drow) : (sg.drow + 64 * nb);
            tr_to_lds(v, scr, lane);
            const int itn = it + nw;
            if (itn < it_hi) { const int kbn = itn / nblk, nbn = itn - kbn * nblk; tr_load(W + (size_t)(64 * kbn) * sg.N + sg.scol + 64 * nbn, sg.N, v, lane); }
            tr_store(WT + (size_t)drow * sg.K + 64 * kb, sg.K, scr, lane);
        }
    }
}
constexpr int SEG_SB = 18, SEG_DEFER = 23, SEG_END = 26, XA_BUSY_WGS = 136, GU_BUSY_WGS = 192;
__device__ __forceinline__ void p0_prologue(const Args& args, unsigned char* ws, LAS unsigned char* lds, int gw, int NGW, int wave, int lane, bool defer) {
    convert_segments(args, ws, lds, 0, defer ? SEG_SB : SEG_END, 0, 1, 1, gw, NGW, wave, lane);
    {
        const float* W = args.in[4]; bf16* WT = (bf16*)(ws + WS_W + WO_MAIN) + (size_t)8192 * DM;
        for (int idx = gw * 64 + lane; idx < 256 * DM; idx += NGW * 64) {
            const int i = idx >> 12, k = idx & (DM - 1);
            float v = 0.f;
            if (i < 24) { const int col = i < 4 ? 6144 + i : (i < 8 ? 6148 + (i - 4) : 12296 + (i - 8)); v = W[(size_t)k * ABIN + col]; }
            WT[idx] = (bf16)f2bf(v);
        }
    }
    for (int r = gw; r < 2 * NMEM; r += NGW) {
        const int l = r >> 8, row = r & 255;
        const float* xr = args.in[1] + (size_t)row * DM; const float* g = args.in[16] + (size_t)l * DM;
        bf16* o = (bf16*)(ws + WS_MEMN) + (size_t)r * DM;
        f32x4 v[16]; float ss = 0.f;
#pragma unroll
        for (int j = 0; j < 16; ++j) { v[j] = *(const f32x4*)(xr + 4 * lane + 256 * j); ss += v[j].x * v[j].x + v[j].y * v[j].y + v[j].z * v[j].z + v[j].w * v[j].w; }
        const float rstd = rsqrtf(wave_sum(ss) * (1.f / DM) + EPS);
#pragma unroll
        for (int j = 0; j < 16; ++j) { const f32x4 gg = *(const f32x4*)(g + 4 * lane + 256 * j);
            v2u w; w.x = pk2(v[j].x * rstd * gg.x, v[j].y * rstd * gg.y); w.y = pk2(v[j].z * rstd * gg.z, v[j].w * rstd * gg.w);
            *(v2u*)(o + 4 * lane + 256 * j) = w; }
    }
}

#define LAUNDER8(a, o) asm volatile("" : "+v"(a[o].x), "+v"(a[o].y), "+v"(a[o+1].x), "+v"(a[o+1].y), "+v"(a[o+2].x), "+v"(a[o+2].y), "+v"(a[o+3].x), "+v"(a[o+3].y), \
    "+v"(a[o+4].x), "+v"(a[o+4].y), "+v"(a[o+5].x), "+v"(a[o+5].y), "+v"(a[o+6].x), "+v"(a[o+6].y), "+v"(a[o+7].x), "+v"(a[o+7].y))
#define LAUNDER_ROW(pw, hw) do { LAUNDER8(pw, 0); LAUNDER8(pw, 8); LAUNDER8(hw, 0); LAUNDER8(hw, 8); } while (0)
template <int MODE>
__device__ __forceinline__ void norm_rows(const float* xin, const bf16* hb, const float* gprev, const float* gpost, const float* gpre, float* xout, bf16* xn, float* rs,
                                          LAS unsigned char* lds, int gw, int NGW, int tid, int lane) {
    LAS float* GP = (LAS float*)lds; LAS float* GN = (LAS float*)(lds + 16384); LAS float* GI = (LAS float*)(lds + 32768);
    __syncthreads();
#pragma unroll
    for (int i = 0; i < 2; ++i) { const int o = 4 * (tid + NTHREADS * i);
        if (MODE != 0) { *(LAS f32x4*)(GP + o) = *(const f32x4*)(gpost + o); const f32x4 g = *(const f32x4*)(gprev + o); *(LAS f32x4*)(GI + o) = (f32x4){1.f / g.x, 1.f / g.y, 1.f / g.z, 1.f / g.w}; }
        if (MODE != 2) *(LAS f32x4*)(GN + o) = *(const f32x4*)(gpre + o); }
    __syncthreads();
    const int lo4 = 4 * lane;
#pragma unroll 1
    for (int row = gw; row < SEQ; row += NGW) {
        asm volatile("" ::: "memory");
        if (MODE == 0) {
            const float* xr = xin + (size_t)row * DM; bf16* nw = xn + (size_t)row * DM;
            f32x4 xv[16]; float ss = 0.f;
#pragma unroll
            for (int j = 0; j < 16; ++j) { xv[j] = *(const f32x4*)(xr + lo4 + 256 * j); ss += xv[j].x * xv[j].x + xv[j].y * xv[j].y + xv[j].z * xv[j].z + xv[j].w * xv[j].w; }
            const float rstd = rsqrtf(wave_sum(ss) * (1.f / DM) + EPS);
            if (lane == 0) rs[row] = rstd;
            asm volatile("" ::: "memory");
#pragma unroll
            for (int j = 0; j < 16; ++j) { const f32x4 g = *(const LAS f32x4*)(GN + lo4 + 256 * j);
                v2u w; w.x = pk2(xv[j].x * rstd * g.x, xv[j].y * rstd * g.y); w.y = pk2(xv[j].z * rstd * g.z, xv[j].w * rstd * g.w);
                *(v2u*)(nw + lo4 + 256 * j) = w; }
        } else {
            bf16* pr = xn + (size_t)row * DM; const bf16* hr = hb + (size_t)row * DM;
            v2u pw[16], hw[16]; float ss = 0.f;
#pragma unroll
            for (int j = 0; j < 16; ++j) { pw[j] = *(const v2u*)(pr + lo4 + 256 * j); hw[j] = *(const v2u*)(hr + lo4 + 256 * j); }
            const float ri = 1.f / rs[row];
#pragma unroll
            for (int j = 0; j < 16; ++j) { const float a = bflo(hw[j].x), b = bfhi(hw[j].x), c = bflo(hw[j].y), d = bfhi(hw[j].y); ss += a * a + b * b + c * c + d * d; }
            const float rstd = rsqrtf(wave_sum(ss) * (1.f / DM) + EPS);
            asm volatile("" ::: "memory");
            LAUNDER_ROW(pw, hw);
            float ss2 = 0.f;
#pragma unroll
            for (int j = 0; j < 16; ++j) { const f32x4 g = *(const LAS f32x4*)(GP + lo4 + 256 * j), gi = *(const LAS f32x4*)(GI + lo4 + 256 * j);
                f32x4 x;
                x.x = bflo(pw[j].x) * ri * gi.x + bflo(hw[j].x) * rstd * g.x; x.y = bfhi(pw[j].x) * ri * gi.y + bfhi(hw[j].x) * rstd * g.y;
                x.z = bflo(pw[j].y) * ri * gi.z + bflo(hw[j].y) * rstd * g.z; x.w = bfhi(pw[j].y) * ri * gi.w + bfhi(hw[j].y) * rstd * g.w;
                if (MODE == 2) *(f32x4*)(xout + (size_t)row * DM + lo4 + 256 * j) = x;
                else ss2 += x.x * x.x + x.y * x.y + x.z * x.z + x.w * x.w;
                if (j & 1) __builtin_amdgcn_sched_barrier(0); }
            if (MODE == 1) {
                const float rstd2 = rsqrtf(wave_sum(ss2) * (1.f / DM) + EPS);
                if (lane == 0) rs[row] = rstd2;
                LAUNDER_ROW(pw, hw);
                float ri2 = ri, rstdb = rstd; asm volatile("" : "+v"(ri2), "+v"(rstdb) :: "memory");
#pragma unroll
                for (int j = 0; j < 16; ++j) { const f32x4 g = *(const LAS f32x4*)(GP + lo4 + 256 * j), gi = *(const LAS f32x4*)(GI + lo4 + 256 * j), gn = *(const LAS f32x4*)(GN + lo4 + 256 * j);
                    f32x4 x;
                    x.x = bflo(pw[j].x) * ri2 * gi.x + bflo(hw[j].x) * rstdb * g.x; x.y = bfhi(pw[j].x) * ri2 * gi.y + bfhi(hw[j].x) * rstdb * g.y;
                    x.z = bflo(pw[j].y) * ri2 * gi.z + bflo(hw[j].y) * rstdb * g.z; x.w = bfhi(pw[j].y) * ri2 * gi.w + bfhi(hw[j].y) * rstdb * g.w;
                    v2u w; w.x = pk2(x.x * rstd2 * gn.x, x.y * rstd2 * gn.y); w.y = pk2(x.z * rstd2 * gn.z, x.w * rstd2 * gn.w);
                    *(v2u*)(pr + lo4 + 256 * j) = w;
                    if (j & 1) __builtin_amdgcn_sched_barrier(0); }
            }
        }
    }
}

__device__ __forceinline__ void gates_minigemm(unsigned char* ws, LAS unsigned char* lds, int bx, int G, int tid, int wave, int lane) {
    const bf16* XNp = (const bf16*)(ws + WS_XN); const bf16* WG = (const bf16*)(ws + WS_W + WO_MAIN) + (size_t)8192 * DM; float* GT = (float*)(ws + WS_GATES);
    LAS f32x4* RED = (LAS f32x4*)lds;
#pragma unroll 1
    for (int blk = bx; blk < SEQ / 32; blk += G) {
        asm volatile("" : "+v"(lane));
        const int fr = lane & 15, fq = lane >> 4;
        const int t0 = 32 * blk;
        f32x4 acc[2][2];
#pragma unroll
        for (int a = 0; a < 2; ++a)
#pragma unroll
            for (int b = 0; b < 2; ++b) acc[a][b] = (f32x4){0.f, 0.f, 0.f, 0.f};
        const int lo = fr * DM + 8 * fq;
        const bf16* ap = (XNp + (size_t)t0 * DM + wave * 512) + lo; const bf16* bp = (WG + wave * 512) + lo;
#pragma unroll 4
        for (int ks = 0; ks < 16; ++ks) {
            const bf16x8 a0 = *(const bf16x8*)(ap + 32 * ks), a1 = *(const bf16x8*)(ap + (size_t)16 * DM + 32 * ks);
            const bf16x8 b0 = *(const bf16x8*)(bp + 32 * ks), b1 = *(const bf16x8*)(bp + (size_t)16 * DM + 32 * ks);
            acc[0][0] = mma(b0, a0, acc[0][0]); acc[0][1] = mma(b1, a0, acc[0][1]); acc[1][0] = mma(b0, a1, acc[1][0]); acc[1][1] = mma(b1, a1, acc[1][1]);
        }
        __syncthreads();
#pragma unroll
        for (int a = 0; a < 2; ++a)
#pragma unroll
            for (int b = 0; b < 2; ++b) RED[(wave * 4 + a * 2 + b) * 64 + lane] = acc[a][b];
        __syncthreads();
        if (tid < 256) { const int tile = tid >> 6, l = tid & 63, rt = tile >> 1, ct = tile & 1; f32x4 s = {0.f, 0.f, 0.f, 0.f};
#pragma unroll
            for (int w = 0; w < 8; ++w) s = s + RED[(w * 4 + tile) * 64 + l];
            *(f32x4*)(GT + (size_t)(t0 + 16 * rt + (l & 15)) * 32 + 16 * ct + 4 * (l >> 4)) = s; }
    }
}

__device__ __forceinline__ float scan_sum(float x, int lane) {
#pragma unroll
    for (int o = 1; o < 64; o <<= 1) { const float y = __shfl_up(x, o); if (lane >= o) x += y; }
    return x;
}
__device__ __forceinline__ float scan_max(float x, int lane) {
#pragma unroll
    for (int o = 1; o < 64; o <<= 1) { const float y = __shfl_up(x, o); if (lane >= o) x = fmaxf(x, y); }
    return x;
}
__device__ __forceinline__ void mlstm_local(const float* gates, float* mls, float bi, float bfb, int h, int c, int lane, LAS float* stash) {
    const int t = c * 64 + lane;
    const float mi = gates[(size_t)t * 32 + h], mf = gates[(size_t)t * 32 + 4 + h];
    const float li = 15.f * tanhf((mi + bi) * (1.f / 15.f)), fp = 15.f * tanhf((mf + bfb) * (1.f / 15.f));
    const float lf = logsig_acc(fp);
    const float bcum = scan_sum(lf, lane);
    const float a = li - bcum;
    const float pm = scan_max(a, lane);
    mls[MLS_A + h * SEQ + t] = a; mls[MLS_PM + h * SEQ + t] = pm; mls[MLS_BC + h * SEQ + t] = bcum;
    if (lane == 63) { mls[MLS_CHB + h * NCH + c] = bcum; mls[MLS_CHP + h * NCH + c] = pm; stash[64] = pm; stash[65] = bcum; }
    stash[lane] = a;
}

constexpr int TL = 264;
constexpr int NPAIR = 64;
__device__ __forceinline__ void gla_g_chunk(const Args& args, const float* gates, float* G, LAS float* GS, LAS float* GRS, int c, int head, int tid) {
    if (tid < 256) { const int t = tid >> 2, r4 = (tid & 3) * 4; *(LAS f32x4*)(GRS + t * 16 + r4) = *(const f32x4*)(gates + (size_t)(c * 64 + t) * 32 + 8 + r4); }
    __syncthreads();
    const int d = tid & 255, half = tid >> 8, col = head * 256 + d;
    float w[16];
#pragma unroll
    for (int r = 0; r < 16; ++r) w[r] = args.in[8][r * 1024 + col];
    const float b = args.in[9][col];
    float acc = 0.f;
#pragma unroll 4
    for (int tt = 0; tt < 32; ++tt) { const int t = 32 * half + tt;
        float z = b;
#pragma unroll
        for (int q4 = 0; q4 < 4; ++q4) { const f32x4 g4 = *(const LAS f32x4*)(GRS + t * 16 + 4 * q4); z += g4.x * w[4 * q4] + g4.y * w[4 * q4 + 1] + g4.z * w[4 * q4 + 2] + g4.w * w[4 * q4 + 3]; }
        acc += (fminf(z, 0.f) - 0.6931471805599453f * flog2(1.f + fexp2(-1.4426950408889634f * fabsf(z)))) * 0.0625f;
        GS[t * 256 + d] = acc; }
    __syncthreads();
    const float add = half ? GS[31 * 256 + d] : 0.f;
#pragma unroll 4
    for (int tt = 0; tt < 32; ++tt) { const int t = 32 * half + tt; const float gv = GS[t * 256 + d] + add;
        if (half) GS[t * 256 + d] = gv;
        G[(size_t)(c * 64 + t) * 1024 + col] = gv; }
    __syncthreads();
}
__device__ __forceinline__ void dc_unit(const Args& args, unsigned char* ws, LAS unsigned char* lds, int u, int tid, int wave, int lane) {
    asm volatile("" : "+v"(lane), "+v"(tid));
    const int mixer = u >> 8, pair = (u >> 2) & 63, head = u & 3;
    const bf16* PROJ = (const bf16*)(ws + WS_PROJ); const bf16* VT = (const bf16*)(ws + WS_VT);
    const float* gates = (const float*)(ws + WS_GATES);
    LAS bf16* KS = (LAS bf16*)lds;
    LAS float* GS = (LAS float*)(lds + 68608);
    LAS float* GRS = (LAS float*)(lds + 137216);
    LAS float* GLB = (LAS float*)(lds + 141312);
    const int kcol = (mixer ? 5120 : 1024) + head * 256;
    const int tok0 = 128 * pair;
    __syncthreads();
    if (mixer == 0) {
        if (wave < 2) mlstm_local(gates, (float*)(ws + WS_MLS), args.in[5][head], args.in[6][head], head, 2 * pair + wave, lane, GS + 128 * wave);
        __syncthreads();
        const float blA = GS[65], pmP = fmaxf(GS[64], GS[128 + 64] - blA);
#pragma unroll
        for (int i = 0; i < 8; ++i) {
            const int q = tid + 512 * i, s = q >> 5, d0 = (q & 31) * 8;
            const v4u kw = *(const v4u*)(PROJ + (size_t)(tok0 + s) * 8192 + kcol + d0);
            const float aa = (s < 64) ? GS[s] : (GS[128 + s - 64] - blA);
            const float w = fexp2(1.4426950408889634f * (aa - pmP)) * 0.0625f;
            v4u o; o.x = pk2(bflo(kw.x) * w, bfhi(kw.x) * w); o.y = pk2(bflo(kw.y) * w, bfhi(kw.y) * w); o.z = pk2(bflo(kw.z) * w, bfhi(kw.z) * w); o.w = pk2(bflo(kw.w) * w, bfhi(kw.w) * w);
            *(LAS v4u*)(KS + s * TL + d0) = o;
        }
    } else {
        float* G = (float*)(ws + WS_GG);
        gla_g_chunk(args, gates, G, GS, GRS, 2 * pair + 1, head, tid);
        if (tid < 256) GLB[tid] = GS[63 * 256 + tid];
#pragma unroll
        for (int i = 0; i < 4; ++i) {
            const int q = tid + 512 * i, s = q >> 5, d0 = (q & 31) * 8;
            const v4u kw = *(const v4u*)(PROJ + (size_t)(tok0 + 64 + s) * 8192 + kcol + d0);
            const f32x4 a0 = *(const LAS f32x4*)(GS + 63 * 256 + d0), a1 = *(const LAS f32x4*)(GS + 63 * 256 + d0 + 4), b0 = *(const LAS f32x4*)(GS + s * 256 + d0), b1 = *(const LAS f32x4*)(GS + s * 256 + d0 + 4);
            v4u o; o.x = pk2(bflo(kw.x) * __expf(a0.x - b0.x), bfhi(kw.x) * __expf(a0.y - b0.y)); o.y = pk2(bflo(kw.y) * __expf(a0.z - b0.z), bfhi(kw.y) * __expf(a0.w - b0.w));
            o.z = pk2(bflo(kw.z) * __expf(a1.x - b1.x), bfhi(kw.z) * __expf(a1.y - b1.y)); o.w = pk2(bflo(kw.w) * __expf(a1.z - b1.z), bfhi(kw.w) * __expf(a1.w - b1.w));
            *(LAS v4u*)(KS + (64 + s) * TL + d0) = o;
        }
        __syncthreads();
        gla_g_chunk(args, gates, G, GS, GRS, 2 * pair, head, tid);
#pragma unroll
        for (int i = 0; i < 4; ++i) {
            const int q = tid + 512 * i, s = q >> 5, d0 = (q & 31) * 8;
            const v4u kw = *(const v4u*)(PROJ + (size_t)(tok0 + s) * 8192 + kcol + d0);
            const f32x4 a0 = *(const LAS f32x4*)(GS + 63 * 256 + d0), a1 = *(const LAS f32x4*)(GS + 63 * 256 + d0 + 4), b0 = *(const LAS f32x4*)(GS + s * 256 + d0), b1 = *(const LAS f32x4*)(GS + s * 256 + d0 + 4);
            const f32x4 c0 = *(const LAS f32x4*)(GLB + d0), c1 = *(const LAS f32x4*)(GLB + d0 + 4);
            v4u o; o.x = pk2(bflo(kw.x) * __expf(a0.x - b0.x + c0.x), bfhi(kw.x) * __expf(a0.y - b0.y + c0.y)); o.y = pk2(bflo(kw.y) * __expf(a0.z - b0.z + c0.z), bfhi(kw.y) * __expf(a0.w - b0.w + c0.w));
            o.z = pk2(bflo(kw.z) * __expf(a1.x - b1.x + c1.x), bfhi(kw.z) * __expf(a1.y - b1.y + c1.y)); o.w = pk2(bflo(kw.w) * __expf(a1.z - b1.z + c1.z), bfhi(kw.w) * __expf(a1.w - b1.w + c1.w));
            *(LAS v4u*)(KS + s * TL + d0) = o;
        }
    }
    __syncthreads();
    const int fr = lane & 15, fq = lane >> 4;
    bf16* ST = (bf16*)(ws + WS_STATE) + ((size_t)((mixer * 4 + head) * NPAIR + pair)) * (512 * 256);
    const int vrow0 = mixer * 2048 + head * 512 + wave * 64;
    LAS bf16* OS = (LAS bf16*)(lds + 68608 + wave * 8448);
#pragma unroll 1
    for (int vt = 0; vt < 4; ++vt) {
        const bf16* vp = (VT + (size_t)(vrow0 + 16 * vt) * 8192 + tok0) + (fr * 8192 + 8 * fq);
        const bf16x8 b0 = *(const bf16x8*)vp, b1 = *(const bf16x8*)(vp + 32), b2 = *(const bf16x8*)(vp + 64), b3 = *(const bf16x8*)(vp + 96);
#pragma unroll 4
        for (int dt = 0; dt < 16; ++dt) {
            f32x4 acc = {0.f, 0.f, 0.f, 0.f};
            acc = mma(tr_frag(KS + 16 * dt, TL, lane), b0, acc); acc = mma(tr_frag(KS + 32 * TL + 16 * dt, TL, lane), b1, acc);
            acc = mma(tr_frag(KS + 64 * TL + 16 * dt, TL, lane), b2, acc); acc = mma(tr_frag(KS + 96 * TL + 16 * dt, TL, lane), b3, acc);
            v2u w; w.x = pk2(acc[0], acc[1]); w.y = pk2(acc[2], acc[3]);
            *(LAS v2u*)(OS + fr * 264 + 16 * dt + 4 * fq) = w;
        }
        LDS_WAIT(); asm volatile("" ::: "memory");
        bf16* op = ST + (size_t)(wave * 64 + 16 * vt) * 256;
#pragma unroll
        for (int i = 0; i < 8; ++i) { const int rr = 2 * i + (lane >> 5), cc = (lane & 31) * 8;
            *(v4u*)(op + rr * 256 + cc) = *(const LAS v4u*)(OS + rr * 264 + cc); }
        LDS_WAIT(); asm volatile("" ::: "memory");
    }
    if (mixer == 0 && tid < 256) {
        float s = 0.f;
#pragma unroll 8
        for (int t = 0; t < 128; ++t) s += __uint_as_float((unsigned)KS[t * TL + tid] << 16);
        ((float*)(ws + WS_NST))[(size_t)(head * NPAIR + pair) * 256 + tid] = s;
    }
}

__device__ __forceinline__ void scan_phase(unsigned char* ws, int T0, int TS) {
    const float* G = (const float*)(ws + WS_GG); const float* mls = (const float*)(ws + WS_MLS); float* mlsw = (float*)(ws + WS_MLS);
#pragma unroll 1
    for (int T = T0; T < 131072; T += TS) {
        const int mixer = T >> 16, head = (T >> 14) & 3, v = (T >> 5) & 511, d0 = (T & 31) * 8;
        bf16* base = (bf16*)(ws + WS_STATE) + ((size_t)((mixer * 4 + head) * NPAIR)) * (512 * 256) + (size_t)v * 256 + d0;
        float C[8]; float mrun = 0.f;
#pragma unroll
        for (int e = 0; e < 8; ++e) C[e] = 0.f;
#pragma unroll 1
        for (int p0 = 0; p0 < NPAIR; p0 += 4) {
            v4u x[4]; float dec[4][8]; float cor[4] = {1.f, 1.f, 1.f, 1.f};
#pragma unroll
            for (int i = 0; i < 4; ++i) x[i] = *(const v4u*)(base + (size_t)(p0 + i) * (512 * 256));
#pragma unroll
            for (int i = 0; i < 4; ++i) { const int cA = 2 * (p0 + i);
                if (mixer == 0) { const float blA = mls[MLS_CHB + head * NCH + cA], blB = mls[MLS_CHB + head * NCH + cA + 1];
                    const float pmP = fmaxf(mls[MLS_CHP + head * NCH + cA], mls[MLS_CHP + head * NCH + cA + 1] - blA), m63 = fmaxf(pmP, mrun);
                    const float dd = __expf(mrun - m63); cor[i] = __expf(pmP - m63);
                    if (v == 0 && d0 == 0) mlsw[MLS_MC + head * NCH + p0 + i] = mrun;
                    mrun = (blA + blB) + m63;
#pragma unroll
                    for (int e = 0; e < 8; ++e) dec[i][e] = dd; }
                else { const float* ga = G + (size_t)(cA * 64 + 63) * 1024 + head * 256 + d0; const float* gb = ga + (size_t)64 * 1024;
                    const f32x4 a0 = *(const f32x4*)ga, a1 = *(const f32x4*)(ga + 4), b0 = *(const f32x4*)gb, b1 = *(const f32x4*)(gb + 4);
                    dec[i][0] = __expf(a0.x + b0.x); dec[i][1] = __expf(a0.y + b0.y); dec[i][2] = __expf(a0.z + b0.z); dec[i][3] = __expf(a0.w + b0.w);
                    dec[i][4] = __expf(a1.x + b1.x); dec[i][5] = __expf(a1.y + b1.y); dec[i][6] = __expf(a1.z + b1.z); dec[i][7] = __expf(a1.w + b1.w); }
            }
#pragma unroll
            for (int i = 0; i < 4; ++i) {
                v4u o; o.x = pk2(C[0], C[1]); o.y = pk2(C[2], C[3]); o.z = pk2(C[4], C[5]); o.w = pk2(C[6], C[7]);
                *(v4u*)(base + (size_t)(p0 + i) * (512 * 256)) = o;
                C[0] = dec[i][0] * C[0] + cor[i] * bflo(x[i].x); C[1] = dec[i][1] * C[1] + cor[i] * bfhi(x[i].x); C[2] = dec[i][2] * C[2] + cor[i] * bflo(x[i].y); C[3] = dec[i][3] * C[3] + cor[i] * bfhi(x[i].y);
                C[4] = dec[i][4] * C[4] + cor[i] * bflo(x[i].z); C[5] = dec[i][5] * C[5] + cor[i] * bfhi(x[i].z); C[6] = dec[i][6] * C[6] + cor[i] * bflo(x[i].w); C[7] = dec[i][7] * C[7] + cor[i] * bfhi(x[i].w);
            }
        }
    }
    for (int T = T0; T < 1024; T += TS) {
        const int head = T >> 8, d = T & 255; float* np = (float*)(ws + WS_NST) + (size_t)head * NPAIR * 256 + d; float n = 0.f, mrun = 0.f;
#pragma unroll 1
        for (int p = 0; p < NPAIR; ++p) { const float x = np[p * 256]; np[p * 256] = n;
            const float blA = mls[MLS_CHB + head * NCH + 2 * p], blB = mls[MLS_CHB + head * NCH + 2 * p + 1];
            const float pmP = fmaxf(mls[MLS_CHP + head * NCH + 2 * p], mls[MLS_CHP + head * NCH + 2 * p + 1] - blA), m63 = fmaxf(pmP, mrun);
            n = __expf(mrun - m63) * n + __expf(pmP - m63) * x; mrun = (blA + blB) + m63; }
    }
}

constexpr int PLP = 136;
constexpr int HTP = 516;
__device__ __forceinline__ int mixout_chunk(int u) { int c = (u >> 2) & 127; c = (c & ~3) | ((c & 1) << 1) | ((c >> 1) & 1); return c ^ (c >> 6); }
template <bool ODD>
__device__ __forceinline__ void mixout_unit(const Args& args, unsigned char* ws, LAS unsigned char* lds, int u, int tid, int wave, int lane) {
    asm volatile("" : "+v"(lane), "+v"(tid));
    constexpr int NK = ODD ? 128 : 64, KOFF = ODD ? 64 : 0, NST2 = NK / 32;
    const int mixer = u >> 9, chunk = mixout_chunk(u), head = u & 3, pair = chunk >> 1;
    const bf16* PROJ = (const bf16*)(ws + WS_PROJ); const bf16* VT = (const bf16*)(ws + WS_VT);
    const float* G = (const float*)(ws + WS_GG); const float* mls = (const float*)(ws + WS_MLS);
    LAS bf16* KS = (LAS bf16*)lds; LAS bf16* QS = (LAS bf16*)(lds + 67584); LAS bf16* PS = (LAS bf16*)(lds + 101376);
    LAS float* HT = (LAS float*)lds;
    LAS float* RDEN = (LAS float*)(lds + 132096); LAS float* SSQ = (LAS float*)(lds + 132352); LAS float* NPREV = (LAS float*)(lds + 134400); LAS float* RSTD = (LAS float*)(lds + 135424);
    const int qcol = (mixer ? 4096 : 0) + head * 256, kcol = (mixer ? 5120 : 1024) + head * 256;
    const int fr = lane & 15, fq = lane >> 4;
    const int tok0 = chunk * 64, tokK0 = tok0 - KOFF;
    float mc = 0.f, minter = 0.f, blA = 0.f;
    if (mixer == 0) { const float mp = mls[MLS_MC + head * NCH + pair];
        if (ODD) { blA = mls[MLS_CHB + head * NCH + chunk - 1]; mc = blA + fmaxf(mls[MLS_CHP + head * NCH + chunk - 1], mp); minter = blA + mp; } else { mc = mp; minter = mp; } }
    __syncthreads();
#pragma unroll
    for (int i = 0; i < 4; ++i) {
        const int q = tid + 512 * i, s = q >> 5, d0 = (q & 31) * 8;
        const v4u kw = *(const v4u*)(PROJ + (size_t)(tok0 + s) * 8192 + kcol + d0);
        const v4u qw = *(const v4u*)(PROJ + (size_t)(tok0 + s) * 8192 + qcol + d0);
        float sk[8], sq[8];
        if (mixer == 0) {
#pragma unroll
            for (int e = 0; e < 8; ++e) { sk[e] = 0.0625f; sq[e] = 1.f; } }
        else { const float* gs = G + (size_t)(tok0 + s) * 1024 + head * 256 + d0; const f32x4 b0 = *(const f32x4*)gs, b1 = *(const f32x4*)(gs + 4);
            const float gg[8] = {b0.x, b0.y, b0.z, b0.w, b1.x, b1.y, b1.z, b1.w};
#pragma unroll
            for (int e = 0; e < 8; ++e) { sq[e] = __expf(gg[e]) * 0.0625f; sk[e] = __expf(-gg[e]); } }
        v4u o; o.x = pk2(bflo(kw.x) * sk[0], bfhi(kw.x) * sk[1]); o.y = pk2(bflo(kw.y) * sk[2], bfhi(kw.y) * sk[3]);
        o.z = pk2(bflo(kw.z) * sk[4], bfhi(kw.z) * sk[5]); o.w = pk2(bflo(kw.w) * sk[6], bfhi(kw.w) * sk[7]);
        *(LAS v4u*)(KS + (KOFF + s) * TL + d0) = o;
        v4u p; p.x = pk2(bflo(qw.x) * sq[0], bfhi(qw.x) * sq[1]); p.y = pk2(bflo(qw.y) * sq[2], bfhi(qw.y) * sq[3]);
        p.z = pk2(bflo(qw.z) * sq[4], bfhi(qw.z) * sq[5]); p.w = pk2(bflo(qw.w) * sq[6], bfhi(qw.w) * sq[7]);
        *(LAS v4u*)(QS + s * TL + d0) = p;
        if (ODD) {
            const v4u cw = *(const v4u*)(PROJ + (size_t)(tokK0 + s) * 8192 + kcol + d0);
            float sc[8];
            if (mixer == 0) {
#pragma unroll
                for (int e = 0; e < 8; ++e) sc[e] = 0.0625f; }
            else { const float* gl = G + (size_t)(tokK0 + 63) * 1024 + head * 256 + d0; const float* gs2 = G + (size_t)(tokK0 + s) * 1024 + head * 256 + d0;
                const f32x4 a0 = *(const f32x4*)gl, a1 = *(const f32x4*)(gl + 4), b0 = *(const f32x4*)gs2, b1 = *(const f32x4*)(gs2 + 4);
                sc[0] = __expf(a0.x - b0.x); sc[1] = __expf(a0.y - b0.y); sc[2] = __expf(a0.z - b0.z); sc[3] = __expf(a0.w - b0.w);
                sc[4] = __expf(a1.x - b1.x); sc[5] = __expf(a1.y - b1.y); sc[6] = __expf(a1.z - b1.z); sc[7] = __expf(a1.w - b1.w); }
            v4u c4; c4.x = pk2(bflo(cw.x) * sc[0], bfhi(cw.x) * sc[1]); c4.y = pk2(bflo(cw.y) * sc[2], bfhi(cw.y) * sc[3]);
            c4.z = pk2(bflo(cw.z) * sc[4], bfhi(cw.z) * sc[5]); c4.w = pk2(bflo(cw.w) * sc[6], bfhi(cw.w) * sc[7]);
            *(LAS v4u*)(KS + s * TL + d0) = c4;
        }
    }
    if (mixer == 0 && tid < 256) NPREV[tid] = ((const float*)(ws + WS_NST))[(size_t)(head * NPAIR + pair) * 256 + tid];
    __syncthreads();
    {
        const int tt = wave >> 1;
        const bool cross = ODD && ((wave & 1) == 0);
#pragma unroll
        for (int h2 = 0; h2 < NST2; ++h2) {
            const int st = NST2 * (wave & 1) + h2;
            f32x4 acc = {0.f, 0.f, 0.f, 0.f};
#pragma unroll
            for (int ks = 0; ks < 8; ++ks) {
                const bf16x8 a = *(const LAS bf16x8*)(KS + (16 * st + fr) * TL + 32 * ks + 8 * fq);
                const bf16x8 b = *(const LAS bf16x8*)(QS + (16 * tt + fr) * TL + 32 * ks + 8 * fq);
                acc = mma(a, b, acc);
            }
            const int t = 16 * tt + fr, r0 = 16 * st + 4 * fq;
            float f[4] = {1.f, 1.f, 1.f, 1.f};
            if (mixer == 0) { const float Mt = fmaxf(mls[MLS_PM + head * SEQ + tok0 + t], mc); const f32x4 av = *(const f32x4*)(mls + MLS_A + head * SEQ + tokK0 + r0);
                const float off = cross ? blA - Mt : -Mt;
                f[0] = __expf(av.x + off); f[1] = __expf(av.y + off); f[2] = __expf(av.z + off); f[3] = __expf(av.w + off); }
            float pv[4];
#pragma unroll
            for (int r = 0; r < 4; ++r) pv[r] = (cross || (r0 - KOFF + r <= t)) ? acc[r] * f[r] : 0.f;
            v2u w; w.x = pk2(pv[0], pv[1]); w.y = pk2(pv[2], pv[3]);
            *(LAS v2u*)(PS + t * PLP + r0) = w;
        }
    }
    __syncthreads();
    if (wave == 0) {
        float rd = 1.f;
        if (mixer == 0) {
            const int t = lane; float di = 0.f, qn = 0.f;
#pragma unroll 8
            for (int s = 0; s < NK; ++s) di += __uint_as_float((unsigned)PS[t * PLP + s] << 16);
#pragma unroll 8
            for (int d = 0; d < 256; ++d) qn += __uint_as_float((unsigned)QS[t * TL + d] << 16) * NPREV[d];
            const float Mt = fmaxf(mls[MLS_PM + head * SEQ + tok0 + t], mc);
            const float den = di + __expf(minter - Mt) * qn;
            rd = 1.f / fmaxf(fabsf(den), __expf(-(mls[MLS_BC + head * SEQ + tok0 + t] + Mt)));
        }
        RDEN[lane] = rd;
    }
    f32x4 acc[4][4];
#pragma unroll
    for (int a = 0; a < 4; ++a)
#pragma unroll
        for (int b = 0; b < 4; ++b) acc[a][b] = (f32x4){0.f, 0.f, 0.f, 0.f};
    const bf16* ST = (const bf16*)(ws + WS_STATE) + ((size_t)((mixer * 4 + head) * NPAIR + pair)) * (512 * 256);
#pragma unroll
    for (int vt = 0; vt < 4; ++vt) {
        bf16x8 af[8];
        const bf16* sp = (ST + (size_t)(wave * 64 + 16 * vt) * 256) + (fr * 256 + 8 * fq);
#pragma unroll
        for (int ks = 0; ks < 8; ++ks) af[ks] = *(const bf16x8*)(sp + 32 * ks);
        if (ODD && mixer == 1) {
            const float* gl = G + (size_t)(tokK0 + 63) * 1024 + head * 256 + 8 * fq;
#pragma unroll
            for (int ks = 0; ks < 8; ++ks) { const f32x4 e0 = *(const f32x4*)(gl + 32 * ks), e1 = *(const f32x4*)(gl + 32 * ks + 4);
                const v4u w = __builtin_bit_cast(v4u, af[ks]);
                v4u o; o.x = pk2(bflo(w.x) * __expf(e0.x), bfhi(w.x) * __expf(e0.y)); o.y = pk2(bflo(w.y) * __expf(e0.z), bfhi(w.y) * __expf(e0.w));
                o.z = pk2(bflo(w.z) * __expf(e1.x), bfhi(w.z) * __expf(e1.y)); o.w = pk2(bflo(w.w) * __expf(e1.z), bfhi(w.w) * __expf(e1.w));
                af[ks] = u4_as_frag(o); }
        }
#pragma unroll
        for (int tt = 0; tt < 4; ++tt)
#pragma unroll
            for (int ks = 0; ks < 8; ++ks) {
                const bf16x8 b = *(const LAS bf16x8*)(QS + (16 * tt + fr) * TL + 32 * ks + 8 * fq);
                acc[vt][tt] = mma(af[ks], b, acc[vt][tt]);
            }
    }
    if (mixer == 0) {
#pragma unroll
        for (int tt = 0; tt < 4; ++tt) { const float it = __expf(minter - fmaxf(mls[MLS_PM + head * SEQ + tok0 + 16 * tt + fr], mc));
#pragma unroll
            for (int vt = 0; vt < 4; ++vt) acc[vt][tt] = acc[vt][tt] * it; }
    }
    const int vrow0 = mixer * 2048 + head * 512 + wave * 64;
#pragma unroll
    for (int vt = 0; vt < 4; ++vt) {
        const bf16* vp = (VT + (size_t)(vrow0 + 16 * vt) * 8192 + tokK0) + (fr * 8192 + 8 * fq);
        bf16x8 a[NK / 32];
#pragma unroll
        for (int ks = 0; ks < NK / 32; ++ks) a[ks] = *(const bf16x8*)(vp + 32 * ks);
#pragma unroll
        for (int tt = 0; tt < 4; ++tt)
#pragma unroll
            for (int ks = 0; ks < NK / 32; ++ks)
                acc[vt][tt] = mma(a[ks], *(const LAS bf16x8*)(PS + (16 * tt + fr) * PLP + 32 * ks + 8 * fq), acc[vt][tt]);
    }
    __syncthreads();
#pragma unroll
    for (int tt = 0; tt < 4; ++tt) {
        const float rd = RDEN[16 * tt + fr]; float q = 0.f;
#pragma unroll
        for (int vt = 0; vt < 4; ++vt) { acc[vt][tt] = acc[vt][tt] * rd; q += acc[vt][tt][0] * acc[vt][tt][0] + acc[vt][tt][1] * acc[vt][tt][1] + acc[vt][tt][2] * acc[vt][tt][2] + acc[vt][tt][3] * acc[vt][tt][3];
            *(LAS f32x4*)(HT + (16 * tt + fr) * HTP + wave * 64 + 16 * vt + 4 * fq) = acc[vt][tt]; }
        q += __shfl_xor(q, 16); q += __shfl_xor(q, 32);
        if (fq == 0) SSQ[wave * 64 + 16 * tt + fr] = q;
    }
    __syncthreads();
    if (tid < 64) { float tot = 0.f;
#pragma unroll
        for (int w = 0; w < 8; ++w) tot += SSQ[w * 64 + tid];
        RSTD[tid] = rsqrtf(tot * (1.f / 512.f) + EPS); }
    __syncthreads();
    const float* hn = args.in[mixer ? 10 : 7] + head * 512;
    const bf16* gp = PROJ + (size_t)tok0 * 8192 + (mixer ? 6144 : 2048) + head * 512;
    bf16* hc = (bf16*)(ws + WS_HC) + (size_t)tok0 * DM + mixer * 2048 + head * 512;
#pragma unroll
    for (int i = 0; i < 8; ++i) {
        const int it = tid + NTHREADS * i, t = it >> 6, v0 = (it & 63) * 8;
        const f32x4 h0 = *(const LAS f32x4*)(HT + t * HTP + v0), h1 = *(const LAS f32x4*)(HT + t * HTP + v0 + 4);
        const f32x4 n0 = *(const f32x4*)(hn + v0), n1 = *(const f32x4*)(hn + v0 + 4);
        const v4u gw4 = *(const v4u*)(gp + (size_t)t * 8192 + v0);
        const float rstd = RSTD[t];
        float gt[8] = {bflo(gw4.x), bfhi(gw4.x), bflo(gw4.y), bfhi(gw4.y), bflo(gw4.z), bfhi(gw4.z), bflo(gw4.w), bfhi(gw4.w)};
#pragma unroll
        for (int r = 0; r < 8; ++r) { const float sg = sigmoid_fast(gt[r]); gt[r] = mixer ? gt[r] * sg : sg; }
        v4u w; w.x = pk2(h0[0] * rstd * n0[0] * gt[0], h0[1] * rstd * n0[1] * gt[1]); w.y = pk2(h0[2] * rstd * n0[2] * gt[2], h0[3] * rstd * n0[3] * gt[3]);
        w.z = pk2(h1[0] * rstd * n1[0] * gt[4], h1[1] * rstd * n1[1] * gt[5]); w.w = pk2(h1[2] * rstd * n1[2] * gt[6], h1[3] * rstd * n1[3] * gt[7]);
        *(v4u*)(hc + (size_t)t * DM + v0) = w;
    }
}

constexpr int SBK_P = 136, SBV_P = 72;
constexpr int SB_KS = 0, SB_VS = 17408, SB_BUF = 35840, SB_FLAGS = 8 * 16640;
__device__ __forceinline__ void stickbreak_phase(const Args& args, unsigned char* ws, LAS unsigned char* lds, int bx, int G, int tid, int wave, int lane) {
    const bf16* QK = (const bf16*)(ws + WS_PROJ); const bf16* VT = (const bf16*)(ws + WS_VT); bf16* HC = (bf16*)(ws + WS_HC);
    const float scale = 0.08838834764831845f * 1.4426950408889634f;
    volatile LAS int* FLAGS = (volatile LAS int*)(lds + SB_FLAGS);
    int iu = 0;
#pragma unroll 1
    for (int U = bx; U < 2048; U += G, ++iu) {
        asm volatile("" : "+v"(lane), "+v"(tid));
        const int fr = lane & 15, fq = lane >> 4;
        const bool rider = (G == 256) && (iu < 4);
        f32x4 rv[16]; Seg rsg; int rkb = 0, rnb = 0;
        if (rider) { const int gi = iu * 2048 + bx * NWAVES + wave; const int sI = gi < 4096 ? SEG_SB : SEG_SB + 1 + ((gi - 4096) >> 10); const int it = gi < 4096 ? gi : ((gi - 4096) & 1023);
            rsg = seg_at(sI); const int nblk = rsg.ncols / 64; rkb = it / nblk; rnb = it - rkb * nblk;
            tr_load(args.in[rsg.in_idx] + (size_t)rsg.src_l * rsg.K * rsg.N + (size_t)(64 * rkb) * rsg.N + rsg.scol + 64 * rnb, rsg.N, rv, lane); }
        const int kr0 = tid >> 4, kc0 = (tid & 15) * 8;
        const int vr0 = tid >> 3, vc0 = (tid & 7) * 8;
        const int head = U & 31, Q0 = (U >> 5) * 128, q0 = Q0 + 16 * wave, t = q0 + fr;
        bf16x8 qf[4];
#pragma unroll
        for (int ks = 0; ks < 4; ++ks) qf[ks] = *(const bf16x8*)(QK + (size_t)(q0 + fr) * 8192 + head * 128 + 32 * ks + 8 * fq);
        f32x4 o[8];
#pragma unroll
        for (int dt = 0; dt < 8; ++dt) o[dt] = (f32x4){0.f, 0.f, 0.f, 0.f};
        float carry = 0.f; bool done = false;
        const bf16* kg = QK + 4096 + head * 128 + kc0; const bf16* vg = VT + (size_t)(head * 128) * 8192 + vc0;
        const int KB0 = Q0 + 64;
        v4u kreg[2], vreg[2];
        kreg[0] = *(const v4u*)(kg + (size_t)(KB0 + kr0) * 8192); kreg[1] = *(const v4u*)(kg + (size_t)(KB0 + kr0 + 32) * 8192);
        vreg[0] = *(const v4u*)(vg + (size_t)vr0 * 8192 + KB0); vreg[1] = *(const v4u*)(vg + (size_t)(vr0 + 64) * 8192 + KB0);
        __syncthreads();
        { LAS bf16* KS = (LAS bf16*)(lds + SB_KS); LAS bf16* VS = (LAS bf16*)(lds + SB_VS);
          *(LAS v4u*)(KS + kr0 * SBK_P + kc0) = kreg[0]; *(LAS v4u*)(KS + (kr0 + 32) * SBK_P + kc0) = kreg[1];
          *(LAS v4u*)(VS + vr0 * SBV_P + vc0) = vreg[0]; *(LAS v4u*)(VS + (vr0 + 64) * SBV_P + vc0) = vreg[1]; }
        __syncthreads();
#pragma unroll 1
        for (int j = 0;; ++j) {
            const int kb = KB0 - 64 * j; const bool has_next = kb >= 64;
            if (has_next) { const int kn = kb - 64;
                kreg[0] = *(const v4u*)(kg + (size_t)(kn + kr0) * 8192); kreg[1] = *(const v4u*)(kg + (size_t)(kn + kr0 + 32) * 8192);
                vreg[0] = *(const v4u*)(vg + (size_t)vr0 * 8192 + kn); vreg[1] = *(const v4u*)(vg + (size_t)(vr0 + 64) * 8192 + kn); }
            const LAS bf16* KS = (const LAS bf16*)(lds + (j & 1) * SB_BUF + SB_KS); const LAS bf16* VS = (const LAS bf16*)(lds + (j & 1) * SB_BUF + SB_VS);
            if (!done && kb <= q0 + 15) {
                f32x4 sa[4];
#pragma unroll
                for (int i = 0; i < 4; ++i) { sa[i] = (f32x4){0.f, 0.f, 0.f, 0.f};
#pragma unroll
                    for (int ks = 0; ks < 4; ++ks) sa[i] = mma(*(const LAS bf16x8*)(KS + (16 * i + fr) * SBK_P + 32 * ks + 8 * fq), qf[ks], sa[i]); }
                float l1[4][4], lb[4][4], Tl[4];
                if (kb + 63 >= q0) {
#pragma unroll
                    for (int i = 0; i < 4; ++i) {
#pragma unroll
                        for (int r = 0; r < 4; ++r) { const float z = sa[i][r] * scale; const float sp = fmaxf(z, 0.f) + flog2(1.f + fexp2(-fabsf(z)));
                            const bool valid = (kb + 16 * i + 4 * fq + r) < t; l1[i][r] = valid ? -sp : 0.f; lb[i][r] = valid ? (z - sp) : -1e30f; }
                        Tl[i] = (l1[i][0] + l1[i][1]) + (l1[i][2] + l1[i][3]);
                    }
                } else {
#pragma unroll
                    for (int i = 0; i < 4; ++i) {
#pragma unroll
                        for (int r = 0; r < 4; ++r) { const float z = sa[i][r] * scale; const float sp = fmaxf(z, 0.f) + flog2(1.f + fexp2(-fabsf(z)));
                            l1[i][r] = -sp; lb[i][r] = z - sp; }
                        Tl[i] = (l1[i][0] + l1[i][1]) + (l1[i][2] + l1[i][3]);
                    }
                }
                float run = carry; float att[4][4];
#pragma unroll
                for (int i = 3; i >= 0; --i) {
                    const float T = Tl[i];
                    const float pb = xor16f(T, fq), pc = xor32f(T, fq), pd = xor32f(pb, fq);
                    const float sg = fq == 0 ? (pb + pc) + pd : (fq == 1 ? pc + pd : (fq == 2 ? pb : 0.f));
                    const float tot = (T + pb) + (pc + pd);
                    const float e3 = run + sg, e2 = e3 + l1[i][3], e1 = e2 + l1[i][2], e0 = e1 + l1[i][1];
                    att[i][0] = fexp2(lb[i][0] + e0); att[i][1] = fexp2(lb[i][1] + e1); att[i][2] = fexp2(lb[i][2] + e2); att[i][3] = fexp2(lb[i][3] + e3);
                    run += tot;
                }
                carry = run;
                bf16x8 pf[2];
#pragma unroll
                for (int s2 = 0; s2 < 2; ++s2) { v4u w; w.x = pk2(att[2 * s2][0], att[2 * s2][1]); w.y = pk2(att[2 * s2][2], att[2 * s2][3]);
                    w.z = pk2(att[2 * s2 + 1][0], att[2 * s2 + 1][1]); w.w = pk2(att[2 * s2 + 1][2], att[2 * s2 + 1][3]); pf[s2] = u4_as_frag(w); }
#pragma unroll
                for (int dt = 0; dt < 8; ++dt) {
                    const LAS bf16* vp = VS + (16 * dt + fr) * SBV_P + 4 * fq;
#pragma unroll
                    for (int s2 = 0; s2 < 2; ++s2) { const s16x4 lo = *(const LAS s16x4*)(vp + 32 * s2), hi = *(const LAS s16x4*)(vp + 32 * s2 + 16);
                        o[dt] = mma(cat8(lo, hi), pf[s2], o[dt]); }
                }
                if (__all(carry < -127.f)) done = true;
            }
            if (lane == 0) FLAGS[(j & 1) * 8 + wave] = done ? 1 : 0;
            if (has_next) { LAS bf16* KN = (LAS bf16*)(lds + ((j + 1) & 1) * SB_BUF + SB_KS); LAS bf16* VN = (LAS bf16*)(lds + ((j + 1) & 1) * SB_BUF + SB_VS);
                *(LAS v4u*)(KN + kr0 * SBK_P + kc0) = kreg[0]; *(LAS v4u*)(KN + (kr0 + 32) * SBK_P + kc0) = kreg[1];
                *(LAS v4u*)(VN + vr0 * SBV_P + vc0) = vreg[0]; *(LAS v4u*)(VN + (vr0 + 64) * SBV_P + vc0) = vreg[1]; }
            __syncthreads();
            int nd = 0;
#pragma unroll
            for (int w8 = 0; w8 < 8; ++w8) nd += FLAGS[(j & 1) * 8 + w8];
            if (!has_next || nd == 8) break;
        }
        { LAS bf16* OT = (LAS bf16*)(lds + wave * 16640);
#pragma unroll
          for (int dt = 0; dt < 8; ++dt) { v2u w; w.x = pk2(o[dt][0], o[dt][1]); w.y = pk2(o[dt][2], o[dt][3]);
              *(LAS v2u*)(OT + fr * SBK_P + 16 * dt + 4 * fq) = w; }
          LDS_WAIT(); asm volatile("" ::: "memory");
          bf16* hrow = HC + (size_t)q0 * DM + head * 128;
#pragma unroll
          for (int i = 0; i < 4; ++i) { const int rr = 4 * i + fq, cc = fr * 8;
              *(v4u*)(hrow + (size_t)rr * DM + cc) = *(const LAS v4u*)(OT + rr * SBK_P + cc); }
          LDS_WAIT(); asm volatile("" ::: "memory"); }
        if (rider) { LAS float* scr = (LAS float*)(lds + wave * 16640);
            tr_to_lds(rv, scr, lane);
            bf16* WT = (bf16*)(ws + WS_W + (size_t)rsg.layer * LAYER_W + (size_t)rsg.wsub_mib * MiB);
            tr_store(WT + (size_t)(rsg.drow + 64 * rnb) * rsg.K + 64 * rkb, rsg.K, scr, lane); }
    }
}

constexpr int XA_P = 264, XA_BUF = 64 * XA_P * 2;
__device__ __forceinline__ void xattn_phase(unsigned char* ws, LAS unsigned char* lds, int bx, int G, int tid, int wave, int lane) {
    const bf16* XQ = (const bf16*)(ws + WS_XQ); const bf16* KM = (const bf16*)(ws + WS_KMEM); const bf16* VTM = (const bf16*)(ws + WS_VTMEM); bf16* XO = (bf16*)(ws + WS_XO);
#pragma unroll 1
    for (int U = bx; U < 256; U += G) {
        asm volatile("" : "+v"(lane), "+v"(tid));
        const int fr = lane & 15, fq = lane >> 4;
        const int pr0 = tid >> 5, pc0 = (tid & 31) * 8;
        const int head = U & 3, q0 = (U >> 2) * 128 + 16 * wave;
        bf16x8 qf[8];
#pragma unroll
        for (int ks = 0; ks < 8; ++ks) qf[ks] = *(const bf16x8*)(XQ + (size_t)(q0 + fr) * XAW + head * 256 + 32 * ks + 8 * fq);
        f32x4 s[16]; bf16x8 pf[8]; float rs = 0.f;
        v4u preg[4];
        LAS bf16* OT = (LAS bf16*)(lds + 2 * XA_BUF + wave * 2304);
#define XA_LOAD(p) do { _Pragma("unroll") for (int i_ = 0; i_ < 4; ++i_) { const int r_ = pr0 + 16 * i_; \
            preg[i_] = ((p) < 4) ? *(const v4u*)(KM + (size_t)(64 * (p) + r_) * XAW + head * 256 + pc0) : *(const v4u*)(VTM + (size_t)(head * 256 + 64 * ((p) - 4) + r_) * NMEM + pc0); } } while (0)
#define XA_STORE(p) do { LAS bf16* B_ = (LAS bf16*)(lds + ((p) & 1) * XA_BUF); _Pragma("unroll") for (int i_ = 0; i_ < 4; ++i_) *(LAS v4u*)(B_ + (pr0 + 16 * i_) * XA_P + pc0) = preg[i_]; } while (0)
        XA_LOAD(0);
        __syncthreads();
        XA_STORE(0);
        __syncthreads();
#pragma unroll
        for (int p = 0; p < 8; ++p) {
            if (p < 7) XA_LOAD(p + 1);
            const LAS bf16* B = (const LAS bf16*)(lds + (p & 1) * XA_BUF);
            if (p < 4) {
#pragma unroll
                for (int i = 0; i < 4; ++i) { f32x4 a = {0.f, 0.f, 0.f, 0.f};
#pragma unroll
                    for (int ks = 0; ks < 8; ++ks) a = mma(*(const LAS bf16x8*)(B + (16 * i + fr) * XA_P + 32 * ks + 8 * fq), qf[ks], a);
                    s[4 * p + i] = a; }
                if (p == 3) {
                    float mx = -1e30f;
#pragma unroll
                    for (int i = 0; i < 16; ++i) { s[i] = s[i] * 0.0625f; mx = fmaxf(mx, fmaxf(fmaxf(s[i][0], s[i][1]), fmaxf(s[i][2], s[i][3]))); }
                    mx = fmaxf(mx, __shfl_xor(mx, 16)); mx = fmaxf(mx, __shfl_xor(mx, 32));
                    float sum = 0.f;
#pragma unroll
                    for (int i = 0; i < 16; ++i) { s[i][0] = __expf(s[i][0] - mx); s[i][1] = __expf(s[i][1] - mx); s[i][2] = __expf(s[i][2] - mx); s[i][3] = __expf(s[i][3] - mx);
                        sum += (s[i][0] + s[i][1]) + (s[i][2] + s[i][3]); }
                    sum += __shfl_xor(sum, 16); sum += __shfl_xor(sum, 32);
                    rs = 1.f / sum;
#pragma unroll
                    for (int s2 = 0; s2 < 8; ++s2) { v4u w; w.x = pk2(s[2 * s2][0], s[2 * s2][1]); w.y = pk2(s[2 * s2][2], s[2 * s2][3]);
                        w.z = pk2(s[2 * s2 + 1][0], s[2 * s2 + 1][1]); w.w = pk2(s[2 * s2 + 1][2], s[2 * s2 + 1][3]); pf[s2] = u4_as_frag(w); }
                }
            } else {
#pragma unroll
                for (int i = 0; i < 4; ++i) {
                    const LAS bf16* vp = B + (16 * i + fr) * XA_P + 4 * fq;
                    f32x4 o = {0.f, 0.f, 0.f, 0.f};
#pragma unroll
                    for (int s2 = 0; s2 < 8; ++s2) { const s16x4 lo = *(const LAS s16x4*)(vp + 32 * s2), hi = *(const LAS s16x4*)(vp + 32 * s2 + 16); o = mma(cat8(lo, hi), pf[s2], o); }
                    v2u w; w.x = pk2(o[0] * rs, o[1] * rs); w.y = pk2(o[2] * rs, o[3] * rs);
                    *(LAS v2u*)(OT + fr * 72 + 16 * i + 4 * fq) = w;
                }
                LDS_WAIT(); asm volatile("" ::: "memory");
                { bf16* xrow = XO + (size_t)q0 * XAW + head * 256 + 64 * (p - 4);
#pragma unroll
                  for (int i = 0; i < 2; ++i) { const int rr = 8 * i + (lane >> 3), cc = (lane & 7) * 8;
                      *(v4u*)(xrow + (size_t)rr * XAW + cc) = *(const LAS v4u*)(OT + rr * 72 + cc); } }
                LDS_WAIT(); asm volatile("" ::: "memory");
            }
            if (p < 7) XA_STORE(p + 1);
            __syncthreads();
        }
#undef XA_LOAD
#undef XA_STORE
    }
}

__device__ __forceinline__ void conv_fixup(const float* cw, const float* cb, unsigned char* ws, int T0, int TS) {
    const float* halo = (const float*)(ws + WS_HALO); bf16* H = (bf16*)(ws + WS_H);
#pragma unroll 1
    for (int T = T0; T < 64 * FF; T += TS) {
        const int pr = T / FF, f = T - pr * FF, pm = pr >> 1, rr = pr & 1;
        const float* hp = halo + (size_t)pm * 6 * FF + f;
        float p2 = 0.f, p3 = 0.f;
        if (pm > 0) { const float* hq = halo + (size_t)(pm - 1) * 6 * FF + f; p2 = hq[2 * FF]; p3 = hq[3 * FF]; }
        const float g0 = hp[rr * FF];
        float g1 = rr ? hp[0] : p3, g2 = rr ? p3 : p2;
        g1 = __uint_as_float(f2bf(g1) << 16); g2 = __uint_as_float(f2bf(g2) << 16);
        const float x = cb[f] + cw[f] * g2 + cw[FF + f] * g1 + cw[2 * FF + f] * g0;
        const float y = -2.3022081983651455f * (x + 0.044715f * x * x * x);
        H[(size_t)(256 * pm + rr) * FF + f] = (bf16)f2bf(x * frcp(1.f + fexp2(y)) * hp[(4 + rr) * FF]);
    }
}

#ifndef EN_MASK
#define EN_MASK 0xffffffffu
#endif
#define EN(k) ((EN_MASK >> (k)) & 1u)
#define STEP_ON (lo <= step && step < hi)
#define OPQ int olane; asm volatile("v_mbcnt_lo_u32_b32 %0, -1, 0\n\tv_mbcnt_hi_u32_b32 %0, -1, %0" : "=v"(olane)); const int otid = wave * 64 + olane
#define STEP_END do { if (MK_SINGLE && step + 1 < hi) xcd_barrier(bar); ++step; } while (0)
typedef pg8::bf16_t pb;
#define glds lds
#define xres (args.out)
#define XN ((bf16*)(ws + WS_XN))
#define HB ((bf16*)(ws + WS_HB))
#define RS ((float*)(ws + WS_RS))
#define HC ((bf16*)(ws + WS_HC))
#define wl (ws + WS_W + (size_t)layer * LAYER_W)
#define SITE size_t wz_ = 0; asm volatile("" : "+s"(wz_)); unsigned char* ws = args.ws + wz_

template <int LAYER>
__device__ __forceinline__ void layer_steps(const Args& args, LAS unsigned char* lds, const XcdBarrier& bar, const int lo, const int hi, int& step,
                                            const int G, const int bx, const int vcu, const int gw, const int NGW, const int wave) {
    constexpr int layer = LAYER;

        if (EN(1) && STEP_ON) { SITE;
            { pg8::Gemm g{(const pb*)XN, (const pb*)(wl + WO_MAIN), SEQ, 8192, DM, DM, DM}; pg8::StaticOrder S; S.init(g.M, g.N, G, bx);
              pg8::EpiStore E{(pb*)(ws + WS_PROJ), 8192, nullptr, -1};
              pg8::gemm_phase<pg8::EpiStore, pg8::StaticOrder, true, true>(glds, g, S, E, wave); }
            { pg8::Gemm g{(const pb*)(wl + WO_V), (const pb*)XN, DM, SEQ, DM, DM, DM}; pg8::StaticOrder S; S.init(g.M, g.N, G, bx);
              pg8::EpiStore E{(pb*)(ws + WS_VT), 8192, nullptr, -1};
              pg8::gemm_phase<pg8::EpiStore, pg8::StaticOrder, true, true>(glds, g, S, E, wave); }
            if (layer == 0) { OPQ; gates_minigemm(ws, lds, bx, G, otid, wave, olane); }
        }
        STEP_END;
        if (layer == 0) {
            if (EN(3) && STEP_ON) { SITE;
                OPQ;
#pragma unroll 1
                for (int u = bx; u < 512; u += G) dc_unit(args, ws, lds, u, otid, wave, olane);
            }
            STEP_END;
            if (EN(4) && STEP_ON) { SITE; OPQ; scan_phase(ws, vcu * NTHREADS + otid, G * NTHREADS); }
            STEP_END;
            if (EN(5) && STEP_ON) { SITE;
                OPQ;
#pragma unroll 1
                for (int u = bx; u < 1024; u += G) { if (mixout_chunk(u) & 1) mixout_unit<true>(args, ws, lds, u, otid, wave, olane); else mixout_unit<false>(args, ws, lds, u, otid, wave, olane); }
            }
            STEP_END;
        } else {
            if (EN(6) && STEP_ON) { SITE; OPQ; stickbreak_phase(args, ws, lds, bx, G, otid, wave, olane); }
            STEP_END;
        }
        if (EN(7) && STEP_ON) { SITE;
            pg8::Gemm g{(const pb*)HC, (const pb*)(wl + WO_OUT), SEQ, DM, DM, DM, DM}; pg8::StaticOrder S; S.init(g.M, g.N, G, bx);
            pg8::EpiStore E{(pb*)HB, DM, nullptr, -1};
            pg8::gemm_phase<pg8::EpiStore, pg8::StaticOrder, true, true>(glds, g, S, E, wave);
        }
        STEP_END;
        if (EN(8) && STEP_ON) { SITE; OPQ; norm_rows<1>(nullptr, HB, args.in[2] + layer * DM, args.in[3] + layer * DM, args.in[14] + layer * DM, nullptr, XN, RS, lds, gw, NGW, otid, olane); }
        STEP_END;
        if (EN(9) && STEP_ON) { SITE;
            { pg8::Gemm g{(const pb*)XN, (const pb*)(wl + WO_XQ), SEQ, XAW, DM, DM, DM}; pg8::StaticOrder S; S.init(g.M, g.N, G, bx);
              pg8::EpiStore E{(pb*)(ws + WS_XQ), XAW, nullptr, -1};
              pg8::gemm_phase<pg8::EpiStore, pg8::StaticOrder, true, true>(glds, g, S, E, wave); }
            { pg8::Gemm g{(const pb*)(ws + WS_MEMN) + (size_t)layer * NMEM * DM, (const pb*)(wl + WO_XK), NMEM, XAW, DM, DM, DM}; pg8::StaticOrder S; S.init(g.M, g.N, G, (bx + G - 128) % G);
              pg8::EpiStore E{(pb*)(ws + WS_KMEM), XAW, nullptr, -1};
              pg8::gemm_phase<pg8::EpiStore, pg8::StaticOrder, true, true>(glds, g, S, E, wave); }
            { pg8::Gemm g{(const pb*)(wl + WO_XV), (const pb*)(ws + WS_MEMN) + (size_t)layer * NMEM * DM, XAW, NMEM, DM, DM, DM}; pg8::StaticOrder S; S.init(g.M, g.N, G, (bx + G - 132) % G);
              pg8::EpiStore E{(pb*)(ws + WS_VTMEM), NMEM, nullptr, -1};
              pg8::gemm_phase<pg8::EpiStore, pg8::StaticOrder, true, true>(glds, g, S, E, wave); }
            if (G == 256 && bx >= XA_BUSY_WGS) { OPQ; convert_segments(args, ws, lds, SEG_DEFER, SEG_END, layer == 0 ? 0 : 1, layer == 0 ? 1 : 2, 2, (bx - XA_BUSY_WGS) * NWAVES + wave, (G - XA_BUSY_WGS) * NWAVES, wave, olane); }
        }
        STEP_END;
        if (EN(10) && STEP_ON) { SITE; OPQ; xattn_phase(ws, lds, bx, G, otid, wave, olane); }
        STEP_END;
        if (EN(11) && STEP_ON) { SITE;
            pg8::Gemm g{(const pb*)(ws + WS_XO), (const pb*)(wl + WO_XO), SEQ, DM, XAW, XAW, XAW}; pg8::StaticOrder S; S.init(g.M, g.N, G, bx);
            pg8::EpiStore E{(pb*)HB, DM, nullptr, -1};
            pg8::gemm_phase<pg8::EpiStore, pg8::StaticOrder, true, true>(glds, g, S, E, wave);
        }
        STEP_END;
        if (EN(12) && STEP_ON) { SITE; OPQ; norm_rows<1>(nullptr, HB, args.in[14] + layer * DM, args.in[15] + layer * DM, args.in[21] + layer * DM, nullptr, XN, RS, lds, gw, NGW, otid, olane); }
        STEP_END;
        if (EN(13) && STEP_ON) { SITE;
            pg8::Gemm g{(const pb*)XN, (const pb*)(wl + WO_GU), SEQ, 2 * FF, DM, DM, DM}; pg8::StaticOrder S; S.init(g.M, g.N, G, bx);
            pg8::EpiConvGelu E{(pb*)(ws + WS_H), FF, args.in[25] + (size_t)layer * 3 * FF, args.in[26] + (size_t)layer * FF, FF, (float*)(ws + WS_HALO), (PG8_LAS float*)(lds + 131072)};
            pg8::gemm_phase<pg8::EpiConvGelu, pg8::StaticOrder, true, true>(glds, g, S, E, wave);
        }
        STEP_END;
        if (EN(14) && STEP_ON) { SITE; OPQ; conv_fixup(args.in[25] + (size_t)layer * 3 * FF, args.in[26] + (size_t)layer * FF, ws, vcu * NTHREADS + otid, G * NTHREADS); }
        STEP_END;
        if (EN(15) && STEP_ON) { SITE;
            pg8::Gemm g{(const pb*)(ws + WS_H), (const pb*)(wl + WO_DOWN), SEQ, DM, FF, FF, FF}; pg8::StaticOrder S; S.init(g.M, g.N, G, bx);
            pg8::EpiStore E{(pb*)HB, DM, nullptr, -1};
            pg8::gemm_phase<pg8::EpiStore, pg8::StaticOrder, true, true>(glds, g, S, E, wave);
        }
        STEP_END;
        if (EN(16) && STEP_ON) { SITE;
            OPQ;
            if (layer == 0) norm_rows<1>(nullptr, HB, args.in[21], args.in[22], args.in[2] + DM, nullptr, XN, RS, lds, gw, NGW, otid, olane);
            else norm_rows<2>(nullptr, HB, args.in[21] + DM, args.in[22] + DM, nullptr, xres, XN, RS, lds, gw, NGW, otid, olane);
        }
        STEP_END;
}
__global__ void __launch_bounds__(NTHREADS, 2) mk_fwd(Args args) {
    extern __shared__ __attribute__((aligned(16))) unsigned char lds_raw[];
    LAS unsigned char* lds = (LAS unsigned char*)lds_raw;
    volatile LAS unsigned* MISC = (volatile LAS unsigned*)(lds + MISC_OFF);
    const int tid = threadIdx.x, wave = __builtin_amdgcn_readfirstlane(tid >> 6);
    const int G = gridDim.x, bx = blockIdx.x;
    const int vcu = (G % 8 == 0) ? (bx % 8) * (G / 8) + bx / 8 : bx;
    const int gw = vcu * NWAVES + wave, NGW = G * NWAVES;
    gu32* ctl = (gu32*)(args.ws + WS_CTL);
    for (int u = tid; u < (LDS_BYTES - LDSCTL_OFF) / 4; u += NTHREADS) ((LAS unsigned*)(lds + LDSCTL_OFF))[u] = 0u;
    __syncthreads();
    XcdBarrier bar; bar.bar = (unsigned*)(ctl + CW_BAR); bar.x = 0; bar.st = nullptr;
    if (MK_SINGLE) bar = xcd_barrier_post((unsigned*)(ctl + CW_BAR), MISC + 8);
    const int lo = args.ph_lo, hi = args.ph_hi;
    int step = 0;
    if (EN(0) && STEP_ON) { SITE;
        { OPQ; p0_prologue(args, ws, lds, gw, NGW, wave, olane, G == 256); }
        { OPQ; norm_rows<0>(args.in[0], nullptr, nullptr, nullptr, args.in[2], nullptr, XN, RS, lds, gw, NGW, otid, olane); }
    }
    STEP_END;

    layer_steps<0>(args, lds, bar, lo, hi, step, G, bx, vcu, gw, NGW, wave);
    layer_steps<1>(args, lds, bar, lo, hi, step, G, bx, vcu, gw, NGW, wave);
#undef STEP_ON
#undef STEP_END
}

extern "C" void kernel_launch(void* const* d_in, const int* in_sizes, int n_in, void* d_out, int out_size, void* d_ws, size_t ws_size, hipStream_t stream) {
    static int grid = 0;
    if (grid == 0) {
        if (n_in != 28 || out_size != SEQ * DM || ws_size < WS_END) { fprintf(stderr, "kernel_launch: built for 28 inputs, out %d floats, >= %zu bytes of workspace; got n_in %d, out %d, ws %zu; nothing launched\n", SEQ * DM, (size_t)WS_END, n_in, out_size, ws_size); grid = -1; return; }
        int dev = 0, cus = 0, per_cu = 0;
        if (hipGetDevice(&dev) != hipSuccess || hipDeviceGetAttribute(&cus, hipDeviceAttributeMultiprocessorCount, dev) != hipSuccess) { fprintf(stderr, "kernel_launch: device query failed\n"); grid = -1; return; }
        if (hipFuncSetAttribute((const void*)mk_fwd, hipFuncAttributeMaxDynamicSharedMemorySize, LDS_BYTES) != hipSuccess) { fprintf(stderr, "kernel_launch: hipFuncSetAttribute failed\n"); grid = -1; return; }
        if (hipOccupancyMaxActiveBlocksPerMultiprocessor(&per_cu, (const void*)mk_fwd, NTHREADS, LDS_BYTES) != hipSuccess || per_cu < 1)
            fprintf(stderr, "kernel_launch: note: occupancy query reports %d workgroups per CU\n", per_cu);
        (void)hipGetLastError();
        grid = cus;
    }
    if (grid < 0) return;
    if (hipMemsetAsync((char*)d_ws + WS_CTL, 0, CTL_ZERO_BYTES, stream) != hipSuccess) { fprintf(stderr, "kernel_launch: hipMemsetAsync failed\n"); return; }
    Args a{};
    for (int i = 0; i < 28; ++i) a.in[i] = (const float*)d_in[i];
    a.out = (float*)d_out; a.ws = (unsigned char*)d_ws;
#if MK_SINGLE
    a.ph_lo = 0; a.ph_hi = N_STEPS;
    hipLaunchKernelGGL(mk_fwd, dim3(grid), dim3(NTHREADS), LDS_BYTES, stream, a);
#else
#ifndef DUP_STEPS
#define DUP_STEPS 0u
#endif
#ifndef DUP_N
#define DUP_N 2
#endif
    for (int s = 0; s < N_STEPS; ++s) { a.ph_lo = s; a.ph_hi = s + 1;
        for (int rep = 0; rep < (((DUP_STEPS >> s) & 1u) ? DUP_N : 1); ++rep) hipLaunchKernelGGL(mk_fwd, dim3(grid), dim3(NTHREADS), LDS_BYTES, stream, a); }
#endif
    const hipError_t le = hipPeekAtLastError();
    if (le != hipSuccess) fprintf(stderr, "kernel_launch: launch failed: %s\n", hipGetErrorName(le));
}
```

```cpp
#include <hip/hip_runtime.h>
#include <cstdio>
#include <cstdint>
#define MK_SINGLE 1
namespace pg8 {
#define PG8_LAS __attribute__((address_space(3)))
typedef unsigned short bf16_t;
typedef short bf16x8 __attribute__((ext_vector_type(8)));
typedef float f32x4 __attribute__((ext_vector_type(4)));
typedef unsigned u32x4 __attribute__((ext_vector_type(4)));
constexpr int BM = 256, BK = 64, HALF = 128, HTB = HALF * BK * 2  , STAGE_BYTES = 8 * HTB, NXCD = 8, WGM = 8;

__host__ __device__ __forceinline__ int lds_byte(int r, int c) { const int st = (r >> 4) * 2 + (c >> 5), rr = r & 15, cc = c & 31, ob = rr * 64 + cc * 2; return st * 1024 + (ob ^ (((ob >> 9) & 1) << 5)); }
__host__ __device__ __forceinline__ void stage_rc(int b, int& R, int& C) { const int st = b / 1024, sb = b % 1024, swz = sb ^ (((sb >> 9) & 1) << 5); R = (st >> 1) * 16 + swz / 64; C = (st & 1) * 32 + (swz % 64) / 2; }
__host__ __device__ __forceinline__ int perm32(int rho) { const int n = rho >> 4, i = rho & 15; return 8 * (i >> 2) + 4 * n + (i & 3); }

struct Unit { int pm, pn; };
struct Gemm { const bf16_t* A; const bf16_t* Bt; int M, N, K, lda, ldb; };

struct StaticOrder {
    int nM, nN, nwg, G, c;
    __host__ __device__ void init(int M, int N, int G_, int c_) { nM = M / BM; nN = N / BM; nwg = nM * nN; G = G_; c = c_; }
    __host__ __device__ bool next(int i, Unit& u) const {
        const long L = (long)i * G + c; if (L >= nwg) return false;
        int wgid = (int)L; { const int q = nwg / NXCD, r = nwg % NXCD, xcd = wgid % NXCD, off = wgid / NXCD; wgid = (xcd < r ? xcd * (q + 1) : r * (q + 1) + (xcd - r) * q) + off; }
        const int nig = WGM * nN, gid = wgid / nig, fm = gid * WGM, gsz = (nM - fm) < WGM ? (nM - fm) : WGM;
        u.pm = fm + ((wgid % nig) % gsz); u.pn = (wgid % nig) / gsz; return true;
    }
    __device__ __forceinline__ void a_ready(const Unit&) const {}
    __device__ __forceinline__ void done(const Unit&) const {}
};

__device__ __forceinline__ unsigned cvt_pk_bf16(float lo, float hi) { unsigned r; asm volatile("v_cvt_pk_bf16_f32 %0, %1, %2" : "=v"(r) : "v"(lo), "v"(hi)); return r; }

struct EpiStore {
    static constexpr bool PERM = true, AFTER_DRAIN = false;
    bf16_t* O; int ldc; float* gates; int gate_pn;
    __device__ __forceinline__ void operator()(const f32x4 (&acc)[2][2][4][2], const Unit& u, int wr, int wc, int fr, int fq) const {
        const int row0 = u.pm * BM + wr * 64 + fr;
        if (u.pn == gate_pn) {
            if (wc == 0) {
#pragma unroll
                for (int ai = 0; ai < 2; ++ai)
#pragma unroll
                    for (int m = 0; m < 4; ++m) { float* gp = gates + (size_t)(row0 + ai * HALF + m * 16) * 32 + 8 * fq;
                        *(f32x4*)(gp) = acc[ai][0][m][0]; *(f32x4*)(gp + 4) = acc[ai][0][m][1]; }
            }
            return;
        }
        const int col0 = u.pn * BM + wc * 32 + 8 * fq;
#pragma unroll
        for (int ai = 0; ai < 2; ++ai)
#pragma unroll
            for (int m = 0; m < 4; ++m) { bf16_t* rowp = O + (size_t)(row0 + ai * HALF + m * 16) * ldc + col0;
#pragma unroll
                for (int bj = 0; bj < 2; ++bj) { const f32x4 v0 = acc[ai][bj][m][0], v1 = acc[ai][bj][m][1];
                    u32x4 w; w.x = cvt_pk_bf16(v0[0], v0[1]); w.y = cvt_pk_bf16(v0[2], v0[3]); w.z = cvt_pk_bf16(v1[0], v1[1]); w.w = cvt_pk_bf16(v1[2], v1[3]);
                    *(u32x4*)(rowp + bj * HALF) = w; } }
    }
};

__device__ __forceinline__ float gelu_tanh_f(float x) { const float y = -2.3022081983651455f * (x + 0.044715f * x * x * x); return x * __builtin_amdgcn_rcpf(1.f + __builtin_amdgcn_exp2f(y)); }
struct EpiConvGelu {
    static constexpr bool PERM = true, AFTER_DRAIN = false;
    bf16_t* H; int ldh; const float* cw; const float* cb; int ff; float* halo; PG8_LAS float* X;
    __device__ __forceinline__ void operator()(const f32x4 (&acc)[2][2][4][2], const Unit& u, int wr, int wc, int fr, int fq) const {
        const int cl = 32 * wc + 8 * fq;
        const int f0 = 128 * u.pn + cl;
        if (fr >= 14) {
#pragma unroll
            for (int ai = 0; ai < 2; ++ai) { PG8_LAS float* xp = X + ((2 * ai + wr) * 2 + (fr - 14)) * 128 + cl;
                *(PG8_LAS f32x4*)xp = acc[ai][0][3][0]; *(PG8_LAS f32x4*)(xp + 4) = acc[ai][0][3][1]; }
        }
        asm volatile("s_waitcnt lgkmcnt(0)" ::: "memory"); __builtin_amdgcn_s_barrier(); asm volatile("" ::: "memory");
        float w0[8], w1[8], w2[8], bb[8];
#pragma unroll
        for (int h = 0; h < 2; ++h) { const f32x4 a = *(const f32x4*)(cw + f0 + 4 * h), b = *(const f32x4*)(cw + ff + f0 + 4 * h), c = *(const f32x4*)(cw + 2 * ff + f0 + 4 * h), d = *(const f32x4*)(cb + f0 + 4 * h);
#pragma unroll
            for (int j = 0; j < 4; ++j) { w0[4 * h + j] = a[j]; w1[4 * h + j] = b[j]; w2[4 * h + j] = c[j]; bb[4 * h + j] = d[j]; } }
        float* hp = halo + (size_t)u.pm * 6 * ff + f0;
#pragma unroll
        for (int ai = 0; ai < 2; ++ai) {
            const int slab = 2 * ai + wr;
            unsigned l14[4], l15[4];
            if (slab > 0) { const PG8_LAS float* xp = X + ((slab - 1) * 2) * 128 + cl;
                const f32x4 a0 = *(const PG8_LAS f32x4*)xp, a1 = *(const PG8_LAS f32x4*)(xp + 4), b0 = *(const PG8_LAS f32x4*)(xp + 128), b1 = *(const PG8_LAS f32x4*)(xp + 132);
                l14[0] = cvt_pk_bf16(a0[0], a0[1]); l14[1] = cvt_pk_bf16(a0[2], a0[3]); l14[2] = cvt_pk_bf16(a1[0], a1[1]); l14[3] = cvt_pk_bf16(a1[2], a1[3]);
                l15[0] = cvt_pk_bf16(b0[0], b0[1]); l15[1] = cvt_pk_bf16(b0[2], b0[3]); l15[2] = cvt_pk_bf16(b1[0], b1[1]); l15[3] = cvt_pk_bf16(b1[2], b1[3]); }
            else { l14[0] = l14[1] = l14[2] = l14[3] = 0u; l15[0] = l15[1] = l15[2] = l15[3] = 0u; }
#pragma unroll
            for (int m = 0; m < 4; ++m) {
                const int row = u.pm * BM + ai * HALF + wr * 64 + m * 16 + fr;
                unsigned pk[4];
                pk[0] = cvt_pk_bf16(acc[ai][0][m][0][0], acc[ai][0][m][0][1]); pk[1] = cvt_pk_bf16(acc[ai][0][m][0][2], acc[ai][0][m][0][3]);
                pk[2] = cvt_pk_bf16(acc[ai][0][m][1][0], acc[ai][0][m][1][1]); pk[3] = cvt_pk_bf16(acc[ai][0][m][1][2], acc[ai][0][m][1][3]);
                float hv[8];
#pragma unroll
                for (int q = 0; q < 4; ++q) {
                    unsigned g1 = (unsigned)__shfl_up((int)pk[q], 1, 16), g2 = (unsigned)__shfl_up((int)pk[q], 2, 16);
                    if (fr == 0) { g1 = l15[q]; g2 = l14[q]; } else if (fr == 1) { g2 = l15[q]; }
                    const unsigned n14 = (unsigned)__shfl((int)pk[q], 14, 16), n15 = (unsigned)__shfl((int)pk[q], 15, 16);
                    l14[q] = n14; l15[q] = n15;
                    const int n = q >> 1, j = (q & 1) * 2, e = 2 * q;
                    const float x0 = bb[e] + w0[e] * __uint_as_float(g2 << 16) + w1[e] * __uint_as_float(g1 << 16) + w2[e] * acc[ai][0][m][n][j];
                    const float x1 = bb[e + 1] + w0[e + 1] * __uint_as_float(g2 & 0xffff0000u) + w1[e + 1] * __uint_as_float(g1 & 0xffff0000u) + w2[e + 1] * acc[ai][0][m][n][j + 1];
                    hv[e] = gelu_tanh_f(x0) * acc[ai][1][m][n][j]; hv[e + 1] = gelu_tanh_f(x1) * acc[ai][1][m][n][j + 1];
                }
                const bool first2 = (slab == 0 && m == 0 && fr < 2);
                if (!first2) { u32x4 w; w.x = cvt_pk_bf16(hv[0], hv[1]); w.y = cvt_pk_bf16(hv[2], hv[3]); w.z = cvt_pk_bf16(hv[4], hv[5]); w.w = cvt_pk_bf16(hv[6], hv[7]);
                    *(u32x4*)(H + (size_t)row * ldh + f0) = w; }
                else { float* p = hp + (size_t)fr * ff; *(f32x4*)p = acc[0][0][0][0]; *(f32x4*)(p + 4) = acc[0][0][0][1];
                    float* pu = hp + (size_t)(4 + fr) * ff; *(f32x4*)pu = acc[0][1][0][0]; *(f32x4*)(pu + 4) = acc[0][1][0][1]; }
                if (slab == 3 && m == 3 && fr >= 14) { float* p = hp + (size_t)(2 + fr - 14) * ff; *(f32x4*)p = acc[1][0][3][0]; *(f32x4*)(p + 4) = acc[1][0][3][1]; }
            }
        }
    }
};
template <class Epi, class Sched, bool ALIGN_EPI = false, bool SP2 = false>
__device__ __forceinline__ void gemm_phase(PG8_LAS unsigned char* lds, const Gemm g, const Sched& S, const Epi& E, const int wv  ) {
    int tid_o; asm volatile("v_mbcnt_lo_u32_b32 %0, -1, 0\n\tv_mbcnt_hi_u32_b32 %0, -1, %0" : "=v"(tid_o)); tid_o += wv * 64;
    const int tid = tid_o, wid = __builtin_amdgcn_readfirstlane(tid >> 6), lane = tid & 63, wr = wid >> 2, wc = wid & 3, fr = lane & 15, fq = lane >> 4;
    const int K = g.K, nt = K / BK;
    unsigned voffA[2], voffB[2];
#pragma unroll
    for (int i = 0; i < 2; ++i) { int R, C; stage_rc(tid * 16 + i * 8192, R, C); const int Rb = Epi::PERM ? ((R & ~31) + perm32(R & 31)) : R;
        voffA[i] = (unsigned)(R * g.lda + C) * 2u; voffB[i] = (unsigned)(Rb * g.ldb + C) * 2u; }
    const size_t kstep = (size_t)(BK * 2);
    const size_t hstepA = (size_t)HALF * g.lda * 2, hstepB = (size_t)HALF * g.ldb * 2;
    const size_t tstepA = 2 * hstepA, tstepB = 2 * hstepB;
    const unsigned ldsw = (unsigned)wid * 1024u;
    const int aoff = lds_byte(wr * 64 + fr, fq * 8), boff = lds_byte(wc * 32 + fr, fq * 8);
#define PG8_SA(b, h) (((b) * 2 + (h)) * HTB)
#define PG8_SB(b, h) ((4 + (b) * 2 + (h)) * HTB)
#define PG8_STAGE(bufoff, gbase, voff) do { _Pragma("unroll") for (int _i = 0; _i < 2; ++_i) \
        __builtin_amdgcn_global_load_lds((const unsigned*)((const char*)(gbase) + (voff)[_i]), (PG8_LAS unsigned*)(lds + (bufoff) + ldsw + _i * 8192), 16, 0, 0); } while (0)
#define PG8_LDA(dst, b, h) do { _Pragma("unroll") for (int m = 0; m < 4; ++m) _Pragma("unroll") for (int k = 0; k < 2; ++k) dst[m][k] = *(const PG8_LAS bf16x8*)(lds + PG8_SA(b, h) + aoff + m * 2048 + k * 1024); } while (0)
#define PG8_LDB(dst, b, h) do { _Pragma("unroll") for (int n = 0; n < 2; ++n) _Pragma("unroll") for (int k = 0; k < 2; ++k) dst[n][k] = *(const PG8_LAS bf16x8*)(lds + PG8_SB(b, h) + boff + n * 2048 + k * 1024); } while (0)
#define PG8_MMA(ai, bj, At, Bt) do { __builtin_amdgcn_s_setprio(1); _Pragma("unroll") for (int m = 0; m < 4; ++m) _Pragma("unroll") for (int n = 0; n < 2; ++n) _Pragma("unroll") for (int k = 0; k < 2; ++k) \
        acc[ai][bj][m][n] = __builtin_amdgcn_mfma_f32_16x16x32_bf16(Bt[n][k], At[m][k], acc[ai][bj][m][n], 0, 0, 0); __builtin_amdgcn_s_setprio(0); } while (0)
#define PG8_WAIT_V(n) asm volatile("s_waitcnt vmcnt(" #n ")" ::: "memory")
#define PG8_WAIT_L(n) asm volatile("s_waitcnt lgkmcnt(" #n ")" ::: "memory")
#define PG8_BAR __builtin_amdgcn_s_barrier()
#define PG8_SCHED __builtin_amdgcn_sched_barrier(0)
    Unit cur, nxt; int ui = 0;
    if (!S.next(0, cur)) return;
    f32x4 acc[2][2][4][2];
#pragma unroll
    for (int a = 0; a < 2; ++a)
#pragma unroll
        for (int b = 0; b < 2; ++b)
#pragma unroll
            for (int m = 0; m < 4; ++m)
#pragma unroll
                for (int n = 0; n < 2; ++n) acc[a][b][m][n] = (f32x4){0.f, 0.f, 0.f, 0.f};
    bf16x8 At[4][2], B0[2][2], B1[2][2];
    const char* cA = (const char*)g.A + (size_t)cur.pm * tstepA; const char* cB = (const char*)g.Bt + (size_t)cur.pn * tstepB;
    S.a_ready(cur);
    if constexpr (SP2) {
        PG8_STAGE(PG8_SB(0, 0), cB, voffB); PG8_STAGE(PG8_SB(0, 1), cB + hstepB, voffB); PG8_STAGE(PG8_SA(0, 0), cA, voffA); PG8_STAGE(PG8_SA(0, 1), cA + hstepA, voffA);
        if (wr == 1) PG8_BAR;
        PG8_WAIT_V(2); PG8_BAR;
        PG8_STAGE(PG8_SB(1, 0), cB + kstep, voffB); PG8_STAGE(PG8_SA(1, 0), cA + kstep, voffA); PG8_STAGE(PG8_SB(1, 1), cB + hstepB + kstep, voffB);
        PG8_WAIT_V(6); PG8_BAR;
    } else {
        PG8_STAGE(PG8_SB(0, 0), cB, voffB); PG8_STAGE(PG8_SA(0, 0), cA, voffA); PG8_STAGE(PG8_SB(0, 1), cB + hstepB, voffB); PG8_STAGE(PG8_SA(0, 1), cA + hstepA, voffA);
        if (wr == 1) PG8_BAR;
        PG8_WAIT_V(4); PG8_BAR;
        PG8_STAGE(PG8_SB(1, 0), cB + kstep, voffB); PG8_STAGE(PG8_SA(1, 0), cA + kstep, voffA); PG8_STAGE(PG8_SB(1, 1), cB + hstepB + kstep, voffB);
        PG8_WAIT_V(6); PG8_BAR;
    }
    for (;;) {
        const bool has_next = S.next(ui + 1, nxt);
        const char* nA = has_next ? (const char*)g.A + (size_t)nxt.pm * tstepA : cA; const char* nB = has_next ? (const char*)g.Bt + (size_t)nxt.pn * tstepB : cB;
        for (int t = 0; t < nt; t += 2) {
            const bool last = (t == nt - 2);
            const char* a1 = cA + (size_t)(t + 1) * kstep;
            const char* a2 = last ? nA : cA + (size_t)(t + 2) * kstep; const char* b2 = last ? nB : cB + (size_t)(t + 2) * kstep;
            const char* a3 = a2 + kstep; const char* b3 = b2 + kstep;
            if (last && has_next) S.a_ready(nxt);
            if constexpr (SP2) {
            PG8_LDB(B0, 0, 0); PG8_LDB(B1, 0, 1); PG8_SCHED; PG8_LDA(At, 0, 0); PG8_STAGE(PG8_SA(1, 1), a1 + hstepA, voffA);
            PG8_WAIT_V(8); PG8_WAIT_L(0); PG8_BAR; PG8_MMA(0, 0, At, B0); PG8_MMA(0, 1, At, B1); PG8_BAR; PG8_SCHED;
            PG8_LDA(At, 0, 1); PG8_STAGE(PG8_SB(0, 0), b2, voffB); PG8_STAGE(PG8_SB(0, 1), b2 + hstepB, voffB); PG8_STAGE(PG8_SA(0, 0), a2, voffA);
            PG8_WAIT_V(8); PG8_WAIT_L(0); PG8_BAR; PG8_MMA(1, 0, At, B0); PG8_MMA(1, 1, At, B1); PG8_BAR; PG8_SCHED;
            PG8_LDB(B0, 1, 0); PG8_LDB(B1, 1, 1); PG8_SCHED; PG8_LDA(At, 1, 0); PG8_STAGE(PG8_SA(0, 1), a2 + hstepA, voffA);
            PG8_WAIT_V(8); PG8_WAIT_L(0); PG8_BAR; PG8_MMA(0, 0, At, B0); PG8_MMA(0, 1, At, B1); PG8_BAR; PG8_SCHED;
            PG8_LDA(At, 1, 1); PG8_STAGE(PG8_SB(1, 0), b3, voffB); PG8_STAGE(PG8_SB(1, 1), b3 + hstepB, voffB); PG8_STAGE(PG8_SA(1, 0), a3, voffA);
            PG8_WAIT_V(8); PG8_WAIT_L(0); PG8_BAR; PG8_MMA(1, 0, At, B0); PG8_MMA(1, 1, At, B1); PG8_BAR; PG8_SCHED;
            } else {
            PG8_LDB(B0, 0, 0); PG8_SCHED; PG8_LDA(At, 0, 0); PG8_STAGE(PG8_SA(1, 1), a1 + hstepA, voffA);
            PG8_WAIT_L(8); PG8_BAR; PG8_WAIT_L(0); PG8_MMA(0, 0, At, B0); PG8_BAR; PG8_SCHED;
            PG8_LDB(B1, 0, 1); PG8_STAGE(PG8_SB(0, 0), b2, voffB);
            PG8_BAR; PG8_WAIT_L(0); PG8_MMA(0, 1, At, B1); PG8_BAR;
            PG8_LDA(At, 0, 1); PG8_STAGE(PG8_SA(0, 0), a2, voffA);
            PG8_BAR; PG8_WAIT_L(0); PG8_MMA(1, 0, At, B0); PG8_BAR; PG8_SCHED;
            PG8_STAGE(PG8_SB(0, 1), b2 + hstepB, voffB);
            PG8_WAIT_V(6); PG8_BAR; PG8_MMA(1, 1, At, B1); PG8_BAR;
            PG8_LDB(B0, 1, 0); PG8_SCHED; PG8_LDA(At, 1, 0); PG8_STAGE(PG8_SA(0, 1), a2 + hstepA, voffA);
            PG8_WAIT_L(8); PG8_BAR; PG8_WAIT_L(0); PG8_MMA(0, 0, At, B0); PG8_BAR; PG8_SCHED;
            PG8_LDB(B1, 1, 1); PG8_STAGE(PG8_SB(1, 0), b3, voffB);
            PG8_BAR; PG8_WAIT_L(0); PG8_MMA(0, 1, At, B1); PG8_BAR;
            PG8_LDA(At, 1, 1); PG8_STAGE(PG8_SA(1, 0), a3, voffA);
            PG8_BAR; PG8_WAIT_L(0); PG8_MMA(1, 0, At, B0); PG8_BAR; PG8_SCHED;
            PG8_STAGE(PG8_SB(1, 1), b3 + hstepB, voffB);
            PG8_WAIT_V(6); PG8_BAR; PG8_MMA(1, 1, At, B1); PG8_BAR;
            }
        }
        if constexpr (ALIGN_EPI) { if (wr == 0) PG8_BAR; }
        if constexpr (!Epi::AFTER_DRAIN) { E(acc, cur, wr, wc, fr, fq); S.done(cur); }
        if (!has_next) break;
#pragma unroll
        for (int a = 0; a < 2; ++a)
#pragma unroll
            for (int b = 0; b < 2; ++b)
#pragma unroll
                for (int m = 0; m < 4; ++m)
#pragma unroll
                    for (int n = 0; n < 2; ++n) acc[a][b][m][n] = (f32x4){0.f, 0.f, 0.f, 0.f};
        cur = nxt; cA = nA; cB = nB; ++ui;
        if constexpr (ALIGN_EPI) { if (wr == 1) PG8_BAR; }
    }
    PG8_WAIT_V(0);
    if constexpr (!ALIGN_EPI) { if (wr == 0) PG8_BAR; }
    PG8_BAR;
    if constexpr (Epi::AFTER_DRAIN) { E.fused(acc, cur, wr, wc, fr, fq, lds, wid, lane); S.done(cur); }
#undef PG8_SA
#undef PG8_SB
#undef PG8_STAGE
#undef PG8_LDA
#undef PG8_LDB
#undef PG8_MMA
#undef PG8_WAIT_V
#undef PG8_WAIT_L
#undef PG8_BAR
#undef PG8_SCHED
}
}

constexpr int SEQ = 8192, DM = 4096, NMEM = 256, FF = 11008, XAW = 1024, ABIN = 12312;
constexpr int NCH = 128;
constexpr float EPS = 1e-6f;
constexpr int NWAVES = 8, NTHREADS = 512;
#ifndef MK_SINGLE
#define MK_SINGLE 1
#endif
constexpr int N_STEPS = 27;

constexpr size_t MiB = 1u << 20;
constexpr size_t WS_CTL = 0, CTL_ZERO_BYTES = 1 * MiB;
constexpr size_t WS_GATES = 1 * MiB;
constexpr size_t WS_MLS = 2 * MiB;
constexpr size_t WS_RS = 2 * MiB + 768 * 1024;
constexpr size_t WS_NST = 3 * MiB;
constexpr size_t WS_MEMN = 4 * MiB;
constexpr size_t WS_KMEM = 8 * MiB;
constexpr size_t WS_VTMEM = 8 * MiB + 512 * 1024;
constexpr size_t WS_XQ = 16 * MiB;
constexpr size_t WS_XO = 32 * MiB;
constexpr size_t WS_XN = 48 * MiB;
constexpr size_t WS_HB = 112 * MiB;
constexpr size_t WS_HC = 176 * MiB;
constexpr size_t WS_GG = 240 * MiB;
constexpr size_t WS_BIG = 272 * MiB;
constexpr size_t WS_PROJ = WS_BIG;
constexpr size_t WS_VT = WS_BIG + 132 * MiB;
constexpr size_t WS_STATE = WS_BIG + 196 * MiB;
constexpr size_t WS_H = WS_BIG;
constexpr size_t WS_HALO = WS_GG;
constexpr size_t WS_W = 724 * MiB;
constexpr size_t LAYER_W = 420 * MiB;
constexpr size_t WO_MAIN = 0, WO_V = 66 * MiB, WO_OUT = 98 * MiB, WO_XQ = 130 * MiB, WO_XK = 138 * MiB, WO_XV = 146 * MiB, WO_XO = 154 * MiB, WO_GU = 162 * MiB, WO_DOWN = 334 * MiB;
constexpr size_t WS_END = WS_W + 2 * LAYER_W;
constexpr int CW_TMO = 0, CW_CODE = 1, CW_BAR = 4096;
constexpr int MLS_A = 0, MLS_PM = 4 * SEQ, MLS_BC = 8 * SEQ, MLS_CHB = 12 * SEQ, MLS_CHP = 12 * SEQ + 4 * NCH, MLS_MC = 12 * SEQ + 8 * NCH;

constexpr int SCR_BYTES = 143360;
constexpr int LDSCTL_OFF = SCR_BYTES, MISC_OFF = LDSCTL_OFF + 320;
constexpr int LDS_BYTES = 147456;

#define GAS __attribute__((address_space(1)))
#define LAS __attribute__((address_space(3)))
typedef unsigned short bf16;
typedef unsigned v4u __attribute__((ext_vector_type(4)));
typedef unsigned v2u __attribute__((ext_vector_type(2)));
typedef float f32x4 __attribute__((ext_vector_type(4)));
typedef short bf16x8 __attribute__((ext_vector_type(8)));
typedef short s16x4 __attribute__((ext_vector_type(4)));
typedef GAS unsigned gu32;
#define RLX_AGENT __ATOMIC_RELAXED, __HIP_MEMORY_SCOPE_AGENT
#define LDS_WAIT() asm volatile("s_waitcnt lgkmcnt(0)" ::: "memory")
#define VM_WAIT() asm volatile("s_waitcnt vmcnt(0)" ::: "memory")
__device__ __forceinline__ unsigned f2bf(float f) { unsigned u = __builtin_bit_cast(unsigned, f); return (u + 0x7fffu + ((u >> 16) & 1u)) >> 16; }
__device__ __forceinline__ unsigned pk2(float lo, float hi) { return f2bf(lo) | (f2bf(hi) << 16); }
__device__ __forceinline__ float bflo(unsigned w) { return __uint_as_float(w << 16); }
__device__ __forceinline__ float bfhi(unsigned w) { return __uint_as_float(w & 0xffff0000u); }
__device__ __forceinline__ f32x4 mma(bf16x8 a, bf16x8 b, f32x4 c) { return __builtin_amdgcn_mfma_f32_16x16x32_bf16(a, b, c, 0, 0, 0); }
__device__ __forceinline__ bf16x8 cat8(s16x4 lo, s16x4 hi) { return __builtin_shufflevector(lo, hi, 0, 1, 2, 3, 4, 5, 6, 7); }
__device__ __forceinline__ bf16x8 u4_as_frag(v4u w) { return __builtin_bit_cast(bf16x8, w); }
__device__ __forceinline__ float wave_sum(float v) {
#pragma unroll
    for (int o = 1; o < 64; o <<= 1) v += __shfl_xor(v, o);
    return v;
}
__device__ __forceinline__ float logsig_acc(float x) { return fminf(x, 0.f) - log1pf(expf(-fabsf(x))); }
__device__ __forceinline__ float logsig_fast(float x) { return fminf(x, 0.f) - __logf(1.f + __expf(-fabsf(x))); }
__device__ __forceinline__ float fexp2(float x) { return __builtin_amdgcn_exp2f(x); }
__device__ __forceinline__ float flog2(float x) { return __builtin_amdgcn_logf(x); }
__device__ __forceinline__ float frcp(float x) { return __builtin_amdgcn_rcpf(x); }
__device__ __forceinline__ float sigmoid_fast(float x) { return frcp(1.f + fexp2(-1.4426950408889634f * x)); }
__device__ __forceinline__ float xor16f(float x, int fq) { const unsigned u = __float_as_uint(x); const auto r = __builtin_amdgcn_permlane16_swap(u, u, false, false); return __uint_as_float((fq & 1) ? r[0] : r[1]); }
__device__ __forceinline__ float xor32f(float x, int fq) { const unsigned u = __float_as_uint(x); const auto r = __builtin_amdgcn_permlane32_swap(u, u, false, false); return __uint_as_float((fq & 2) ? r[0] : r[1]); }
__device__ __forceinline__ bf16x8 tr_frag(const LAS bf16* tile, int ld, int lane) {
    const int g = lane >> 4, li = lane & 15, q = li >> 2, p = li & 3;
    const LAS bf16* a = tile + (8 * g + q) * ld + 4 * p;
    const s16x4 lo = __builtin_amdgcn_ds_read_tr16_b64_v4i16((LAS s16x4*)a);
    const s16x4 hi = __builtin_amdgcn_ds_read_tr16_b64_v4i16((LAS s16x4*)(a + 4 * ld));
    return cat8(lo, hi);
}
struct Args { const float* in[28]; float* out; unsigned char* ws; int ph_lo, ph_hi; };
#define XB_TMO      128
#define XB_XCNT(j)  (256  + 64 * (j))
#define XB_XSUB(j)  (1280 + 64 * (j))
#define XB_XGEN(j)  (2304 + 64 * (j))
#define XB_TOP      3328
#define XB_TOPGEN   3392
#define XCD_BAR_WORDS 3456
#define XB_SPIN_CAP (1u << 18)

__device__ __forceinline__ unsigned xb_ld(unsigned* p)              { return __hip_atomic_load(p, __ATOMIC_RELAXED, __HIP_MEMORY_SCOPE_AGENT); }
__device__ __forceinline__ unsigned xb_add(unsigned* p, unsigned v) { return __hip_atomic_fetch_add(p, v, __ATOMIC_RELAXED, __HIP_MEMORY_SCOPE_AGENT); }
__device__ __forceinline__ unsigned xb_xcc_id() { return (unsigned)__builtin_amdgcn_s_getreg((3 << 11) | 20) & 0xFu; }
#define XB_SPIN(cond, bar) do { unsigned _sp = 0; while (cond) { __builtin_amdgcn_s_sleep(1); \
    if ((++_sp & 255u) == 0u) { if (xb_ld(&(bar)[XB_TMO])) break; if (_sp > XB_SPIN_CAP) { atomicAdd(&(bar)[XB_TMO], 1u); break; } } } } while (0)

struct XcdBarrier {
    unsigned* bar; unsigned x;
    volatile LAS unsigned* st;
};

__device__ __forceinline__ XcdBarrier xcd_barrier_post(unsigned* bar, volatile LAS unsigned* st) {
    XcdBarrier b; b.bar = bar; b.x = xb_xcc_id(); b.st = st;
    if (threadIdx.x == 0) (void)xb_add(&bar[XB_XCNT(b.x)], 1u);
    return b;
}
__device__ __forceinline__ void xcd_barrier_complete(unsigned* bar, unsigned x, unsigned& nloc, unsigned& nx) {
    const unsigned G = gridDim.x * gridDim.y * gridDim.z;
    unsigned sum, cnt, mine, sp = 0u;
    for (;;) {
        sum = 0u; cnt = 0u; mine = 0u;
#pragma unroll
        for (unsigned j = 0; j < 16; ++j) { const unsigned c = xb_ld(&bar[XB_XCNT(j)]); sum += c; cnt += (c > 0u) ? 1u : 0u; mine = (j == x) ? c : mine; }
        if (sum == G) break;
        __builtin_amdgcn_s_sleep(1);
        if ((++sp & 255u) == 0u) { if (xb_ld(&bar[XB_TMO])) break; if (sp > XB_SPIN_CAP) { atomicAdd(&bar[XB_TMO], 1u); break; } }
    }
    nloc = mine > 0u ? mine : 1u; nx = cnt > 0u ? cnt : 1u;
}

__device__ __forceinline__ void xcd_barrier(const XcdBarrier& b) {
    asm volatile("s_waitcnt vmcnt(0)" ::: "memory");
    __syncthreads();
    if (threadIdx.x == 0) {
        unsigned* bar = b.bar;
        __builtin_amdgcn_s_waitcnt(0);
        unsigned nloc = b.st[0], nx = b.st[1];
        if (nloc == 0u) { xcd_barrier_complete(bar, b.x, nloc, nx); b.st[0] = nloc; b.st[1] = nx; }
        const unsigned old = xb_add(&bar[XB_XSUB(b.x)], 1u);
        const unsigned gen = old / nloc;
        if (old + 1u == (gen + 1u) * nloc) {
            __builtin_amdgcn_fence(__ATOMIC_RELEASE, "agent");
            asm volatile("s_waitcnt vmcnt(0)" ::: "memory");
            const unsigned og = xb_add(&bar[XB_TOP], 1u);
            const unsigned tg = og / nx;
            if (og + 1u == (tg + 1u) * nx) xb_add(&bar[XB_TOPGEN], 1u);
            else XB_SPIN(xb_ld(&bar[XB_TOPGEN]) == tg, bar);
            __builtin_amdgcn_fence(__ATOMIC_ACQUIRE, "agent");
            xb_add(&bar[XB_XGEN(b.x)], 1u);
            asm volatile("s_waitcnt vmcnt(0)" ::: "memory");
        } else {
            XB_SPIN(xb_ld(&bar[XB_XGEN(b.x)]) == gen, bar);
            __builtin_amdgcn_fence(__ATOMIC_ACQUIRE, "agent");
            asm volatile("s_waitcnt vmcnt(0)" ::: "memory");
        }
    }
    __syncthreads();
}


__device__ __forceinline__ void tr_load(const float* src, int N, f32x4 (&v)[16], int lane) {
    const int r4 = lane >> 4, c4 = (lane & 15) * 4;
#pragma unroll
    for (int i = 0; i < 16; ++i) v[i] = *(const f32x4*)(src + (size_t)(4 * i + r4) * N + c4);
}
__device__ __forceinline__ void tr_to_lds(const f32x4 (&v)[16], LAS float* scr, int lane) {
    const int r4 = lane >> 4, c4 = (lane & 15) * 4;
#pragma unroll
    for (int i = 0; i < 16; ++i) { LAS float* s = scr + (4 * i + r4) * 65 + c4; s[0] = v[i].x; s[1] = v[i].y; s[2] = v[i].z; s[3] = v[i].w; }
    LDS_WAIT(); asm volatile("" ::: "memory");
}
__device__ __forceinline__ void tr_store(bf16* dst, int K, const LAS float* scr, int lane) {
    const int c = lane & 7;
#pragma unroll
    for (int j = 0; j < 8; ++j) { const int n = (lane >> 3) + 8 * j; const LAS float* s = scr + (8 * c) * 65 + n;
        v4u o; o.x = pk2(s[0], s[65]); o.y = pk2(s[130], s[195]); o.z = pk2(s[260], s[325]); o.w = pk2(s[390], s[455]);
        *(v4u*)(dst + (size_t)n * K + 8 * c) = o; }
    LDS_WAIT(); asm volatile("" ::: "memory");
}
struct Seg { int in_idx, src_l, N, K, scol, ncols, layer, wsub_mib, drow, ilv; };
__device__ __forceinline__ Seg seg_at(int i) {
    constexpr Seg segs[26] = {
        {4, 0, ABIN, DM, 0, 1024, 0, 0, 0, 0}, {4, 0, ABIN, DM, 1024, 1024, 0, 0, 1024, 0}, {4, 0, ABIN, DM, 4096, 2048, 0, 0, 2048, 0},
        {4, 0, ABIN, DM, 6152, 1024, 0, 0, 4096, 0}, {4, 0, ABIN, DM, 7176, 1024, 0, 0, 5120, 0}, {4, 0, ABIN, DM, 10248, 2048, 0, 0, 6144, 0},
        {4, 0, ABIN, DM, 2048, 2048, 0, 66, 0, 0}, {4, 0, ABIN, DM, 8200, 2048, 0, 66, 2048, 0},
        {11, 0, DM, DM, 0, DM, 0, 98, 0, 0},
        {17, 0, XAW, DM, 0, XAW, 0, 130, 0, 0}, {18, 0, XAW, DM, 0, XAW, 0, 138, 0, 0}, {19, 0, XAW, DM, 0, XAW, 0, 146, 0, 0}, {20, 0, DM, XAW, 0, DM, 0, 154, 0, 0},
        {23, 0, FF, DM, 0, FF, 0, 162, 0, 1}, {24, 0, FF, DM, 0, FF, 0, 162, 128, 1}, {27, 0, DM, FF, 0, DM, 0, 334, 0, 0},
        {12, 0, 3 * DM, DM, 0, 2 * DM, 1, 0, 0, 0}, {12, 0, 3 * DM, DM, 2 * DM, DM, 1, 66, 0, 0},
        {13, 0, DM, DM, 0, DM, 1, 98, 0, 0},
        {17, 1, XAW, DM, 0, XAW, 1, 130, 0, 0}, {18, 1, XAW, DM, 0, XAW, 1, 138, 0, 0}, {19, 1, XAW, DM, 0, XAW, 1, 146, 0, 0}, {20, 1, DM, XAW, 0, DM, 1, 154, 0, 0},
        {23, 1, FF, DM, 0, FF, 1, 162, 0, 1}, {24, 1, FF, DM, 0, FF, 1, 162, 128, 1}, {27, 1, DM, FF, 0, DM, 1, 334, 0, 0}};
    return segs[i];
}
__device__ __forceinline__ void convert_segments(const Args& args, unsigned char* ws, LAS unsigned char* lds, int seg_lo, int seg_hi, int part_lo, int part_hi, int nparts, int wid, int nw, int wave, int lane) {
    LAS float* scr = (LAS float*)(lds + wave * 16640);
#pragma unroll 1
    for (int sI = seg_lo; sI < seg_hi; ++sI) {
        const Seg sg = seg_at(sI);
        const int nblk = sg.ncols / 64, nit = (sg.K / 64) * nblk;
        const float* W = args.in[sg.in_idx] + (size_t)sg.src_l * sg.K * sg.N;
        bf16* WT = (bf16*)(ws + WS_W + (size_t)sg.layer * LAYER_W + (size_t)sg.wsub_mib * MiB);
        const int it_lo = (int)((long)nit * part_lo / nparts), it_hi = (int)((long)nit * part_hi / nparts);
        int it = it_lo + wid;
        f32x4 v[16];
        if (it < it_hi) { const int kb = it / nblk, nb = it - kb * nblk; tr_load(W + (size_t)(64 * kb) * sg.N + sg.scol + 64 * nb, sg.N, v, lane); }
#pragma unroll 1
        for (; it < it_hi; it += nw) {
            const int kb = it / nblk, nb = it - kb * nblk;
            const int drow = sg.ilv ? (256 * (nb >> 1) + 64 * (nb & 1) + sg.drow) : (sg.drow + 64 * nb);
            tr_to_lds(v, scr, lane);
            const int itn = it + nw;
            if (itn < it_hi) { const int kbn = itn / nblk, nbn = itn - kbn * nblk; tr_load(W + (size_t)(64 * kbn) * sg.N + sg.scol + 64 * nbn, sg.N, v, lane); }
            tr_store(WT + (size_t)drow * sg.K + 64 * kb, sg.K, scr, lane);
        }
    }
}
#ifndef RIDER_ON
#define RIDER_ON 1
#endif
constexpr int SEG_SB = 18, SEG_DEFER = 23, SEG_END = 26, XA_BUSY_WGS = 136, GU_BUSY_WGS = 192;
__device__ __forceinline__ void p0_prologue(const Args& args, unsigned char* ws, LAS unsigned char* lds, int gw, int NGW, int wave, int lane, bool defer) {
    convert_segments(args, ws, lds, 0, defer ? (RIDER_ON ? SEG_SB : SEG_DEFER) : SEG_END, 0, 1, 1, gw, NGW, wave, lane);
    {
        const float* W = args.in[4]; bf16* WT = (bf16*)(ws + WS_W + WO_MAIN) + (size_t)8192 * DM;
        for (int idx = gw * 64 + lane; idx < 256 * DM; idx += NGW * 64) {
            const int i = idx >> 12, k = idx & (DM - 1);
            float v = 0.f;
            if (i < 24) { const int col = i < 4 ? 6144 + i : (i < 8 ? 6148 + (i - 4) : 12296 + (i - 8)); v = W[(size_t)k * ABIN + col]; }
            WT[idx] = (bf16)f2bf(v);
        }
    }
    for (int r = gw; r < 2 * NMEM; r += NGW) {
        const int l = r >> 8, row = r & 255;
        const float* xr = args.in[1] + (size_t)row * DM; const float* g = args.in[16] + (size_t)l * DM;
        bf16* o = (bf16*)(ws + WS_MEMN) + (size_t)r * DM;
        f32x4 v[16]; float ss = 0.f;
#pragma unroll
        for (int j = 0; j < 16; ++j) { v[j] = *(const f32x4*)(xr + 4 * lane + 256 * j); ss += v[j].x * v[j].x + v[j].y * v[j].y + v[j].z * v[j].z + v[j].w * v[j].w; }
        const float rstd = rsqrtf(wave_sum(ss) * (1.f / DM) + EPS);
#pragma unroll
        for (int j = 0; j < 16; ++j) { const f32x4 gg = *(const f32x4*)(g + 4 * lane + 256 * j);
            v2u w; w.x = pk2(v[j].x * rstd * gg.x, v[j].y * rstd * gg.y); w.y = pk2(v[j].z * rstd * gg.z, v[j].w * rstd * gg.w);
            *(v2u*)(o + 4 * lane + 256 * j) = w; }
    }
}

#define LAUNDER8(a, o) asm volatile("" : "+v"(a[o].x), "+v"(a[o].y), "+v"(a[o+1].x), "+v"(a[o+1].y), "+v"(a[o+2].x), "+v"(a[o+2].y), "+v"(a[o+3].x), "+v"(a[o+3].y), \
    "+v"(a[o+4].x), "+v"(a[o+4].y), "+v"(a[o+5].x), "+v"(a[o+5].y), "+v"(a[o+6].x), "+v"(a[o+6].y), "+v"(a[o+7].x), "+v"(a[o+7].y))
#define LAUNDER_ROW(pw, hw) do { LAUNDER8(pw, 0); LAUNDER8(pw, 8); LAUNDER8(hw, 0); LAUNDER8(hw, 8); } while (0)
template <int MODE>
__device__ __forceinline__ void norm_rows(const float* xin, const bf16* hb, const float* gprev, const float* gpost, const float* gpre, float* xout, bf16* xn, float* rs,
                                          LAS unsigned char* lds, int gw, int NGW, int tid, int lane, bf16* xn_out = nullptr, float* rs_out = nullptr) {
    if (!xn_out) { xn_out = xn; rs_out = rs; }
    LAS float* GP = (LAS float*)lds; LAS float* GN = (LAS float*)(lds + 16384); LAS float* GI = (LAS float*)(lds + 32768);
    __syncthreads();
#pragma unroll
    for (int i = 0; i < 2; ++i) { const int o = 4 * (tid + NTHREADS * i);
        if (MODE != 0) { *(LAS f32x4*)(GP + o) = *(const f32x4*)(gpost + o); const f32x4 g = *(const f32x4*)(gprev + o); *(LAS f32x4*)(GI + o) = (f32x4){1.f / g.x, 1.f / g.y, 1.f / g.z, 1.f / g.w}; }
        if (MODE != 2) *(LAS f32x4*)(GN + o) = *(const f32x4*)(gpre + o); }
    __syncthreads();
    const int lo4 = 4 * lane;
#pragma unroll 1
    for (int row = gw; row < SEQ; row += NGW) {
        asm volatile("" ::: "memory");
        if (MODE == 0) {
            const float* xr = xin + (size_t)row * DM; bf16* nw = xn_out + (size_t)row * DM;
            f32x4 xv[16]; float ss = 0.f;
#pragma unroll
            for (int j = 0; j < 16; ++j) { xv[j] = *(const f32x4*)(xr + lo4 + 256 * j); ss += xv[j].x * xv[j].x + xv[j].y * xv[j].y + xv[j].z * xv[j].z + xv[j].w * xv[j].w; }
            const float rstd = rsqrtf(wave_sum(ss) * (1.f / DM) + EPS);
            if (lane == 0) rs_out[row] = rstd;
            asm volatile("" ::: "memory");
#pragma unroll
            for (int j = 0; j < 16; ++j) { const f32x4 g = *(const LAS f32x4*)(GN + lo4 + 256 * j);
                v2u w; w.x = pk2(xv[j].x * rstd * g.x, xv[j].y * rstd * g.y); w.y = pk2(xv[j].z * rstd * g.z, xv[j].w * rstd * g.w);
                *(v2u*)(nw + lo4 + 256 * j) = w; }
        } else {
            const bf16* pr = xn + (size_t)row * DM; bf16* pw_out = xn_out + (size_t)row * DM; const bf16* hr = hb + (size_t)row * DM;
            v2u pw[16], hw[16]; float ss = 0.f;
#pragma unroll
            for (int j = 0; j < 16; ++j) { pw[j] = *(const v2u*)(pr + lo4 + 256 * j); hw[j] = *(const v2u*)(hr + lo4 + 256 * j); }
            const float ri = 1.f / rs[row];
#pragma unroll
            for (int j = 0; j < 16; ++j) { const float a = bflo(hw[j].x), b = bfhi(hw[j].x), c = bflo(hw[j].y), d = bfhi(hw[j].y); ss += a * a + b * b + c * c + d * d; }
            const float rstd = rsqrtf(wave_sum(ss) * (1.f / DM) + EPS);
            asm volatile("" ::: "memory");
            LAUNDER_ROW(pw, hw);
            float ss2 = 0.f;
#pragma unroll
            for (int j = 0; j < 16; ++j) { const f32x4 g = *(const LAS f32x4*)(GP + lo4 + 256 * j), gi = *(const LAS f32x4*)(GI + lo4 + 256 * j);
                f32x4 x;
                x.x = bflo(pw[j].x) * ri * gi.x + bflo(hw[j].x) * rstd * g.x; x.y = bfhi(pw[j].x) * ri * gi.y + bfhi(hw[j].x) * rstd * g.y;
                x.z = bflo(pw[j].y) * ri * gi.z + bflo(hw[j].y) * rstd * g.z; x.w = bfhi(pw[j].y) * ri * gi.w + bfhi(hw[j].y) * rstd * g.w;
                if (MODE == 2) *(f32x4*)(xout + (size_t)row * DM + lo4 + 256 * j) = x;
                else ss2 += x.x * x.x + x.y * x.y + x.z * x.z + x.w * x.w;
                if (j & 1) __builtin_amdgcn_sched_barrier(0); }
            if (MODE == 1) {
                const float rstd2 = rsqrtf(wave_sum(ss2) * (1.f / DM) + EPS);
                if (lane == 0) rs_out[row] = rstd2;
                LAUNDER_ROW(pw, hw);
                float ri2 = ri, rstdb = rstd; asm volatile("" : "+v"(ri2), "+v"(rstdb) :: "memory");
#pragma unroll
                for (int j = 0; j < 16; ++j) { const f32x4 g = *(const LAS f32x4*)(GP + lo4 + 256 * j), gi = *(const LAS f32x4*)(GI + lo4 + 256 * j), gn = *(const LAS f32x4*)(GN + lo4 + 256 * j);
                    f32x4 x;
                    x.x = bflo(pw[j].x) * ri2 * gi.x + bflo(hw[j].x) * rstdb * g.x; x.y = bfhi(pw[j].x) * ri2 * gi.y + bfhi(hw[j].x) * rstdb * g.y;
                    x.z = bflo(pw[j].y) * ri2 * gi.z + bflo(hw[j].y) * rstdb * g.z; x.w = bfhi(pw[j].y) * ri2 * gi.w + bfhi(hw[j].y) * rstdb * g.w;
                    v2u w; w.x = pk2(x.x * rstd2 * gn.x, x.y * rstd2 * gn.y); w.y = pk2(x.z * rstd2 * gn.z, x.w * rstd2 * gn.w);
                    *(v2u*)(pw_out + lo4 + 256 * j) = w;
                    if (j & 1) __builtin_amdgcn_sched_barrier(0); }
            }
        }
    }
}

__device__ __forceinline__ void gates_minigemm(unsigned char* ws, LAS unsigned char* lds, int bx, int G, int tid, int wave, int lane) {
    const bf16* XNp = (const bf16*)(ws + WS_XN); const bf16* WG = (const bf16*)(ws + WS_W + WO_MAIN) + (size_t)8192 * DM; float* GT = (float*)(ws + WS_GATES);
    LAS f32x4* RED = (LAS f32x4*)lds;
#pragma unroll 1
    for (int blk = bx; blk < SEQ / 32; blk += G) {
        asm volatile("" : "+v"(lane));
        const int fr = lane & 15, fq = lane >> 4;
        const int t0 = 32 * blk;
        f32x4 acc[2][2];
#pragma unroll
        for (int a = 0; a < 2; ++a)
#pragma unroll
            for (int b = 0; b < 2; ++b) acc[a][b] = (f32x4){0.f, 0.f, 0.f, 0.f};
        const int lo = fr * DM + 8 * fq;
        const bf16* ap = (XNp + (size_t)t0 * DM + wave * 512) + lo; const bf16* bp = (WG + wave * 512) + lo;
#pragma unroll 4
        for (int ks = 0; ks < 16; ++ks) {
            const bf16x8 a0 = *(const bf16x8*)(ap + 32 * ks), a1 = *(const bf16x8*)(ap + (size_t)16 * DM + 32 * ks);
            const bf16x8 b0 = *(const bf16x8*)(bp + 32 * ks), b1 = *(const bf16x8*)(bp + (size_t)16 * DM + 32 * ks);
            acc[0][0] = mma(b0, a0, acc[0][0]); acc[0][1] = mma(b1, a0, acc[0][1]); acc[1][0] = mma(b0, a1, acc[1][0]); acc[1][1] = mma(b1, a1, acc[1][1]);
        }
        __syncthreads();
#pragma unroll
        for (int a = 0; a < 2; ++a)
#pragma unroll
            for (int b = 0; b < 2; ++b) RED[(wave * 4 + a * 2 + b) * 64 + lane] = acc[a][b];
        __syncthreads();
        if (tid < 256) { const int tile = tid >> 6, l = tid & 63, rt = tile >> 1, ct = tile & 1; f32x4 s = {0.f, 0.f, 0.f, 0.f};
#pragma unroll
            for (int w = 0; w < 8; ++w) s = s + RED[(w * 4 + tile) * 64 + l];
            *(f32x4*)(GT + (size_t)(t0 + 16 * rt + (l & 15)) * 32 + 16 * ct + 4 * (l >> 4)) = s; }
    }
}

__device__ __forceinline__ float scan_sum(float x, int lane) {
#pragma unroll
    for (int o = 1; o < 64; o <<= 1) { const float y = __shfl_up(x, o); if (lane >= o) x += y; }
    return x;
}
__device__ __forceinline__ float scan_max(float x, int lane) {
#pragma unroll
    for (int o = 1; o < 64; o <<= 1) { const float y = __shfl_up(x, o); if (lane >= o) x = fmaxf(x, y); }
    return x;
}
__device__ __forceinline__ void mlstm_local(const float* gates, float* mls, float bi, float bfb, int h, int c, int lane, LAS float* stash) {
    const int t = c * 64 + lane;
    const float mi = gates[(size_t)t * 32 + h], mf = gates[(size_t)t * 32 + 4 + h];
    const float li = 15.f * tanhf((mi + bi) * (1.f / 15.f)), fp = 15.f * tanhf((mf + bfb) * (1.f / 15.f));
    const float lf = logsig_acc(fp);
    const float bcum = scan_sum(lf, lane);
    const float a = li - bcum;
    const float pm = scan_max(a, lane);
    mls[MLS_A + h * SEQ + t] = a; mls[MLS_PM + h * SEQ + t] = pm; mls[MLS_BC + h * SEQ + t] = bcum;
    if (lane == 63) { mls[MLS_CHB + h * NCH + c] = bcum; mls[MLS_CHP + h * NCH + c] = pm; stash[64] = pm; stash[65] = bcum; }
    stash[lane] = a;
}

constexpr int TL = 264;
constexpr int NPAIR = 64;
__device__ __forceinline__ void gla_g_chunk(const Args& args, const float* gates, float* G, LAS float* GS, LAS float* GRS, int c, int head, int tid) {
    if (tid < 256) { const int t = tid >> 2, r4 = (tid & 3) * 4; *(LAS f32x4*)(GRS + t * 16 + r4) = *(const f32x4*)(gates + (size_t)(c * 64 + t) * 32 + 8 + r4); }
    __syncthreads();
    const int d = tid & 255, half = tid >> 8, col = head * 256 + d;
    float w[16];
#pragma unroll
    for (int r = 0; r < 16; ++r) w[r] = args.in[8][r * 1024 + col];
    const float b = args.in[9][col];
    float acc = 0.f;
#pragma unroll 4
    for (int tt = 0; tt < 32; ++tt) { const int t = 32 * half + tt;
        float z = b;
#pragma unroll
        for (int q4 = 0; q4 < 4; ++q4) { const f32x4 g4 = *(const LAS f32x4*)(GRS + t * 16 + 4 * q4); z += g4.x * w[4 * q4] + g4.y * w[4 * q4 + 1] + g4.z * w[4 * q4 + 2] + g4.w * w[4 * q4 + 3]; }
        acc += (fminf(z, 0.f) - 0.6931471805599453f * flog2(1.f + fexp2(-1.4426950408889634f * fabsf(z)))) * 0.0625f;
        GS[t * 256 + d] = acc; }
    __syncthreads();
    const float add = half ? GS[31 * 256 + d] : 0.f;
#pragma unroll 4
    for (int tt = 0; tt < 32; ++tt) { const int t = 32 * half + tt; const float gv = GS[t * 256 + d] + add;
        if (half) GS[t * 256 + d] = gv;
        G[(size_t)(c * 64 + t) * 1024 + col] = gv; }
    __syncthreads();
}
__device__ __forceinline__ void dc_unit(const Args& args, unsigned char* ws, LAS unsigned char* lds, int u, int tid, int wave, int lane) {
    asm volatile("" : "+v"(lane), "+v"(tid));
    const int mixer = u >> 8, pair = (u >> 2) & 63, head = u & 3;
    const bf16* PROJ = (const bf16*)(ws + WS_PROJ); const bf16* VT = (const bf16*)(ws + WS_VT);
    const float* gates = (const float*)(ws + WS_GATES);
    LAS bf16* KS = (LAS bf16*)lds;
    LAS float* GS = (LAS float*)(lds + 68608);
    LAS float* GRS = (LAS float*)(lds + 137216);
    LAS float* GLB = (LAS float*)(lds + 141312);
    const int kcol = (mixer ? 5120 : 1024) + head * 256;
    const int tok0 = 128 * pair;
    __syncthreads();
    if (mixer == 0) {
        if (wave < 2) mlstm_local(gates, (float*)(ws + WS_MLS), args.in[5][head], args.in[6][head], head, 2 * pair + wave, lane, GS + 128 * wave);
        __syncthreads();
        const float blA = GS[65], pmP = fmaxf(GS[64], GS[128 + 64] - blA);
#pragma unroll
        for (int i = 0; i < 8; ++i) {
            const int q = tid + 512 * i, s = q >> 5, d0 = (q & 31) * 8;
            const v4u kw = *(const v4u*)(PROJ + (size_t)(tok0 + s) * 8192 + kcol + d0);
            const float aa = (s < 64) ? GS[s] : (GS[128 + s - 64] - blA);
            const float w = fexp2(1.4426950408889634f * (aa - pmP)) * 0.0625f;
            v4u o; o.x = pk2(bflo(kw.x) * w, bfhi(kw.x) * w); o.y = pk2(bflo(kw.y) * w, bfhi(kw.y) * w); o.z = pk2(bflo(kw.z) * w, bfhi(kw.z) * w); o.w = pk2(bflo(kw.w) * w, bfhi(kw.w) * w);
            *(LAS v4u*)(KS + s * TL + d0) = o;
        }
    } else {
        float* G = (float*)(ws + WS_GG);
        gla_g_chunk(args, gates, G, GS, GRS, 2 * pair + 1, head, tid);
        if (tid < 256) GLB[tid] = GS[63 * 256 + tid];
#pragma unroll
        for (int i = 0; i < 4; ++i) {
            const int q = tid + 512 * i, s = q >> 5, d0 = (q & 31) * 8;
            const v4u kw = *(const v4u*)(PROJ + (size_t)(tok0 + 64 + s) * 8192 + kcol + d0);
            const f32x4 a0 = *(const LAS f32x4*)(GS + 63 * 256 + d0), a1 = *(const LAS f32x4*)(GS + 63 * 256 + d0 + 4), b0 = *(const LAS f32x4*)(GS + s * 256 + d0), b1 = *(const LAS f32x4*)(GS + s * 256 + d0 + 4);
            v4u o; o.x = pk2(bflo(kw.x) * __expf(a0.x - b0.x), bfhi(kw.x) * __expf(a0.y - b0.y)); o.y = pk2(bflo(kw.y) * __expf(a0.z - b0.z), bfhi(kw.y) * __expf(a0.w - b0.w));
            o.z = pk2(bflo(kw.z) * __expf(a1.x - b1.x), bfhi(kw.z) * __expf(a1.y - b1.y)); o.w = pk2(bflo(kw.w) * __expf(a1.z - b1.z), bfhi(kw.w) * __expf(a1.w - b1.w));
            *(LAS v4u*)(KS + (64 + s) * TL + d0) = o;
        }
        __syncthreads();
        gla_g_chunk(args, gates, G, GS, GRS, 2 * pair, head, tid);
#pragma unroll
        for (int i = 0; i < 4; ++i) {
            const int q = tid + 512 * i, s = q >> 5, d0 = (q & 31) * 8;
            const v4u kw = *(const v4u*)(PROJ + (size_t)(tok0 + s) * 8192 + kcol + d0);
            const f32x4 a0 = *(const LAS f32x4*)(GS + 63 * 256 + d0), a1 = *(const LAS f32x4*)(GS + 63 * 256 + d0 + 4), b0 = *(const LAS f32x4*)(GS + s * 256 + d0), b1 = *(const LAS f32x4*)(GS + s * 256 + d0 + 4);
            const f32x4 c0 = *(const LAS f32x4*)(GLB + d0), c1 = *(const LAS f32x4*)(GLB + d0 + 4);
            v4u o; o.x = pk2(bflo(kw.x) * __expf(a0.x - b0.x + c0.x), bfhi(kw.x) * __expf(a0.y - b0.y + c0.y)); o.y = pk2(bflo(kw.y) * __expf(a0.z - b0.z + c0.z), bfhi(kw.y) * __expf(a0.w - b0.w + c0.w));
            o.z = pk2(bflo(kw.z) * __expf(a1.x - b1.x + c1.x), bfhi(kw.z) * __expf(a1.y - b1.y + c1.y)); o.w = pk2(bflo(kw.w) * __expf(a1.z - b1.z + c1.z), bfhi(kw.w) * __expf(a1.w - b1.w + c1.w));
            *(LAS v4u*)(KS + s * TL + d0) = o;
        }
    }
    __syncthreads();
    const int fr = lane & 15, fq = lane >> 4;
    bf16* ST = (bf16*)(ws + WS_STATE) + ((size_t)((mixer * 4 + head) * NPAIR + pair)) * (512 * 256);
    const int vrow0 = mixer * 2048 + head * 512 + wave * 64;
    LAS bf16* OS = (LAS bf16*)(lds + 68608 + wave * 8448);
#pragma unroll 1
    for (int vt = 0; vt < 4; ++vt) {
        const bf16* vp = (VT + (size_t)(vrow0 + 16 * vt) * 8192 + tok0) + (fr * 8192 + 8 * fq);
        const bf16x8 b0 = *(const bf16x8*)vp, b1 = *(const bf16x8*)(vp + 32), b2 = *(const bf16x8*)(vp + 64), b3 = *(const bf16x8*)(vp + 96);
#pragma unroll 4
        for (int dt = 0; dt < 16; ++dt) {
            f32x4 acc = {0.f, 0.f, 0.f, 0.f};
            acc = mma(tr_frag(KS + 16 * dt, TL, lane), b0, acc); acc = mma(tr_frag(KS + 32 * TL + 16 * dt, TL, lane), b1, acc);
            acc = mma(tr_frag(KS + 64 * TL + 16 * dt, TL, lane), b2, acc); acc = mma(tr_frag(KS + 96 * TL + 16 * dt, TL, lane), b3, acc);
            v2u w; w.x = pk2(acc[0], acc[1]); w.y = pk2(acc[2], acc[3]);
            *(LAS v2u*)(OS + fr * 264 + 16 * dt + 4 * fq) = w;
        }
        LDS_WAIT(); asm volatile("" ::: "memory");
        bf16* op = ST + (size_t)(wave * 64 + 16 * vt) * 256;
#pragma unroll
        for (int i = 0; i < 8; ++i) { const int rr = 2 * i + (lane >> 5), cc = (lane & 31) * 8;
            *(v4u*)(op + rr * 256 + cc) = *(const LAS v4u*)(OS + rr * 264 + cc); }
        LDS_WAIT(); asm volatile("" ::: "memory");
    }
    if (mixer == 0 && tid < 256) {
        float s = 0.f;
#pragma unroll 8
        for (int t = 0; t < 128; ++t) s += __uint_as_float((unsigned)KS[t * TL + tid] << 16);
        ((float*)(ws + WS_NST))[(size_t)(head * NPAIR + pair) * 256 + tid] = s;
    }
}

__device__ __forceinline__ void scan_phase(unsigned char* ws, int T0, int TS, bf16* dummy_out = nullptr) {
    const float* G = (const float*)(ws + WS_GG); const float* mls = (const float*)(ws + WS_MLS); float* mlsw = (float*)(ws + WS_MLS);
#pragma unroll 1
    for (int T = T0; T < 131072; T += TS) {
        const int mixer = T >> 16, head = (T >> 14) & 3, v = (T >> 5) & 511, d0 = (T & 31) * 8;
        bf16* base = (bf16*)(ws + WS_STATE) + ((size_t)((mixer * 4 + head) * NPAIR)) * (512 * 256) + (size_t)v * 256 + d0;
        float C[8]; float mrun = 0.f;
#pragma unroll
        for (int e = 0; e < 8; ++e) C[e] = 0.f;
#pragma unroll 1
        for (int p0 = 0; p0 < NPAIR; p0 += 8) {
            v4u x[8]; float dec[8][8]; float cor[8] = {1.f, 1.f, 1.f, 1.f, 1.f, 1.f, 1.f, 1.f};
#pragma unroll
            for (int i = 0; i < 8; ++i) x[i] = *(const v4u*)(base + (size_t)(p0 + i) * (512 * 256));
#pragma unroll
            for (int i = 0; i < 8; ++i) { const int cA = 2 * (p0 + i);
                if (mixer == 0) { const float blA = mls[MLS_CHB + head * NCH + cA], blB = mls[MLS_CHB + head * NCH + cA + 1];
                    const float pmP = fmaxf(mls[MLS_CHP + head * NCH + cA], mls[MLS_CHP + head * NCH + cA + 1] - blA), m63 = fmaxf(pmP, mrun);
                    const float dd = __expf(mrun - m63); cor[i] = __expf(pmP - m63);
                    if (v == 0 && d0 == 0 && !dummy_out) mlsw[MLS_MC + head * NCH + p0 + i] = mrun;
                    mrun = (blA + blB) + m63;
#pragma unroll
                    for (int e = 0; e < 8; ++e) dec[i][e] = dd; }
                else { const float* ga = G + (size_t)(cA * 64 + 63) * 1024 + head * 256 + d0; const float* gb = ga + (size_t)64 * 1024;
                    const f32x4 a0 = *(const f32x4*)ga, a1 = *(const f32x4*)(ga + 4), b0 = *(const f32x4*)gb, b1 = *(const f32x4*)(gb + 4);
                    dec[i][0] = __expf(a0.x + b0.x); dec[i][1] = __expf(a0.y + b0.y); dec[i][2] = __expf(a0.z + b0.z); dec[i][3] = __expf(a0.w + b0.w);
                    dec[i][4] = __expf(a1.x + b1.x); dec[i][5] = __expf(a1.y + b1.y); dec[i][6] = __expf(a1.z + b1.z); dec[i][7] = __expf(a1.w + b1.w); }
            }
#pragma unroll
            for (int i = 0; i < 8; ++i) {
                v4u o; o.x = pk2(C[0], C[1]); o.y = pk2(C[2], C[3]); o.z = pk2(C[4], C[5]); o.w = pk2(C[6], C[7]);
                *(v4u*)((dummy_out ? dummy_out + (base - (bf16*)(ws + WS_STATE)) : base) + (size_t)(p0 + i) * (512 * 256)) = o;
                C[0] = dec[i][0] * C[0] + cor[i] * bflo(x[i].x); C[1] = dec[i][1] * C[1] + cor[i] * bfhi(x[i].x); C[2] = dec[i][2] * C[2] + cor[i] * bflo(x[i].y); C[3] = dec[i][3] * C[3] + cor[i] * bfhi(x[i].y);
                C[4] = dec[i][4] * C[4] + cor[i] * bflo(x[i].z); C[5] = dec[i][5] * C[5] + cor[i] * bfhi(x[i].z); C[6] = dec[i][6] * C[6] + cor[i] * bflo(x[i].w); C[7] = dec[i][7] * C[7] + cor[i] * bfhi(x[i].w);
            }
        }
    }
    if (!dummy_out) for (int T = T0; T < 1024; T += TS) {
        const int head = T >> 8, d = T & 255; float* np = (float*)(ws + WS_NST) + (size_t)head * NPAIR * 256 + d; float n = 0.f, mrun = 0.f;
#pragma unroll 1
        for (int p = 0; p < NPAIR; ++p) { const float x = np[p * 256]; np[p * 256] = n;
            const float blA = mls[MLS_CHB + head * NCH + 2 * p], blB = mls[MLS_CHB + head * NCH + 2 * p + 1];
            const float pmP = fmaxf(mls[MLS_CHP + head * NCH + 2 * p], mls[MLS_CHP + head * NCH + 2 * p + 1] - blA), m63 = fmaxf(pmP, mrun);
            n = __expf(mrun - m63) * n + __expf(pmP - m63) * x; mrun = (blA + blB) + m63; }
    }
}

constexpr int PLP = 136;
constexpr int HTP = 516;
__device__ __forceinline__ int mixout_chunk(int u) { int c = (u >> 2) & 127; c = (c & ~3) | ((c & 1) << 1) | ((c >> 1) & 1); return c ^ (c >> 6); }
template <bool ODD>
__device__ __forceinline__ void mixout_unit(const Args& args, unsigned char* ws, LAS unsigned char* lds, int u, int tid, int wave, int lane) {
    asm volatile("" : "+v"(lane), "+v"(tid));
    constexpr int NK = ODD ? 128 : 64, KOFF = ODD ? 64 : 0, NST2 = NK / 32;
    const int mixer = u >> 9, chunk = mixout_chunk(u), head = u & 3, pair = chunk >> 1;
    const bf16* PROJ = (const bf16*)(ws + WS_PROJ); const bf16* VT = (const bf16*)(ws + WS_VT);
    const float* G = (const float*)(ws + WS_GG); const float* mls = (const float*)(ws + WS_MLS);
    LAS bf16* KS = (LAS bf16*)lds; LAS bf16* QS = (LAS bf16*)(lds + 67584); LAS bf16* PS = (LAS bf16*)(lds + 101376);
    LAS float* HT = (LAS float*)lds;
    LAS float* RDEN = (LAS float*)(lds + 132096); LAS float* SSQ = (LAS float*)(lds + 132352); LAS float* NPREV = (LAS float*)(lds + 134400); LAS float* RSTD = (LAS float*)(lds + 135424);
    const int qcol = (mixer ? 4096 : 0) + head * 256, kcol = (mixer ? 5120 : 1024) + head * 256;
    const int fr = lane & 15, fq = lane >> 4;
    const int tok0 = chunk * 64, tokK0 = tok0 - KOFF;
    float mc = 0.f, minter = 0.f, blA = 0.f;
    if (mixer == 0) { const float mp = mls[MLS_MC + head * NCH + pair];
        if (ODD) { blA = mls[MLS_CHB + head * NCH + chunk - 1]; mc = blA + fmaxf(mls[MLS_CHP + head * NCH + chunk - 1], mp); minter = blA + mp; } else { mc = mp; minter = mp; } }
    __syncthreads();
#pragma unroll
    for (int i = 0; i < 4; ++i) {
        const int q = tid + 512 * i, s = q >> 5, d0 = (q & 31) * 8;
        const v4u kw = *(const v4u*)(PROJ + (size_t)(tok0 + s) * 8192 + kcol + d0);
        const v4u qw = *(const v4u*)(PROJ + (size_t)(tok0 + s) * 8192 + qcol + d0);
        float sk[8], sq[8];
        if (mixer == 0) {
#pragma unroll
            for (int e = 0; e < 8; ++e) { sk[e] = 0.0625f; sq[e] = 1.f; } }
        else { const float* gs = G + (size_t)(tok0 + s) * 1024 + head * 256 + d0; const f32x4 b0 = *(const f32x4*)gs, b1 = *(const f32x4*)(gs + 4);
            const float gg[8] = {b0.x, b0.y, b0.z, b0.w, b1.x, b1.y, b1.z, b1.w};
#pragma unroll
            for (int e = 0; e < 8; ++e) { sq[e] = __expf(gg[e]) * 0.0625f; sk[e] = __expf(-gg[e]); } }
        v4u o; o.x = pk2(bflo(kw.x) * sk[0], bfhi(kw.x) * sk[1]); o.y = pk2(bflo(kw.y) * sk[2], bfhi(kw.y) * sk[3]);
        o.z = pk2(bflo(kw.z) * sk[4], bfhi(kw.z) * sk[5]); o.w = pk2(bflo(kw.w) * sk[6], bfhi(kw.w) * sk[7]);
        *(LAS v4u*)(KS + (KOFF + s) * TL + d0) = o;
        v4u p; p.x = pk2(bflo(qw.x) * sq[0], bfhi(qw.x) * sq[1]); p.y = pk2(bflo(qw.y) * sq[2], bfhi(qw.y) * sq[3]);
        p.z = pk2(bflo(qw.z) * sq[4], bfhi(qw.z) * sq[5]); p.w = pk2(bflo(qw.w) * sq[6], bfhi(qw.w) * sq[7]);
        *(LAS v4u*)(QS + s * TL + d0) = p;
        if (ODD) {
            const v4u cw = *(const v4u*)(PROJ + (size_t)(tokK0 + s) * 8192 + kcol + d0);
            float sc[8];
            if (mixer == 0) {
#pragma unroll
                for (int e = 0; e < 8; ++e) sc[e] = 0.0625f; }
            else { const float* gl = G + (size_t)(tokK0 + 63) * 1024 + head * 256 + d0; const float* gs2 = G + (size_t)(tokK0 + s) * 1024 + head * 256 + d0;
                const f32x4 a0 = *(const f32x4*)gl, a1 = *(const f32x4*)(gl + 4), b0 = *(const f32x4*)gs2, b1 = *(const f32x4*)(gs2 + 4);
                sc[0] = __expf(a0.x - b0.x); sc[1] = __expf(a0.y - b0.y); sc[2] = __expf(a0.z - b0.z); sc[3] = __expf(a0.w - b0.w);
                sc[4] = __expf(a1.x - b1.x); sc[5] = __expf(a1.y - b1.y); sc[6] = __expf(a1.z - b1.z); sc[7] = __expf(a1.w - b1.w); }
            v4u c4; c4.x = pk2(bflo(cw.x) * sc[0], bfhi(cw.x) * sc[1]); c4.y = pk2(bflo(cw.y) * sc[2], bfhi(cw.y) * sc[3]);
            c4.z = pk2(bflo(cw.z) * sc[4], bfhi(cw.z) * sc[5]); c4.w = pk2(bflo(cw.w) * sc[6], bfhi(cw.w) * sc[7]);
            *(LAS v4u*)(KS + s * TL + d0) = c4;
        }
    }
    if (mixer == 0 && tid < 256) NPREV[tid] = ((const float*)(ws + WS_NST))[(size_t)(head * NPAIR + pair) * 256 + tid];
    __syncthreads();
    {
        const int tt = wave >> 1;
        const bool cross = ODD && ((wave & 1) == 0);
#pragma unroll
        for (int h2 = 0; h2 < NST2; ++h2) {
            const int st = NST2 * (wave & 1) + h2;
            f32x4 acc = {0.f, 0.f, 0.f, 0.f};
#pragma unroll
            for (int ks = 0; ks < 8; ++ks) {
                const bf16x8 a = *(const LAS bf16x8*)(KS + (16 * st + fr) * TL + 32 * ks + 8 * fq);
                const bf16x8 b = *(const LAS bf16x8*)(QS + (16 * tt + fr) * TL + 32 * ks + 8 * fq);
                acc = mma(a, b, acc);
            }
            const int t = 16 * tt + fr, r0 = 16 * st + 4 * fq;
            float f[4] = {1.f, 1.f, 1.f, 1.f};
            if (mixer == 0) { const float Mt = fmaxf(mls[MLS_PM + head * SEQ + tok0 + t], mc); const f32x4 av = *(const f32x4*)(mls + MLS_A + head * SEQ + tokK0 + r0);
                const float off = cross ? blA - Mt : -Mt;
                f[0] = __expf(av.x + off); f[1] = __expf(av.y + off); f[2] = __expf(av.z + off); f[3] = __expf(av.w + off); }
            float pv[4];
#pragma unroll
            for (int r = 0; r < 4; ++r) pv[r] = (cross || (r0 - KOFF + r <= t)) ? acc[r] * f[r] : 0.f;
            v2u w; w.x = pk2(pv[0], pv[1]); w.y = pk2(pv[2], pv[3]);
            *(LAS v2u*)(PS + t * PLP + r0) = w;
        }
    }
    __syncthreads();
    if (wave == 0) {
        float rd = 1.f;
        if (mixer == 0) {
            const int t = lane; float di = 0.f, qn = 0.f;
#pragma unroll 8
            for (int s = 0; s < NK; ++s) di += __uint_as_float((unsigned)PS[t * PLP + s] << 16);
#pragma unroll 8
            for (int d = 0; d < 256; ++d) qn += __uint_as_float((unsigned)QS[t * TL + d] << 16) * NPREV[d];
            const float Mt = fmaxf(mls[MLS_PM + head * SEQ + tok0 + t], mc);
            const float den = di + __expf(minter - Mt) * qn;
            rd = 1.f / fmaxf(fabsf(den), __expf(-(mls[MLS_BC + head * SEQ + tok0 + t] + Mt)));
        }
        RDEN[lane] = rd;
    }
    f32x4 acc[4][4];
#pragma unroll
    for (int a = 0; a < 4; ++a)
#pragma unroll
        for (int b = 0; b < 4; ++b) acc[a][b] = (f32x4){0.f, 0.f, 0.f, 0.f};
    const bf16* ST = (const bf16*)(ws + WS_STATE) + ((size_t)((mixer * 4 + head) * NPAIR + pair)) * (512 * 256);
#pragma unroll
    for (int vt = 0; vt < 4; ++vt) {
        bf16x8 af[8];
        const bf16* sp = (ST + (size_t)(wave * 64 + 16 * vt) * 256) + (fr * 256 + 8 * fq);
#pragma unroll
        for (int ks = 0; ks < 8; ++ks) af[ks] = *(const bf16x8*)(sp + 32 * ks);
        if (ODD && mixer == 1) {
            const float* gl = G + (size_t)(tokK0 + 63) * 1024 + head * 256 + 8 * fq;
#pragma unroll
            for (int ks = 0; ks < 8; ++ks) { const f32x4 e0 = *(const f32x4*)(gl + 32 * ks), e1 = *(const f32x4*)(gl + 32 * ks + 4);
                const v4u w = __builtin_bit_cast(v4u, af[ks]);
                v4u o; o.x = pk2(bflo(w.x) * __expf(e0.x), bfhi(w.x) * __expf(e0.y)); o.y = pk2(bflo(w.y) * __expf(e0.z), bfhi(w.y) * __expf(e0.w));
                o.z = pk2(bflo(w.z) * __expf(e1.x), bfhi(w.z) * __expf(e1.y)); o.w = pk2(bflo(w.w) * __expf(e1.z), bfhi(w.w) * __expf(e1.w));
                af[ks] = u4_as_frag(o); }
        }
#pragma unroll
        for (int tt = 0; tt < 4; ++tt)
#pragma unroll
            for (int ks = 0; ks < 8; ++ks) {
                const bf16x8 b = *(const LAS bf16x8*)(QS + (16 * tt + fr) * TL + 32 * ks + 8 * fq);
                acc[vt][tt] = mma(af[ks], b, acc[vt][tt]);
            }
    }
    if (mixer == 0) {
#pragma unroll
        for (int tt = 0; tt < 4; ++tt) { const float it = __expf(minter - fmaxf(mls[MLS_PM + head * SEQ + tok0 + 16 * tt + fr], mc));
#pragma unroll
            for (int vt = 0; vt < 4; ++vt) acc[vt][tt] = acc[vt][tt] * it; }
    }
    const int vrow0 = mixer * 2048 + head * 512 + wave * 64;
#pragma unroll
    for (int vt = 0; vt < 4; ++vt) {
        const bf16* vp = (VT + (size_t)(vrow0 + 16 * vt) * 8192 + tokK0) + (fr * 8192 + 8 * fq);
        bf16x8 a[NK / 32];
#pragma unroll
        for (int ks = 0; ks < NK / 32; ++ks) a[ks] = *(const bf16x8*)(vp + 32 * ks);
#pragma unroll
        for (int tt = 0; tt < 4; ++tt)
#pragma unroll
            for (int ks = 0; ks < NK / 32; ++ks)
                acc[vt][tt] = mma(a[ks], *(const LAS bf16x8*)(PS + (16 * tt + fr) * PLP + 32 * ks + 8 * fq), acc[vt][tt]);
    }
    __syncthreads();
#pragma unroll
    for (int tt = 0; tt < 4; ++tt) {
        const float rd = RDEN[16 * tt + fr]; float q = 0.f;
#pragma unroll
        for (int vt = 0; vt < 4; ++vt) { acc[vt][tt] = acc[vt][tt] * rd; q += acc[vt][tt][0] * acc[vt][tt][0] + acc[vt][tt][1] * acc[vt][tt][1] + acc[vt][tt][2] * acc[vt][tt][2] + acc[vt][tt][3] * acc[vt][tt][3];
            *(LAS f32x4*)(HT + (16 * tt + fr) * HTP + wave * 64 + 16 * vt + 4 * fq) = acc[vt][tt]; }
        q += __shfl_xor(q, 16); q += __shfl_xor(q, 32);
        if (fq == 0) SSQ[wave * 64 + 16 * tt + fr] = q;
    }
    __syncthreads();
    if (tid < 64) { float tot = 0.f;
#pragma unroll
        for (int w = 0; w < 8; ++w) tot += SSQ[w * 64 + tid];
        RSTD[tid] = rsqrtf(tot * (1.f / 512.f) + EPS); }
    __syncthreads();
    const float* hn = args.in[mixer ? 10 : 7] + head * 512;
    const bf16* gp = PROJ + (size_t)tok0 * 8192 + (mixer ? 6144 : 2048) + head * 512;
    bf16* hc = (bf16*)(ws + WS_HC) + (size_t)tok0 * DM + mixer * 2048 + head * 512;
#pragma unroll
    for (int i = 0; i < 8; ++i) {
        const int it = tid + NTHREADS * i, t = it >> 6, v0 = (it & 63) * 8;
        const f32x4 h0 = *(const LAS f32x4*)(HT + t * HTP + v0), h1 = *(const LAS f32x4*)(HT + t * HTP + v0 + 4);
        const f32x4 n0 = *(const f32x4*)(hn + v0), n1 = *(const f32x4*)(hn + v0 + 4);
        const v4u gw4 = *(const v4u*)(gp + (size_t)t * 8192 + v0);
        const float rstd = RSTD[t];
        float gt[8] = {bflo(gw4.x), bfhi(gw4.x), bflo(gw4.y), bfhi(gw4.y), bflo(gw4.z), bfhi(gw4.z), bflo(gw4.w), bfhi(gw4.w)};
#pragma unroll
        for (int r = 0; r < 8; ++r) { const float sg = sigmoid_fast(gt[r]); gt[r] = mixer ? gt[r] * sg : sg; }
        v4u w; w.x = pk2(h0[0] * rstd * n0[0] * gt[0], h0[1] * rstd * n0[1] * gt[1]); w.y = pk2(h0[2] * rstd * n0[2] * gt[2], h0[3] * rstd * n0[3] * gt[3]);
        w.z = pk2(h1[0] * rstd * n1[0] * gt[4], h1[1] * rstd * n1[1] * gt[5]); w.w = pk2(h1[2] * rstd * n1[2] * gt[6], h1[3] * rstd * n1[3] * gt[7]);
        *(v4u*)(hc + (size_t)t * DM + v0) = w;
    }
}

constexpr int SBK_P = 136, SBV_P = 72;
constexpr int SB_KS = 0, SB_VS = 17408, SB_BUF = 35840, SB_FLAGS = 8 * 16640;
__device__ __forceinline__ void stickbreak_phase(const Args& args, unsigned char* ws, LAS unsigned char* lds, int bx, int G, int tid, int wave, int lane) {
    const bf16* QK = (const bf16*)(ws + WS_PROJ); const bf16* VT = (const bf16*)(ws + WS_VT); bf16* HC = (bf16*)(ws + WS_HC);
    const float scale = 0.08838834764831845f * 1.4426950408889634f;
    volatile LAS int* FLAGS = (volatile LAS int*)(lds + SB_FLAGS);
    int iu = 0;
#pragma unroll 1
    for (int U = bx; U < 2048; U += G, ++iu) {
        asm volatile("" : "+v"(lane), "+v"(tid));
        const int fr = lane & 15, fq = lane >> 4;
        const bool rider = RIDER_ON && (G == 256) && (iu < 4);
        f32x4 rv[16]; Seg rsg; int rkb = 0, rnb = 0;
        if (rider) { const int gi = iu * 2048 + bx * NWAVES + wave; const int sI = gi < 4096 ? SEG_SB : SEG_SB + 1 + ((gi - 4096) >> 10); const int it = gi < 4096 ? gi : ((gi - 4096) & 1023);
            rsg = seg_at(sI); const int nblk = rsg.ncols / 64; rkb = it / nblk; rnb = it - rkb * nblk;
            tr_load(args.in[rsg.in_idx] + (size_t)rsg.src_l * rsg.K * rsg.N + (size_t)(64 * rkb) * rsg.N + rsg.scol + 64 * rnb, rsg.N, rv, lane); }
        const int kr0 = tid >> 4, kc0 = (tid & 15) * 8;
        const int vr0 = tid >> 3, vc0 = (tid & 7) * 8;
        const int head = U & 31, Q0 = (U >> 5) * 128, q0 = Q0 + 16 * wave, t = q0 + fr;
        bf16x8 qf[4];
#pragma unroll
        for (int ks = 0; ks < 4; ++ks) qf[ks] = *(const bf16x8*)(QK + (size_t)(q0 + fr) * 8192 + head * 128 + 32 * ks + 8 * fq);
        f32x4 o[8];
#pragma unroll
        for (int dt = 0; dt < 8; ++dt) o[dt] = (f32x4){0.f, 0.f, 0.f, 0.f};
        float carry = 0.f; bool done = false;
        const bf16* kg = QK + 4096 + head * 128 + kc0; const bf16* vg = VT + (size_t)(head * 128) * 8192 + vc0;
        const int KB0 = Q0 + 64;
        v4u kreg[2], vreg[2];
        kreg[0] = *(const v4u*)(kg + (size_t)(KB0 + kr0) * 8192); kreg[1] = *(const v4u*)(kg + (size_t)(KB0 + kr0 + 32) * 8192);
        vreg[0] = *(const v4u*)(vg + (size_t)vr0 * 8192 + KB0); vreg[1] = *(const v4u*)(vg + (size_t)(vr0 + 64) * 8192 + KB0);
        __syncthreads();
        { LAS bf16* KS = (LAS bf16*)(lds + SB_KS); LAS bf16* VS = (LAS bf16*)(lds + SB_VS);
          *(LAS v4u*)(KS + kr0 * SBK_P + kc0) = kreg[0]; *(LAS v4u*)(KS + (kr0 + 32) * SBK_P + kc0) = kreg[1];
          *(LAS v4u*)(VS + vr0 * SBV_P + vc0) = vreg[0]; *(LAS v4u*)(VS + (vr0 + 64) * SBV_P + vc0) = vreg[1]; }
        __syncthreads();
#pragma unroll 1
        for (int j = 0;; ++j) {
            const int kb = KB0 - 64 * j; const bool has_next = kb >= 64;
            if (has_next) { const int kn = kb - 64;
                kreg[0] = *(const v4u*)(kg + (size_t)(kn + kr0) * 8192); kreg[1] = *(const v4u*)(kg + (size_t)(kn + kr0 + 32) * 8192);
                vreg[0] = *(const v4u*)(vg + (size_t)vr0 * 8192 + kn); vreg[1] = *(const v4u*)(vg + (size_t)(vr0 + 64) * 8192 + kn); }
            const LAS bf16* KS = (const LAS bf16*)(lds + (j & 1) * SB_BUF + SB_KS); const LAS bf16* VS = (const LAS bf16*)(lds + (j & 1) * SB_BUF + SB_VS);
            if (!done && kb <= q0 + 15) {
                f32x4 sa[4];
#pragma unroll
                for (int i = 0; i < 4; ++i) { sa[i] = (f32x4){0.f, 0.f, 0.f, 0.f};
#pragma unroll
                    for (int ks = 0; ks < 4; ++ks) sa[i] = mma(*(const LAS bf16x8*)(KS + (16 * i + fr) * SBK_P + 32 * ks + 8 * fq), qf[ks], sa[i]); }
                float l1[4][4], lb[4][4], Tl[4];
                if (kb + 63 >= q0) {
#pragma unroll
                    for (int i = 0; i < 4; ++i) {
#pragma unroll
                        for (int r = 0; r < 4; ++r) { const float z = sa[i][r] * scale; const float sp = fmaxf(z, 0.f) + flog2(1.f + fexp2(-fabsf(z)));
                            const bool valid = (kb + 16 * i + 4 * fq + r) < t; l1[i][r] = valid ? -sp : 0.f; lb[i][r] = valid ? (z - sp) : -1e30f; }
                        Tl[i] = (l1[i][0] + l1[i][1]) + (l1[i][2] + l1[i][3]);
                    }
                } else {
#pragma unroll
                    for (int i = 0; i < 4; ++i) {
#pragma unroll
                        for (int r = 0; r < 4; ++r) { const float z = sa[i][r] * scale; const float sp = fmaxf(z, 0.f) + flog2(1.f + fexp2(-fabsf(z)));
                            l1[i][r] = -sp; lb[i][r] = z - sp; }
                        Tl[i] = (l1[i][0] + l1[i][1]) + (l1[i][2] + l1[i][3]);
                    }
                }
                float run = carry; float att[4][4];
#pragma unroll
                for (int i = 3; i >= 0; --i) {
                    const float T = Tl[i];
                    const float pb = xor16f(T, fq), pc = xor32f(T, fq), pd = xor32f(pb, fq);
                    const float sg = fq == 0 ? (pb + pc) + pd : (fq == 1 ? pc + pd : (fq == 2 ? pb : 0.f));
                    const float tot = (T + pb) + (pc + pd);
                    const float e3 = run + sg, e2 = e3 + l1[i][3], e1 = e2 + l1[i][2], e0 = e1 + l1[i][1];
                    att[i][0] = fexp2(lb[i][0] + e0); att[i][1] = fexp2(lb[i][1] + e1); att[i][2] = fexp2(lb[i][2] + e2); att[i][3] = fexp2(lb[i][3] + e3);
                    run += tot;
                }
                carry = run;
                bf16x8 pf[2];
#pragma unroll
                for (int s2 = 0; s2 < 2; ++s2) { v4u w; w.x = pk2(att[2 * s2][0], att[2 * s2][1]); w.y = pk2(att[2 * s2][2], att[2 * s2][3]);
                    w.z = pk2(att[2 * s2 + 1][0], att[2 * s2 + 1][1]); w.w = pk2(att[2 * s2 + 1][2], att[2 * s2 + 1][3]); pf[s2] = u4_as_frag(w); }
#pragma unroll
                for (int dt = 0; dt < 8; ++dt) {
                    const LAS bf16* vp = VS + (16 * dt + fr) * SBV_P + 4 * fq;
#pragma unroll
                    for (int s2 = 0; s2 < 2; ++s2) { const s16x4 lo = *(const LAS s16x4*)(vp + 32 * s2), hi = *(const LAS s16x4*)(vp + 32 * s2 + 16);
                        o[dt] = mma(cat8(lo, hi), pf[s2], o[dt]); }
                }
                if (__all(carry < -127.f)) done = true;
            }
            if (lane == 0) FLAGS[(j & 1) * 8 + wave] = done ? 1 : 0;
            if (has_next) { LAS bf16* KN = (LAS bf16*)(lds + ((j + 1) & 1) * SB_BUF + SB_KS); LAS bf16* VN = (LAS bf16*)(lds + ((j + 1) & 1) * SB_BUF + SB_VS);
                *(LAS v4u*)(KN + kr0 * SBK_P + kc0) = kreg[0]; *(LAS v4u*)(KN + (kr0 + 32) * SBK_P + kc0) = kreg[1];
                *(LAS v4u*)(VN + vr0 * SBV_P + vc0) = vreg[0]; *(LAS v4u*)(VN + (vr0 + 64) * SBV_P + vc0) = vreg[1]; }
            __syncthreads();
            int nd = 0;
#pragma unroll
            for (int w8 = 0; w8 < 8; ++w8) nd += FLAGS[(j & 1) * 8 + w8];
            if (!has_next || nd == 8) break;
        }
        { LAS bf16* OT = (LAS bf16*)(lds + wave * 16640);
#pragma unroll
          for (int dt = 0; dt < 8; ++dt) { v2u w; w.x = pk2(o[dt][0], o[dt][1]); w.y = pk2(o[dt][2], o[dt][3]);
              *(LAS v2u*)(OT + fr * SBK_P + 16 * dt + 4 * fq) = w; }
          LDS_WAIT(); asm volatile("" ::: "memory");
          bf16* hrow = HC + (size_t)q0 * DM + head * 128;
#pragma unroll
          for (int i = 0; i < 4; ++i) { const int rr = 4 * i + fq, cc = fr * 8;
              *(v4u*)(hrow + (size_t)rr * DM + cc) = *(const LAS v4u*)(OT + rr * SBK_P + cc); }
          LDS_WAIT(); asm volatile("" ::: "memory"); }
        if (rider) { LAS float* scr = (LAS float*)(lds + wave * 16640);
            tr_to_lds(rv, scr, lane);
            bf16* WT = (bf16*)(ws + WS_W + (size_t)rsg.layer * LAYER_W + (size_t)rsg.wsub_mib * MiB);
            tr_store(WT + (size_t)(rsg.drow + 64 * rnb) * rsg.K + 64 * rkb, rsg.K, scr, lane); }
    }
}

constexpr int XA_P = 264, XA_BUF = 64 * XA_P * 2;
__device__ __forceinline__ void xattn_phase(unsigned char* ws, LAS unsigned char* lds, int bx, int G, int tid, int wave, int lane) {
    const bf16* XQ = (const bf16*)(ws + WS_XQ); const bf16* KM = (const bf16*)(ws + WS_KMEM); const bf16* VTM = (const bf16*)(ws + WS_VTMEM); bf16* XO = (bf16*)(ws + WS_XO);
#pragma unroll 1
    for (int U = bx; U < 256; U += G) {
        asm volatile("" : "+v"(lane), "+v"(tid));
        const int fr = lane & 15, fq = lane >> 4;
        const int pr0 = tid >> 5, pc0 = (tid & 31) * 8;
        const int head = U & 3, q0 = (U >> 2) * 128 + 16 * wave;
        bf16x8 qf[8];
#pragma unroll
        for (int ks = 0; ks < 8; ++ks) qf[ks] = *(const bf16x8*)(XQ + (size_t)(q0 + fr) * XAW + head * 256 + 32 * ks + 8 * fq);
        f32x4 s[16]; bf16x8 pf[8]; float rs = 0.f;
        v4u preg[4];
        LAS bf16* OT = (LAS bf16*)(lds + 2 * XA_BUF + wave * 2304);
#define XA_LOAD(p) do { _Pragma("unroll") for (int i_ = 0; i_ < 4; ++i_) { const int r_ = pr0 + 16 * i_; \
            preg[i_] = ((p) < 4) ? *(const v4u*)(KM + (size_t)(64 * (p) + r_) * XAW + head * 256 + pc0) : *(const v4u*)(VTM + (size_t)(head * 256 + 64 * ((p) - 4) + r_) * NMEM + pc0); } } while (0)
#define XA_STORE(p) do { LAS bf16* B_ = (LAS bf16*)(lds + ((p) & 1) * XA_BUF); _Pragma("unroll") for (int i_ = 0; i_ < 4; ++i_) *(LAS v4u*)(B_ + (pr0 + 16 * i_) * XA_P + pc0) = preg[i_]; } while (0)
        XA_LOAD(0);
        __syncthreads();
        XA_STORE(0);
        __syncthreads();
#pragma unroll
        for (int p = 0; p < 8; ++p) {
            if (p < 7) XA_LOAD(p + 1);
            const LAS bf16* B = (const LAS bf16*)(lds + (p & 1) * XA_BUF);
            if (p < 4) {
#pragma unroll
                for (int i = 0; i < 4; ++i) { f32x4 a = {0.f, 0.f, 0.f, 0.f};
#pragma unroll
                    for (int ks = 0; ks < 8; ++ks) a = mma(*(const LAS bf16x8*)(B + (16 * i + fr) * XA_P + 32 * ks + 8 * fq), qf[ks], a);
                    s[4 * p + i] = a; }
                if (p == 3) {
                    float mx = -1e30f;
#pragma unroll
                    for (int i = 0; i < 16; ++i) { s[i] = s[i] * 0.0625f; mx = fmaxf(mx, fmaxf(fmaxf(s[i][0], s[i][1]), fmaxf(s[i][2], s[i][3]))); }
                    mx = fmaxf(mx, __shfl_xor(mx, 16)); mx = fmaxf(mx, __shfl_xor(mx, 32));
                    float sum = 0.f;
#pragma unroll
                    for (int i = 0; i < 16; ++i) { s[i][0] = __expf(s[i][0] - mx); s[i][1] = __expf(s[i][1] - mx); s[i][2] = __expf(s[i][2] - mx); s[i][3] = __expf(s[i][3] - mx);
                        sum += (s[i][0] + s[i][1]) + (s[i][2] + s[i][3]); }
                    sum += __shfl_xor(sum, 16); sum += __shfl_xor(sum, 32);
                    rs = 1.f / sum;
#pragma unroll
                    for (int s2 = 0; s2 < 8; ++s2) { v4u w; w.x = pk2(s[2 * s2][0], s[2 * s2][1]); w.y = pk2(s[2 * s2][2], s[2 * s2][3]);
                        w.z = pk2(s[2 * s2 + 1][0], s[2 * s2 + 1][1]); w.w = pk2(s[2 * s2 + 1][2], s[2 * s2 + 1][3]); pf[s2] = u4_as_frag(w); }
                }
            } else {
#pragma unroll
                for (int i = 0; i < 4; ++i) {
                    const LAS bf16* vp = B + (16 * i + fr) * XA_P + 4 * fq;
                    f32x4 o = {0.f, 0.f, 0.f, 0.f};
#pragma unroll
                    for (int s2 = 0; s2 < 8; ++s2) { const s16x4 lo = *(const LAS s16x4*)(vp + 32 * s2), hi = *(const LAS s16x4*)(vp + 32 * s2 + 16); o = mma(cat8(lo, hi), pf[s2], o); }
                    v2u w; w.x = pk2(o[0] * rs, o[1] * rs); w.y = pk2(o[2] * rs, o[3] * rs);
                    *(LAS v2u*)(OT + fr * 72 + 16 * i + 4 * fq) = w;
                }
                LDS_WAIT(); asm volatile("" ::: "memory");
                { bf16* xrow = XO + (size_t)q0 * XAW + head * 256 + 64 * (p - 4);
#pragma unroll
                  for (int i = 0; i < 2; ++i) { const int rr = 8 * i + (lane >> 3), cc = (lane & 7) * 8;
                      *(v4u*)(xrow + (size_t)rr * XAW + cc) = *(const LAS v4u*)(OT + rr * 72 + cc); } }
                LDS_WAIT(); asm volatile("" ::: "memory");
            }
            if (p < 7) XA_STORE(p + 1);
            __syncthreads();
        }
#undef XA_LOAD
#undef XA_STORE
    }
}

__device__ __forceinline__ void conv_fixup(const float* cw, const float* cb, unsigned char* ws, int T0, int TS) {
    const float* halo = (const float*)(ws + WS_HALO); bf16* H = (bf16*)(ws + WS_H);
#pragma unroll 1
    for (int T = T0; T < 64 * FF; T += TS) {
        const int pr = T / FF, f = T - pr * FF, pm = pr >> 1, rr = pr & 1;
        const float* hp = halo + (size_t)pm * 6 * FF + f;
        float p2 = 0.f, p3 = 0.f;
        if (pm > 0) { const float* hq = halo + (size_t)(pm - 1) * 6 * FF + f; p2 = hq[2 * FF]; p3 = hq[3 * FF]; }
        const float g0 = hp[rr * FF];
        float g1 = rr ? hp[0] : p3, g2 = rr ? p3 : p2;
        g1 = __uint_as_float(f2bf(g1) << 16); g2 = __uint_as_float(f2bf(g2) << 16);
        const float x = cb[f] + cw[f] * g2 + cw[FF + f] * g1 + cw[2 * FF + f] * g0;
        const float y = -2.3022081983651455f * (x + 0.044715f * x * x * x);
        H[(size_t)(256 * pm + rr) * FF + f] = (bf16)f2bf(x * frcp(1.f + fexp2(y)) * hp[(4 + rr) * FF]);
    }
}

#ifndef EN_MASK
#define EN_MASK 0xffffffffu
#endif
#define EN(k) ((EN_MASK >> (k)) & 1u)
#define STEP_ON (lo <= step && step < hi)
#define OPQ int olane; asm volatile("v_mbcnt_lo_u32_b32 %0, -1, 0\n\tv_mbcnt_hi_u32_b32 %0, -1, %0" : "=v"(olane)); const int otid = wave * 64 + olane
#define STEP_END do { if (MK_SINGLE && step + 1 < hi) xcd_barrier(bar); ++step; } while (0)
typedef pg8::bf16_t pb;
#define glds lds
#define xres (args.out)
#define XN ((bf16*)(ws + WS_XN))
#define HB ((bf16*)(ws + WS_HB))
#define RS ((float*)(ws + WS_RS))
#define HC ((bf16*)(ws + WS_HC))
#define wl (ws + WS_W + (size_t)layer * LAYER_W)
#define SITE size_t wz_ = 0; asm volatile("" : "+s"(wz_)); unsigned char* ws = args.ws + wz_

template <int LAYER>
__device__ __forceinline__ void layer_steps(const Args& args, LAS unsigned char* lds, const XcdBarrier& bar, const int lo, const int hi, int& step,
                                            const int G, const int bx, const int vcu, const int gw, const int NGW, const int wave) {
    constexpr int layer = LAYER;

        if (EN(1) && STEP_ON) { SITE;
            { pg8::Gemm g{(const pb*)XN, (const pb*)(wl + WO_MAIN), SEQ, 8192, DM, DM, DM}; pg8::StaticOrder S; S.init(g.M, g.N, G, bx);
              pg8::EpiStore E{(pb*)(ws + WS_PROJ), 8192, nullptr, -1};
              pg8::gemm_phase<pg8::EpiStore, pg8::StaticOrder, true, true>(glds, g, S, E, wave); }
            { pg8::Gemm g{(const pb*)(wl + WO_V), (const pb*)XN, DM, SEQ, DM, DM, DM}; pg8::StaticOrder S; S.init(g.M, g.N, G, bx);
              pg8::EpiStore E{(pb*)(ws + WS_VT), 8192, nullptr, -1};
              pg8::gemm_phase<pg8::EpiStore, pg8::StaticOrder, true, true>(glds, g, S, E, wave); }
            if (layer == 0) { OPQ; gates_minigemm(ws, lds, bx, G, otid, wave, olane); }
        }
        STEP_END;
        if (layer == 0) {
            if (EN(3) && STEP_ON) { SITE;
                OPQ;
#pragma unroll 1
                for (int u = bx; u < 512; u += G) dc_unit(args, ws, lds, u, otid, wave, olane);
            }
            STEP_END;
#ifdef SCAN_PROBE
            if (EN(4) && STEP_ON) { SITE; OPQ; for (int rep_ = 0; rep_ < SCAN_PROBE; ++rep_) scan_phase(ws, vcu * NTHREADS + otid, G * NTHREADS, (bf16*)(ws + WS_W + LAYER_W + WO_GU)); }
#endif
            if (EN(4) && STEP_ON) { SITE; OPQ; scan_phase(ws, vcu * NTHREADS + otid, G * NTHREADS); }
            STEP_END;
            if (EN(5) && STEP_ON) { SITE;
                OPQ;
#pragma unroll 1
                for (int u = bx; u < 1024; u += G) { if (mixout_chunk(u) & 1) mixout_unit<true>(args, ws, lds, u, otid, wave, olane); else mixout_unit<false>(args, ws, lds, u, otid, wave, olane); }
            }
            STEP_END;
        } else {
            if (EN(6) && STEP_ON) { SITE; OPQ; stickbreak_phase(args, ws, lds, bx, G, otid, wave, olane); }
            STEP_END;
        }
        if (EN(7) && STEP_ON) { SITE;
            pg8::Gemm g{(const pb*)HC, (const pb*)(wl + WO_OUT), SEQ, DM, DM, DM, DM}; pg8::StaticOrder S; S.init(g.M, g.N, G, bx);
            pg8::EpiStore E{(pb*)HB, DM, nullptr, -1};
            pg8::gemm_phase<pg8::EpiStore, pg8::StaticOrder, true, true>(glds, g, S, E, wave);
        }
        STEP_END;
#ifdef NORM_PROBE
        if (EN(8) && STEP_ON) { SITE; OPQ; for (int rep_ = 0; rep_ < NORM_PROBE; ++rep_) norm_rows<1>(nullptr, HB, args.in[2] + layer * DM, args.in[3] + layer * DM, args.in[14] + layer * DM, nullptr, XN, RS, lds, gw, NGW, otid, olane, HC, RS + 16384); }
#endif
        if (EN(8) && STEP_ON) { SITE; OPQ; norm_rows<1>(nullptr, HB, args.in[2] + layer * DM, args.in[3] + layer * DM, args.in[14] + layer * DM, nullptr, XN, RS, lds, gw, NGW, otid, olane); }
        STEP_END;
        if (EN(9) && STEP_ON) { SITE;
            { pg8::Gemm g{(const pb*)XN, (const pb*)(wl + WO_XQ), SEQ, XAW, DM, DM, DM}; pg8::StaticOrder S; S.init(g.M, g.N, G, bx);
              pg8::EpiStore E{(pb*)(ws + WS_XQ), XAW, nullptr, -1};
              pg8::gemm_phase<pg8::EpiStore, pg8::StaticOrder, true, true>(glds, g, S, E, wave); }
            { pg8::Gemm g{(const pb*)(ws + WS_MEMN) + (size_t)layer * NMEM * DM, (const pb*)(wl + WO_XK), NMEM, XAW, DM, DM, DM}; pg8::StaticOrder S; S.init(g.M, g.N, G, (bx + G - 128) % G);
              pg8::EpiStore E{(pb*)(ws + WS_KMEM), XAW, nullptr, -1};
              pg8::gemm_phase<pg8::EpiStore, pg8::StaticOrder, true, true>(glds, g, S, E, wave); }
            { pg8::Gemm g{(const pb*)(wl + WO_XV), (const pb*)(ws + WS_MEMN) + (size_t)layer * NMEM * DM, XAW, NMEM, DM, DM, DM}; pg8::StaticOrder S; S.init(g.M, g.N, G, (bx + G - 132) % G);
              pg8::EpiStore E{(pb*)(ws + WS_VTMEM), NMEM, nullptr, -1};
              pg8::gemm_phase<pg8::EpiStore, pg8::StaticOrder, true, true>(glds, g, S, E, wave); }
            if (G == 256 && bx >= XA_BUSY_WGS) { OPQ; convert_segments(args, ws, lds, SEG_DEFER, SEG_END, layer == 0 ? 0 : 1, layer == 0 ? 1 : 2, 2, (bx - XA_BUSY_WGS) * NWAVES + wave, (G - XA_BUSY_WGS) * NWAVES, wave, olane); }
        }
        STEP_END;
        if (EN(10) && STEP_ON) { SITE; OPQ; xattn_phase(ws, lds, bx, G, otid, wave, olane); }
        STEP_END;
        if (EN(11) && STEP_ON) { SITE;
            pg8::Gemm g{(const pb*)(ws + WS_XO), (const pb*)(wl + WO_XO), SEQ, DM, XAW, XAW, XAW}; pg8::StaticOrder S; S.init(g.M, g.N, G, bx);
            pg8::EpiStore E{(pb*)HB, DM, nullptr, -1};
            pg8::gemm_phase<pg8::EpiStore, pg8::StaticOrder, true, true>(glds, g, S, E, wave);
        }
        STEP_END;
        if (EN(12) && STEP_ON) { SITE; OPQ; norm_rows<1>(nullptr, HB, args.in[14] + layer * DM, args.in[15] + layer * DM, args.in[21] + layer * DM, nullptr, XN, RS, lds, gw, NGW, otid, olane); }
        STEP_END;
        if (EN(13) && STEP_ON) { SITE;
            pg8::Gemm g{(const pb*)XN, (const pb*)(wl + WO_GU), SEQ, 2 * FF, DM, DM, DM}; pg8::StaticOrder S; S.init(g.M, g.N, G, bx);
            pg8::EpiConvGelu E{(pb*)(ws + WS_H), FF, args.in[25] + (size_t)layer * 3 * FF, args.in[26] + (size_t)layer * FF, FF, (float*)(ws + WS_HALO), (PG8_LAS float*)(lds + 131072)};
            pg8::gemm_phase<pg8::EpiConvGelu, pg8::StaticOrder, true, true>(glds, g, S, E, wave);
        }
        STEP_END;
        if (EN(14) && STEP_ON) { SITE; OPQ; conv_fixup(args.in[25] + (size_t)layer * 3 * FF, args.in[26] + (size_t)layer * FF, ws, vcu * NTHREADS + otid, G * NTHREADS); }
        STEP_END;
        if (EN(15) && STEP_ON) { SITE;
            pg8::Gemm g{(const pb*)(ws + WS_H), (const pb*)(wl + WO_DOWN), SEQ, DM, FF, FF, FF}; pg8::StaticOrder S; S.init(g.M, g.N, G, bx);
            pg8::EpiStore E{(pb*)HB, DM, nullptr, -1};
            pg8::gemm_phase<pg8::EpiStore, pg8::StaticOrder, true, true>(glds, g, S, E, wave);
        }
        STEP_END;
        if (EN(16) && STEP_ON) { SITE;
            OPQ;
            if (layer == 0) norm_rows<1>(nullptr, HB, args.in[21], args.in[22], args.in[2] + DM, nullptr, XN, RS, lds, gw, NGW, otid, olane);
            else norm_rows<2>(nullptr, HB, args.in[21] + DM, args.in[22] + DM, nullptr, xres, XN, RS, lds, gw, NGW, otid, olane);
        }
        STEP_END;
}
__global__ void __launch_bounds__(NTHREADS, 2) mk_fwd(Args args) {
    extern __shared__ __attribute__((aligned(16))) unsigned char lds_raw[];
    LAS unsigned char* lds = (LAS unsigned char*)lds_raw;
    volatile LAS unsigned* MISC = (volatile LAS unsigned*)(lds + MISC_OFF);
    const int tid = threadIdx.x, wave = __builtin_amdgcn_readfirstlane(tid >> 6);
    const int G = gridDim.x, bx = blockIdx.x;
    const int vcu = (G % 8 == 0) ? (bx % 8) * (G / 8) + bx / 8 : bx;
    const int gw = vcu * NWAVES + wave, NGW = G * NWAVES;
    gu32* ctl = (gu32*)(args.ws + WS_CTL);
    for (int u = tid; u < (LDS_BYTES - LDSCTL_OFF) / 4; u += NTHREADS) ((LAS unsigned*)(lds + LDSCTL_OFF))[u] = 0u;
    __syncthreads();
    XcdBarrier bar; bar.bar = (unsigned*)(ctl + CW_BAR); bar.x = 0; bar.st = nullptr;
    if (MK_SINGLE) bar = xcd_barrier_post((unsigned*)(ctl + CW_BAR), MISC + 8);
    const int lo = args.ph_lo, hi = args.ph_hi;
    int step = 0;
    if (EN(0) && STEP_ON) { SITE;
        { OPQ; p0_prologue(args, ws, lds, gw, NGW, wave, olane, G == 256); }
        { OPQ; norm_rows<0>(args.in[0], nullptr, nullptr, nullptr, args.in[2], nullptr, XN, RS, lds, gw, NGW, otid, olane); }
    }
    STEP_END;

    layer_steps<0>(args, lds, bar, lo, hi, step, G, bx, vcu, gw, NGW, wave);
    layer_steps<1>(args, lds, bar, lo, hi, step, G, bx, vcu, gw, NGW, wave);
#undef STEP_ON
#undef STEP_END
}

extern "C" void kernel_launch(void* const* d_in, const int* in_sizes, int n_in, void* d_out, int out_size, void* d_ws, size_t ws_size, hipStream_t stream) {
    static int grid = 0;
    if (grid == 0) {
        if (n_in != 28 || out_size != SEQ * DM || ws_size < WS_END) { fprintf(stderr, "kernel_launch: built for 28 inputs, out %d floats, >= %zu bytes of workspace; got n_in %d, out %d, ws %zu; nothing launched\n", SEQ * DM, (size_t)WS_END, n_in, out_size, ws_size); grid = -1; return; }
        int dev = 0, cus = 0, per_cu = 0;
        if (hipGetDevice(&dev) != hipSuccess || hipDeviceGetAttribute(&cus, hipDeviceAttributeMultiprocessorCount, dev) != hipSuccess) { fprintf(stderr, "kernel_launch: device query failed\n"); grid = -1; return; }
        if (hipFuncSetAttribute((const void*)mk_fwd, hipFuncAttributeMaxDynamicSharedMemorySize, LDS_BYTES) != hipSuccess) { fprintf(stderr, "kernel_launch: hipFuncSetAttribute failed\n"); grid = -1; return; }
        if (hipOccupancyMaxActiveBlocksPerMultiprocessor(&per_cu, (const void*)mk_fwd, NTHREADS, LDS_BYTES) != hipSuccess || per_cu < 1)
            fprintf(stderr, "kernel_launch: note: occupancy query reports %d workgroups per CU\n", per_cu);
        (void)hipGetLastError();
        grid = cus;
    }
    if (grid < 0) return;
    if (hipMemsetAsync((char*)d_ws + WS_CTL, 0, CTL_ZERO_BYTES, stream) != hipSuccess) { fprintf(stderr, "kernel_launch: hipMemsetAsync failed\n"); return; }
    Args a{};
    for (int i = 0; i < 28; ++i) a.in[i] = (const float*)d_in[i];
    a.out = (float*)d_out; a.ws = (unsigned char*)d_ws;
#if MK_SINGLE
    a.ph_lo = 0; a.ph_hi = N_STEPS;
    hipLaunchKernelGGL(mk_fwd, dim3(grid), dim3(NTHREADS), LDS_BYTES, stream, a);
#else
#ifndef DUP_STEPS
#define DUP_STEPS 0u
#endif
#ifndef DUP_N
#define DUP_N 2
#endif
    for (int s = 0; s < N_STEPS; ++s) { a.ph_lo = s; a.ph_hi = s + 1;
        for (int rep = 0; rep < (((DUP_STEPS >> s) & 1u) ? DUP_N : 1); ++rep) hipLaunchKernelGGL(mk_fwd, dim3(grid), dim3(NTHREADS), LDS_BYTES, stream, a); }
#endif
    const hipError_t le = hipPeekAtLastError();
    if (le != hipSuccess) fprintf(stderr, "kernel_launch: launch failed: %s\n", hipGetErrorName(le));
}
```

```cpp
#include <hip/hip_runtime.h>
#include <cstdio>
#include <cstdint>
#define MK_SINGLE 1
namespace pg8 {
#define PG8_LAS __attribute__((address_space(3)))
typedef unsigned short bf16_t;
typedef short bf16x8 __attribute__((ext_vector_type(8)));
typedef float f32x4 __attribute__((ext_vector_type(4)));
typedef unsigned u32x4 __attribute__((ext_vector_type(4)));
constexpr int BM = 256, BK = 64, HALF = 128, HTB = HALF * BK * 2  , STAGE_BYTES = 8 * HTB, NXCD = 8, WGM = 8;

__host__ __device__ __forceinline__ int lds_byte(int r, int c) { const int st = (r >> 4) * 2 + (c >> 5), rr = r & 15, cc = c & 31, ob = rr * 64 + cc * 2; return st * 1024 + (ob ^ (((ob >> 9) & 1) << 5)); }
__host__ __device__ __forceinline__ void stage_rc(int b, int& R, int& C) { const int st = b / 1024, sb = b % 1024, swz = sb ^ (((sb >> 9) & 1) << 5); R = (st >> 1) * 16 + swz / 64; C = (st & 1) * 32 + (swz % 64) / 2; }
__host__ __device__ __forceinline__ int perm32(int rho) { const int n = rho >> 4, i = rho & 15; return 8 * (i >> 2) + 4 * n + (i & 3); }

struct Unit { int pm, pn; };
struct Gemm { const bf16_t* A; const bf16_t* Bt; int M, N, K, lda, ldb; };

struct StaticOrder {
    int nM, nN, nwg, G, c;
    __host__ __device__ void init(int M, int N, int G_, int c_) { nM = M / BM; nN = N / BM; nwg = nM * nN; G = G_; c = c_; }
    __host__ __device__ bool next(int i, Unit& u) const {
        const long L = (long)i * G + c; if (L >= nwg) return false;
        int wgid = (int)L; { const int q = nwg / NXCD, r = nwg % NXCD, xcd = wgid % NXCD, off = wgid / NXCD; wgid = (xcd < r ? xcd * (q + 1) : r * (q + 1) + (xcd - r) * q) + off; }
        const int nig = WGM * nN, gid = wgid / nig, fm = gid * WGM, gsz = (nM - fm) < WGM ? (nM - fm) : WGM;
        u.pm = fm + ((wgid % nig) % gsz); u.pn = (wgid % nig) / gsz; return true;
    }
    __device__ __forceinline__ void a_ready(const Unit&) const {}
    __device__ __forceinline__ void done(const Unit&) const {}
};

__device__ __forceinline__ unsigned cvt_pk_bf16(float lo, float hi) { unsigned r; asm volatile("v_cvt_pk_bf16_f32 %0, %1, %2" : "=v"(r) : "v"(lo), "v"(hi)); return r; }

struct EpiStore {
    static constexpr bool PERM = true, AFTER_DRAIN = false;
    bf16_t* O; int ldc; float* gates; int gate_pn;
    __device__ __forceinline__ void operator()(const f32x4 (&acc)[2][2][4][2], const Unit& u, int wr, int wc, int fr, int fq) const {
        const int row0 = u.pm * BM + wr * 64 + fr;
        if (u.pn == gate_pn) {
            if (wc == 0) {
#pragma unroll
                for (int ai = 0; ai < 2; ++ai)
#pragma unroll
                    for (int m = 0; m < 4; ++m) { float* gp = gates + (size_t)(row0 + ai * HALF + m * 16) * 32 + 8 * fq;
                        *(f32x4*)(gp) = acc[ai][0][m][0]; *(f32x4*)(gp + 4) = acc[ai][0][m][1]; }
            }
            return;
        }
        const int col0 = u.pn * BM + wc * 32 + 8 * fq;
#pragma unroll
        for (int ai = 0; ai < 2; ++ai)
#pragma unroll
            for (int m = 0; m < 4; ++m) { bf16_t* rowp = O + (size_t)(row0 + ai * HALF + m * 16) * ldc + col0;
#pragma unroll
                for (int bj = 0; bj < 2; ++bj) { const f32x4 v0 = acc[ai][bj][m][0], v1 = acc[ai][bj][m][1];
                    u32x4 w; w.x = cvt_pk_bf16(v0[0], v0[1]); w.y = cvt_pk_bf16(v0[2], v0[3]); w.z = cvt_pk_bf16(v1[0], v1[1]); w.w = cvt_pk_bf16(v1[2], v1[3]);
                    *(u32x4*)(rowp + bj * HALF) = w; } }
    }
};

__device__ __forceinline__ float gelu_tanh_f(float x) { const float y = -2.3022081983651455f * (x + 0.044715f * x * x * x); return x * __builtin_amdgcn_rcpf(1.f + __builtin_amdgcn_exp2f(y)); }
struct EpiConvGelu {
    static constexpr bool PERM = true, AFTER_DRAIN = false;
    bf16_t* H; int ldh; const float* cw; const float* cb; int ff; float* halo; PG8_LAS float* X;
    __device__ __forceinline__ void operator()(const f32x4 (&acc)[2][2][4][2], const Unit& u, int wr, int wc, int fr, int fq) const {
        const int cl = 32 * wc + 8 * fq;
        const int f0 = 128 * u.pn + cl;
        if (fr >= 14) {
#pragma unroll
            for (int ai = 0; ai < 2; ++ai) { PG8_LAS float* xp = X + ((2 * ai + wr) * 2 + (fr - 14)) * 128 + cl;
                *(PG8_LAS f32x4*)xp = acc[ai][0][3][0]; *(PG8_LAS f32x4*)(xp + 4) = acc[ai][0][3][1]; }
        }
        asm volatile("s_waitcnt lgkmcnt(0)" ::: "memory"); __builtin_amdgcn_s_barrier(); asm volatile("" ::: "memory");
        float w0[8], w1[8], w2[8], bb[8];
#pragma unroll
        for (int h = 0; h < 2; ++h) { const f32x4 a = *(const f32x4*)(cw + f0 + 4 * h), b = *(const f32x4*)(cw + ff + f0 + 4 * h), c = *(const f32x4*)(cw + 2 * ff + f0 + 4 * h), d = *(const f32x4*)(cb + f0 + 4 * h);
#pragma unroll
            for (int j = 0; j < 4; ++j) { w0[4 * h + j] = a[j]; w1[4 * h + j] = b[j]; w2[4 * h + j] = c[j]; bb[4 * h + j] = d[j]; } }
        float* hp = halo + (size_t)u.pm * 6 * ff + f0;
#pragma unroll
        for (int ai = 0; ai < 2; ++ai) {
            const int slab = 2 * ai + wr;
            unsigned l14[4], l15[4];
            if (slab > 0) { const PG8_LAS float* xp = X + ((slab - 1) * 2) * 128 + cl;
                const f32x4 a0 = *(const PG8_LAS f32x4*)xp, a1 = *(const PG8_LAS f32x4*)(xp + 4), b0 = *(const PG8_LAS f32x4*)(xp + 128), b1 = *(const PG8_LAS f32x4*)(xp + 132);
                l14[0] = cvt_pk_bf16(a0[0], a0[1]); l14[1] = cvt_pk_bf16(a0[2], a0[3]); l14[2] = cvt_pk_bf16(a1[0], a1[1]); l14[3] = cvt_pk_bf16(a1[2], a1[3]);
                l15[0] = cvt_pk_bf16(b0[0], b0[1]); l15[1] = cvt_pk_bf16(b0[2], b0[3]); l15[2] = cvt_pk_bf16(b1[0], b1[1]); l15[3] = cvt_pk_bf16(b1[2], b1[3]); }
            else { l14[0] = l14[1] = l14[2] = l14[3] = 0u; l15[0] = l15[1] = l15[2] = l15[3] = 0u; }
#pragma unroll
            for (int m = 0; m < 4; ++m) {
                const int row = u.pm * BM + ai * HALF + wr * 64 + m * 16 + fr;
                unsigned pk[4];
                pk[0] = cvt_pk_bf16(acc[ai][0][m][0][0], acc[ai][0][m][0][1]); pk[1] = cvt_pk_bf16(acc[ai][0][m][0][2], acc[ai][0][m][0][3]);
                pk[2] = cvt_pk_bf16(acc[ai][0][m][1][0], acc[ai][0][m][1][1]); pk[3] = cvt_pk_bf16(acc[ai][0][m][1][2], acc[ai][0][m][1][3]);
                float hv[8];
#pragma unroll
                for (int q = 0; q < 4; ++q) {
                    unsigned g1 = (unsigned)__shfl_up((int)pk[q], 1, 16), g2 = (unsigned)__shfl_up((int)pk[q], 2, 16);
                    if (fr == 0) { g1 = l15[q]; g2 = l14[q]; } else if (fr == 1) { g2 = l15[q]; }
                    const unsigned n14 = (unsigned)__shfl((int)pk[q], 14, 16), n15 = (unsigned)__shfl((int)pk[q], 15, 16);
                    l14[q] = n14; l15[q] = n15;
                    const int n = q >> 1, j = (q & 1) * 2, e = 2 * q;
                    const float x0 = bb[e] + w0[e] * __uint_as_float(g2 << 16) + w1[e] * __uint_as_float(g1 << 16) + w2[e] * acc[ai][0][m][n][j];
                    const float x1 = bb[e + 1] + w0[e + 1] * __uint_as_float(g2 & 0xffff0000u) + w1[e + 1] * __uint_as_float(g1 & 0xffff0000u) + w2[e + 1] * acc[ai][0][m][n][j + 1];
                    hv[e] = gelu_tanh_f(x0) * acc[ai][1][m][n][j]; hv[e + 1] = gelu_tanh_f(x1) * acc[ai][1][m][n][j + 1];
                }
                const bool first2 = (slab == 0 && m == 0 && fr < 2);
                if (!first2) { u32x4 w; w.x = cvt_pk_bf16(hv[0], hv[1]); w.y = cvt_pk_bf16(hv[2], hv[3]); w.z = cvt_pk_bf16(hv[4], hv[5]); w.w = cvt_pk_bf16(hv[6], hv[7]);
                    *(u32x4*)(H + (size_t)row * ldh + f0) = w; }
                else { float* p = hp + (size_t)fr * ff; *(f32x4*)p = acc[0][0][0][0]; *(f32x4*)(p + 4) = acc[0][0][0][1];
                    float* pu = hp + (size_t)(4 + fr) * ff; *(f32x4*)pu = acc[0][1][0][0]; *(f32x4*)(pu + 4) = acc[0][1][0][1]; }
                if (slab == 3 && m == 3 && fr >= 14) { float* p = hp + (size_t)(2 + fr - 14) * ff; *(f32x4*)p = acc[1][0][3][0]; *(f32x4*)(p + 4) = acc[1][0][3][1]; }
            }
        }
    }
};
template <class Epi, class Sched, bool ALIGN_EPI = false, bool SP2 = false>
__device__ __forceinline__ void gemm_phase(PG8_LAS unsigned char* lds, const Gemm g, const Sched& S, const Epi& E, const int wv  ) {
    int tid_o; asm volatile("v_mbcnt_lo_u32_b32 %0, -1, 0\n\tv_mbcnt_hi_u32_b32 %0, -1, %0" : "=v"(tid_o)); tid_o += wv * 64;
    const int tid = tid_o, wid = __builtin_amdgcn_readfirstlane(tid >> 6), lane = tid & 63, wr = wid >> 2, wc = wid & 3, fr = lane & 15, fq = lane >> 4;
    const int K = g.K, nt = K / BK;
    unsigned voffA[2], voffB[2];
#pragma unroll
    for (int i = 0; i < 2; ++i) { int R, C; stage_rc(tid * 16 + i * 8192, R, C); const int Rb = Epi::PERM ? ((R & ~31) + perm32(R & 31)) : R;
        voffA[i] = (unsigned)(R * g.lda + C) * 2u; voffB[i] = (unsigned)(Rb * g.ldb + C) * 2u; }
    const size_t kstep = (size_t)(BK * 2);
    const size_t hstepA = (size_t)HALF * g.lda * 2, hstepB = (size_t)HALF * g.ldb * 2;
    const size_t tstepA = 2 * hstepA, tstepB = 2 * hstepB;
    const unsigned ldsw = (unsigned)wid * 1024u;
    const int aoff = lds_byte(wr * 64 + fr, fq * 8), boff = lds_byte(wc * 32 + fr, fq * 8);
#define PG8_SA(b, h) (((b) * 2 + (h)) * HTB)
#define PG8_SB(b, h) ((4 + (b) * 2 + (h)) * HTB)
#define PG8_STAGE(bufoff, gbase, voff) do { _Pragma("unroll") for (int _i = 0; _i < 2; ++_i) \
        __builtin_amdgcn_global_load_lds((const unsigned*)((const char*)(gbase) + (voff)[_i]), (PG8_LAS unsigned*)(lds + (bufoff) + ldsw + _i * 8192), 16, 0, 0); } while (0)
#define PG8_LDA(dst, b, h) do { _Pragma("unroll") for (int m = 0; m < 4; ++m) _Pragma("unroll") for (int k = 0; k < 2; ++k) dst[m][k] = *(const PG8_LAS bf16x8*)(lds + PG8_SA(b, h) + aoff + m * 2048 + k * 1024); } while (0)
#define PG8_LDB(dst, b, h) do { _Pragma("unroll") for (int n = 0; n < 2; ++n) _Pragma("unroll") for (int k = 0; k < 2; ++k) dst[n][k] = *(const PG8_LAS bf16x8*)(lds + PG8_SB(b, h) + boff + n * 2048 + k * 1024); } while (0)
#define PG8_MMA(ai, bj, At, Bt) do { __builtin_amdgcn_s_setprio(1); _Pragma("unroll") for (int m = 0; m < 4; ++m) _Pragma("unroll") for (int n = 0; n < 2; ++n) _Pragma("unroll") for (int k = 0; k < 2; ++k) \
        acc[ai][bj][m][n] = __builtin_amdgcn_mfma_f32_16x16x32_bf16(Bt[n][k], At[m][k], acc[ai][bj][m][n], 0, 0, 0); __builtin_amdgcn_s_setprio(0); } while (0)
#define PG8_WAIT_V(n) asm volatile("s_waitcnt vmcnt(" #n ")" ::: "memory")
#define PG8_WAIT_L(n) asm volatile("s_waitcnt lgkmcnt(" #n ")" ::: "memory")
#define PG8_BAR __builtin_amdgcn_s_barrier()
#define PG8_SCHED __builtin_amdgcn_sched_barrier(0)
    Unit cur, nxt; int ui = 0;
    if (!S.next(0, cur)) return;
    f32x4 acc[2][2][4][2];
#pragma unroll
    for (int a = 0; a < 2; ++a)
#pragma unroll
        for (int b = 0; b < 2; ++b)
#pragma unroll
            for (int m = 0; m < 4; ++m)
#pragma unroll
                for (int n = 0; n < 2; ++n) acc[a][b][m][n] = (f32x4){0.f, 0.f, 0.f, 0.f};
    bf16x8 At[4][2], B0[2][2], B1[2][2];
    const char* cA = (const char*)g.A + (size_t)cur.pm * tstepA; const char* cB = (const char*)g.Bt + (size_t)cur.pn * tstepB;
    S.a_ready(cur);
    if constexpr (SP2) {
        PG8_STAGE(PG8_SB(0, 0), cB, voffB); PG8_STAGE(PG8_SB(0, 1), cB + hstepB, voffB); PG8_STAGE(PG8_SA(0, 0), cA, voffA); PG8_STAGE(PG8_SA(0, 1), cA + hstepA, voffA);
        if (wr == 1) PG8_BAR;
        PG8_WAIT_V(2); PG8_BAR;
        PG8_STAGE(PG8_SB(1, 0), cB + kstep, voffB); PG8_STAGE(PG8_SA(1, 0), cA + kstep, voffA); PG8_STAGE(PG8_SB(1, 1), cB + hstepB + kstep, voffB);
        PG8_WAIT_V(6); PG8_BAR;
    } else {
        PG8_STAGE(PG8_SB(0, 0), cB, voffB); PG8_STAGE(PG8_SA(0, 0), cA, voffA); PG8_STAGE(PG8_SB(0, 1), cB + hstepB, voffB); PG8_STAGE(PG8_SA(0, 1), cA + hstepA, voffA);
        if (wr == 1) PG8_BAR;
        PG8_WAIT_V(4); PG8_BAR;
        PG8_STAGE(PG8_SB(1, 0), cB + kstep, voffB); PG8_STAGE(PG8_SA(1, 0), cA + kstep, voffA); PG8_STAGE(PG8_SB(1, 1), cB + hstepB + kstep, voffB);
        PG8_WAIT_V(6); PG8_BAR;
    }
    for (;;) {
        const bool has_next = S.next(ui + 1, nxt);
        const char* nA = has_next ? (const char*)g.A + (size_t)nxt.pm * tstepA : cA; const char* nB = has_next ? (const char*)g.Bt + (size_t)nxt.pn * tstepB : cB;
        for (int t = 0; t < nt; t += 2) {
            const bool last = (t == nt - 2);
            const char* a1 = cA + (size_t)(t + 1) * kstep;
            const char* a2 = last ? nA : cA + (size_t)(t + 2) * kstep; const char* b2 = last ? nB : cB + (size_t)(t + 2) * kstep;
            const char* a3 = a2 + kstep; const char* b3 = b2 + kstep;
            if (last && has_next) S.a_ready(nxt);
            if constexpr (SP2) {
            PG8_LDB(B0, 0, 0); PG8_LDB(B1, 0, 1); PG8_SCHED; PG8_LDA(At, 0, 0); PG8_STAGE(PG8_SA(1, 1), a1 + hstepA, voffA);
            PG8_WAIT_V(8); PG8_WAIT_L(0); PG8_BAR; PG8_MMA(0, 0, At, B0); PG8_MMA(0, 1, At, B1); PG8_BAR; PG8_SCHED;
            PG8_LDA(At, 0, 1); PG8_STAGE(PG8_SB(0, 0), b2, voffB); PG8_STAGE(PG8_SB(0, 1), b2 + hstepB, voffB); PG8_STAGE(PG8_SA(0, 0), a2, voffA);
            PG8_WAIT_V(8); PG8_WAIT_L(0); PG8_BAR; PG8_MMA(1, 0, At, B0); PG8_MMA(1, 1, At, B1); PG8_BAR; PG8_SCHED;
            PG8_LDB(B0, 1, 0); PG8_LDB(B1, 1, 1); PG8_SCHED; PG8_LDA(At, 1, 0); PG8_STAGE(PG8_SA(0, 1), a2 + hstepA, voffA);
            PG8_WAIT_V(8); PG8_WAIT_L(0); PG8_BAR; PG8_MMA(0, 0, At, B0); PG8_MMA(0, 1, At, B1); PG8_BAR; PG8_SCHED;
            PG8_LDA(At, 1, 1); PG8_STAGE(PG8_SB(1, 0), b3, voffB); PG8_STAGE(PG8_SB(1, 1), b3 + hstepB, voffB); PG8_STAGE(PG8_SA(1, 0), a3, voffA);
            PG8_WAIT_V(8); PG8_WAIT_L(0); PG8_BAR; PG8_MMA(1, 0, At, B0); PG8_MMA(1, 1, At, B1); PG8_BAR; PG8_SCHED;
            } else {
            PG8_LDB(B0, 0, 0); PG8_SCHED; PG8_LDA(At, 0, 0); PG8_STAGE(PG8_SA(1, 1), a1 + hstepA, voffA);
            PG8_WAIT_L(8); PG8_BAR; PG8_WAIT_L(0); PG8_MMA(0, 0, At, B0); PG8_BAR; PG8_SCHED;
            PG8_LDB(B1, 0, 1); PG8_STAGE(PG8_SB(0, 0), b2, voffB);
            PG8_BAR; PG8_WAIT_L(0); PG8_MMA(0, 1, At, B1); PG8_BAR;
            PG8_LDA(At, 0, 1); PG8_STAGE(PG8_SA(0, 0), a2, voffA);
            PG8_BAR; PG8_WAIT_L(0); PG8_MMA(1, 0, At, B0); PG8_BAR; PG8_SCHED;
            PG8_STAGE(PG8_SB(0, 1), b2 + hstepB, voffB);
            PG8_WAIT_V(6); PG8_BAR; PG8_MMA(1, 1, At, B1); PG8_BAR;
            PG8_LDB(B0, 1, 0); PG8_SCHED; PG8_LDA(At, 1, 0); PG8_STAGE(PG8_SA(0, 1), a2 + hstepA, voffA);
            PG8_WAIT_L(8); PG8_BAR; PG8_WAIT_L(0); PG8_MMA(0, 0, At, B0); PG8_BAR; PG8_SCHED;
            PG8_LDB(B1, 1, 1); PG8_STAGE(PG8_SB(1, 0), b3, voffB);
            PG8_BAR; PG8_WAIT_L(0); PG8_MMA(0, 1, At, B1); PG8_BAR;
            PG8_LDA(At, 1, 1); PG8_STAGE(PG8_SA(1, 0), a3, voffA);
            PG8_BAR; PG8_WAIT_L(0); PG8_MMA(1, 0, At, B0); PG8_BAR; PG8_SCHED;
            PG8_STAGE(PG8_SB(1, 1), b3 + hstepB, voffB);
            PG8_WAIT_V(6); PG8_BAR; PG8_MMA(1, 1, At, B1); PG8_BAR;
            }
        }
        if constexpr (ALIGN_EPI) { if (wr == 0) PG8_BAR; }
        if constexpr (!Epi::AFTER_DRAIN) { E(acc, cur, wr, wc, fr, fq); S.done(cur); }
        if (!has_next) break;
#pragma unroll
        for (int a = 0; a < 2; ++a)
#pragma unroll
            for (int b = 0; b < 2; ++b)
#pragma unroll
                for (int m = 0; m < 4; ++m)
#pragma unroll
                    for (int n = 0; n < 2; ++n) acc[a][b][m][n] = (f32x4){0.f, 0.f, 0.f, 0.f};
        cur = nxt; cA = nA; cB = nB; ++ui;
        if constexpr (ALIGN_EPI) { if (wr == 1) PG8_BAR; }
    }
    PG8_WAIT_V(0);
    if constexpr (!ALIGN_EPI) { if (wr == 0) PG8_BAR; }
    PG8_BAR;
    if constexpr (Epi::AFTER_DRAIN) { E.fused(acc, cur, wr, wc, fr, fq, lds, wid, lane); S.done(cur); }
#undef PG8_SA
#undef PG8_SB
#undef PG8_STAGE
#undef PG8_LDA
#undef PG8_LDB
#undef PG8_MMA
#undef PG8_WAIT_V
#undef PG8_WAIT_L
#undef PG8_BAR
#undef PG8_SCHED
}
}

constexpr int SEQ = 8192, DM = 4096, NMEM = 256, FF = 11008, XAW = 1024, ABIN = 12312;
constexpr int NCH = 128;
constexpr float EPS = 1e-6f;
constexpr int NWAVES = 8, NTHREADS = 512;
#ifndef MK_SINGLE
#define MK_SINGLE 1
#endif
constexpr int N_STEPS = 27;

constexpr size_t MiB = 1u << 20;
constexpr size_t WS_CTL = 0, CTL_ZERO_BYTES = 1 * MiB;
constexpr size_t WS_GATES = 1 * MiB;
constexpr size_t WS_MLS = 2 * MiB;
constexpr size_t WS_RS = 2 * MiB + 768 * 1024;
constexpr size_t WS_NST = 3 * MiB;
constexpr size_t WS_MEMN = 4 * MiB;
constexpr size_t WS_KMEM = 8 * MiB;
constexpr size_t WS_VTMEM = 8 * MiB + 512 * 1024;
constexpr size_t WS_XQ = 16 * MiB;
constexpr size_t WS_XO = 32 * MiB;
constexpr size_t WS_XN = 48 * MiB;
constexpr size_t WS_HB = 112 * MiB;
constexpr size_t WS_HC = 176 * MiB;
constexpr size_t WS_GG = 240 * MiB;
constexpr size_t WS_BIG = 272 * MiB;
constexpr size_t WS_PROJ = WS_BIG;
constexpr size_t WS_VT = WS_BIG + 132 * MiB;
constexpr size_t WS_STATE = WS_BIG + 196 * MiB;
constexpr size_t WS_H = WS_BIG;
constexpr size_t WS_HALO = WS_GG;
constexpr size_t WS_W = 724 * MiB;
constexpr size_t LAYER_W = 420 * MiB;
constexpr size_t WO_MAIN = 0, WO_V = 66 * MiB, WO_OUT = 98 * MiB, WO_XQ = 130 * MiB, WO_XK = 138 * MiB, WO_XV = 146 * MiB, WO_XO = 154 * MiB, WO_GU = 162 * MiB, WO_DOWN = 334 * MiB;
constexpr size_t WS_END = WS_W + 2 * LAYER_W;
constexpr int CW_TMO = 0, CW_CODE = 1, CW_BAR = 4096;
constexpr int MLS_A = 0, MLS_PM = 4 * SEQ, MLS_BC = 8 * SEQ, MLS_CHB = 12 * SEQ, MLS_CHP = 12 * SEQ + 4 * NCH, MLS_MC = 12 * SEQ + 8 * NCH;

constexpr int SCR_BYTES = 143360;
constexpr int LDSCTL_OFF = SCR_BYTES, MISC_OFF = LDSCTL_OFF + 320;
constexpr int LDS_BYTES = 147456;

#define GAS __attribute__((address_space(1)))
#define LAS __attribute__((address_space(3)))
typedef unsigned short bf16;
typedef unsigned v4u __attribute__((ext_vector_type(4)));
typedef unsigned v2u __attribute__((ext_vector_type(2)));
typedef float f32x4 __attribute__((ext_vector_type(4)));
typedef short bf16x8 __attribute__((ext_vector_type(8)));
typedef short s16x4 __attribute__((ext_vector_type(4)));
typedef GAS unsigned gu32;
#define RLX_AGENT __ATOMIC_RELAXED, __HIP_MEMORY_SCOPE_AGENT
#define LDS_WAIT() asm volatile("s_waitcnt lgkmcnt(0)" ::: "memory")
#define VM_WAIT() asm volatile("s_waitcnt vmcnt(0)" ::: "memory")
typedef float f32x2c __attribute__((ext_vector_type(2)));
typedef __bf16 bf16x2c __attribute__((ext_vector_type(2)));
__device__ __forceinline__ unsigned pk2(float lo, float hi) { const f32x2c v = {lo, hi}; return __builtin_bit_cast(unsigned, __builtin_convertvector(v, bf16x2c)); }
__device__ __forceinline__ unsigned f2bf(float f) { return pk2(f, 0.f) & 0xffffu; }
__device__ __forceinline__ float bflo(unsigned w) { return __uint_as_float(w << 16); }
__device__ __forceinline__ float bfhi(unsigned w) { return __uint_as_float(w & 0xffff0000u); }
__device__ __forceinline__ f32x4 mma(bf16x8 a, bf16x8 b, f32x4 c) { return __builtin_amdgcn_mfma_f32_16x16x32_bf16(a, b, c, 0, 0, 0); }
__device__ __forceinline__ bf16x8 cat8(s16x4 lo, s16x4 hi) { return __builtin_shufflevector(lo, hi, 0, 1, 2, 3, 4, 5, 6, 7); }
__device__ __forceinline__ bf16x8 u4_as_frag(v4u w) { return __builtin_bit_cast(bf16x8, w); }
__device__ __forceinline__ float wave_sum(float v) {
#pragma unroll
    for (int o = 1; o < 64; o <<= 1) v += __shfl_xor(v, o);
    return v;
}
__device__ __forceinline__ float logsig_acc(float x) { return fminf(x, 0.f) - log1pf(expf(-fabsf(x))); }
__device__ __forceinline__ float logsig_fast(float x) { return fminf(x, 0.f) - __logf(1.f + __expf(-fabsf(x))); }
__device__ __forceinline__ float fexp2(float x) { return __builtin_amdgcn_exp2f(x); }
__device__ __forceinline__ float flog2(float x) { return __builtin_amdgcn_logf(x); }
__device__ __forceinline__ float frcp(float x) { return __builtin_amdgcn_rcpf(x); }
__device__ __forceinline__ float sigmoid_fast(float x) { return frcp(1.f + fexp2(-1.4426950408889634f * x)); }
__device__ __forceinline__ float xor16f(float x, int fq) { const unsigned u = __float_as_uint(x); const auto r = __builtin_amdgcn_permlane16_swap(u, u, false, false); return __uint_as_float((fq & 1) ? r[0] : r[1]); }
__device__ __forceinline__ float xor32f(float x, int fq) { const unsigned u = __float_as_uint(x); const auto r = __builtin_amdgcn_permlane32_swap(u, u, false, false); return __uint_as_float((fq & 2) ? r[0] : r[1]); }
__device__ __forceinline__ bf16x8 tr_frag(const LAS bf16* tile, int ld, int lane) {
    const int g = lane >> 4, li = lane & 15, q = li >> 2, p = li & 3;
    const LAS bf16* a = tile + (8 * g + q) * ld + 4 * p;
    const s16x4 lo = __builtin_amdgcn_ds_read_tr16_b64_v4i16((LAS s16x4*)a);
    const s16x4 hi = __builtin_amdgcn_ds_read_tr16_b64_v4i16((LAS s16x4*)(a + 4 * ld));
    return cat8(lo, hi);
}
struct Args { const float* in[28]; float* out; unsigned char* ws; int ph_lo, ph_hi; };
#define XB_TMO      128
#define XB_XCNT(j)  (256  + 64 * (j))
#define XB_XSUB(j)  (1280 + 64 * (j))
#define XB_XGEN(j)  (2304 + 64 * (j))
#define XB_TOP      3328
#define XB_TOPGEN   3392
#define XCD_BAR_WORDS 3456
#define XB_SPIN_CAP (1u << 18)

__device__ __forceinline__ unsigned xb_ld(unsigned* p)              { return __hip_atomic_load(p, __ATOMIC_RELAXED, __HIP_MEMORY_SCOPE_AGENT); }
__device__ __forceinline__ unsigned xb_add(unsigned* p, unsigned v) { return __hip_atomic_fetch_add(p, v, __ATOMIC_RELAXED, __HIP_MEMORY_SCOPE_AGENT); }
__device__ __forceinline__ unsigned xb_xcc_id() { return (unsigned)__builtin_amdgcn_s_getreg((3 << 11) | 20) & 0xFu; }
#define XB_SPIN(cond, bar) do { unsigned _sp = 0; while (cond) { __builtin_amdgcn_s_sleep(1); \
    if ((++_sp & 255u) == 0u) { if (xb_ld(&(bar)[XB_TMO])) break; if (_sp > XB_SPIN_CAP) { atomicAdd(&(bar)[XB_TMO], 1u); break; } } } } while (0)

struct XcdBarrier {
    unsigned* bar; unsigned x;
    volatile LAS unsigned* st;
};

__device__ __forceinline__ XcdBarrier xcd_barrier_post(unsigned* bar, volatile LAS unsigned* st) {
    XcdBarrier b; b.bar = bar; b.x = xb_xcc_id(); b.st = st;
    if (threadIdx.x == 0) (void)xb_add(&bar[XB_XCNT(b.x)], 1u);
    return b;
}
__device__ __forceinline__ void xcd_barrier_complete(unsigned* bar, unsigned x, unsigned& nloc, unsigned& nx) {
    const unsigned G = gridDim.x * gridDim.y * gridDim.z;
    unsigned sum, cnt, mine, sp = 0u;
    for (;;) {
        sum = 0u; cnt = 0u; mine = 0u;
#pragma unroll
        for (unsigned j = 0; j < 16; ++j) { const unsigned c = xb_ld(&bar[XB_XCNT(j)]); sum += c; cnt += (c > 0u) ? 1u : 0u; mine = (j == x) ? c : mine; }
        if (sum == G) break;
        __builtin_amdgcn_s_sleep(1);
        if ((++sp & 255u) == 0u) { if (xb_ld(&bar[XB_TMO])) break; if (sp > XB_SPIN_CAP) { atomicAdd(&bar[XB_TMO], 1u); break; } }
    }
    nloc = mine > 0u ? mine : 1u; nx = cnt > 0u ? cnt : 1u;
}

__device__ __forceinline__ void xcd_barrier(const XcdBarrier& b) {
    asm volatile("s_waitcnt vmcnt(0)" ::: "memory");
    __syncthreads();
    if (threadIdx.x == 0) {
        unsigned* bar = b.bar;
        __builtin_amdgcn_s_waitcnt(0);
        unsigned nloc = b.st[0], nx = b.st[1];
        if (nloc == 0u) { xcd_barrier_complete(bar, b.x, nloc, nx); b.st[0] = nloc; b.st[1] = nx; }
        const unsigned old = xb_add(&bar[XB_XSUB(b.x)], 1u);
        const unsigned gen = old / nloc;
        if (old + 1u == (gen + 1u) * nloc) {
            __builtin_amdgcn_fence(__ATOMIC_RELEASE, "agent");
            asm volatile("s_waitcnt vmcnt(0)" ::: "memory");
            const unsigned og = xb_add(&bar[XB_TOP], 1u);
            const unsigned tg = og / nx;
            if (og + 1u == (tg + 1u) * nx) xb_add(&bar[XB_TOPGEN], 1u);
            else XB_SPIN(xb_ld(&bar[XB_TOPGEN]) == tg, bar);
            __builtin_amdgcn_fence(__ATOMIC_ACQUIRE, "agent");
            xb_add(&bar[XB_XGEN(b.x)], 1u);
            asm volatile("s_waitcnt vmcnt(0)" ::: "memory");
        } else {
            XB_SPIN(xb_ld(&bar[XB_XGEN(b.x)]) == gen, bar);
            __builtin_amdgcn_fence(__ATOMIC_ACQUIRE, "agent");
            asm volatile("s_waitcnt vmcnt(0)" ::: "memory");
        }
    }
    __syncthreads();
}


__device__ __forceinline__ void tr_load(const float* src, int N, f32x4 (&v)[16], int lane) {
    const int r4 = lane >> 4, c4 = (lane & 15) * 4;
#pragma unroll
    for (int i = 0; i < 16; ++i) v[i] = *(const f32x4*)(src + (size_t)(4 * i + r4) * N + c4);
}
__device__ __forceinline__ void tr_to_lds(const f32x4 (&v)[16], LAS float* scr, int lane) {
    const int r4 = lane >> 4, c4 = (lane & 15) * 4;
#pragma unroll
    for (int i = 0; i < 16; ++i) { LAS float* s = scr + (4 * i + r4) * 65 + c4; s[0] = v[i].x; s[1] = v[i].y; s[2] = v[i].z; s[3] = v[i].w; }
    LDS_WAIT(); asm volatile("" ::: "memory");
}
__device__ __forceinline__ void tr_store(bf16* dst, int K, const LAS float* scr, int lane) {
    const int c = lane & 7;
#pragma unroll
    for (int j = 0; j < 8; ++j) { const int n = (lane >> 3) + 8 * j; const LAS float* s = scr + (8 * c) * 65 + n;
        v4u o; o.x = pk2(s[0], s[65]); o.y = pk2(s[130], s[195]); o.z = pk2(s[260], s[325]); o.w = pk2(s[390], s[455]);
        *(v4u*)(dst + (size_t)n * K + 8 * c) = o; }
    LDS_WAIT(); asm volatile("" ::: "memory");
}
struct Seg { int in_idx, src_l, N, K, scol, ncols, layer, wsub_mib, drow, ilv; };
__device__ __forceinline__ Seg seg_at(int i) {
    constexpr Seg segs[26] = {
        {4, 0, ABIN, DM, 0, 1024, 0, 0, 0, 0}, {4, 0, ABIN, DM, 1024, 1024, 0, 0, 1024, 0}, {4, 0, ABIN, DM, 4096, 2048, 0, 0, 2048, 0},
        {4, 0, ABIN, DM, 6152, 1024, 0, 0, 4096, 0}, {4, 0, ABIN, DM, 7176, 1024, 0, 0, 5120, 0}, {4, 0, ABIN, DM, 10248, 2048, 0, 0, 6144, 0},
        {4, 0, ABIN, DM, 2048, 2048, 0, 66, 0, 0}, {4, 0, ABIN, DM, 8200, 2048, 0, 66, 2048, 0},
        {11, 0, DM, DM, 0, DM, 0, 98, 0, 0},
        {17, 0, XAW, DM, 0, XAW, 0, 130, 0, 0}, {18, 0, XAW, DM, 0, XAW, 0, 138, 0, 0}, {19, 0, XAW, DM, 0, XAW, 0, 146, 0, 0}, {20, 0, DM, XAW, 0, DM, 0, 154, 0, 0},
        {23, 0, FF, DM, 0, FF, 0, 162, 0, 1}, {24, 0, FF, DM, 0, FF, 0, 162, 128, 1}, {27, 0, DM, FF, 0, DM, 0, 334, 0, 0},
        {12, 0, 3 * DM, DM, 0, 2 * DM, 1, 0, 0, 0}, {12, 0, 3 * DM, DM, 2 * DM, DM, 1, 66, 0, 0},
        {13, 0, DM, DM, 0, DM, 1, 98, 0, 0},
        {17, 1, XAW, DM, 0, XAW, 1, 130, 0, 0}, {18, 1, XAW, DM, 0, XAW, 1, 138, 0, 0}, {19, 1, XAW, DM, 0, XAW, 1, 146, 0, 0}, {20, 1, DM, XAW, 0, DM, 1, 154, 0, 0},
        {23, 1, FF, DM, 0, FF, 1, 162, 0, 1}, {24, 1, FF, DM, 0, FF, 1, 162, 128, 1}, {27, 1, DM, FF, 0, DM, 1, 334, 0, 0}};
    return segs[i];
}
__device__ __forceinline__ void convert_segments(const Args& args, unsigned char* ws, LAS unsigned char* lds, int seg_lo, int seg_hi, int part_lo, int part_hi, int nparts, int wid, int nw, int wave, int lane) {
    LAS float* scr = (LAS float*)(lds + wave * 16640);
#pragma unroll 1
    for (int sI = seg_lo; sI < seg_hi; ++sI) {
        const Seg sg = seg_at(sI);
        const int nblk = sg.ncols / 64, nit = (sg.K / 64) * nblk;
        const float* W = args.in[sg.in_idx] + (size_t)sg.src_l * sg.K * sg.N;
        bf16* WT = (bf16*)(ws + WS_W + (size_t)sg.layer * LAYER_W + (size_t)sg.wsub_mib * MiB);
        const int it_lo = (int)((long)nit * part_lo / nparts), it_hi = (int)((long)nit * part_hi / nparts);
        int it = it_lo + wid;
        f32x4 v[16];
        if (it < it_hi) { const int kb = it / nblk, nb = it - kb * nblk; tr_load(W + (size_t)(64 * kb) * sg.N + sg.scol + 64 * nb, sg.N, v, lane); }
#pragma unroll 1
        for (; it < it_hi; it += nw) {
            const int kb = it / nblk, nb = it - kb * nblk;
            const int drow = sg.ilv ? (256 * (nb >> 1) + 64 * (nb & 1) + sg.drow) : (sg.drow + 64 * nb);
            tr_to_lds(v, scr, lane);
            const int itn = it + nw;
            if (itn < it_hi) { const int kbn = itn / nblk, nbn = itn - kbn * nblk; tr_load(W + (size_t)(64 * kbn) * sg.N + sg.scol + 64 * nbn, sg.N, v, lane); }
            tr_store(WT + (size_t)drow * sg.K + 64 * kb, sg.K, scr, lane);
        }
    }
}
#ifndef RIDER_ON
#define RIDER_ON 1
#endif
constexpr int SEG_SB = 18, SEG_DEFER = 23, SEG_END = 26, XA_BUSY_WGS = 136, GU_BUSY_WGS = 192;
__device__ __forceinline__ void p0_prologue(const Args& args, unsigned char* ws, LAS unsigned char* lds, int gw, int NGW, int wave, int lane, bool defer) {
    convert_segments(args, ws, lds, 0, defer ? (RIDER_ON ? SEG_SB : SEG_DEFER) : SEG_END, 0, 1, 1, gw, NGW, wave, lane);
    {
        const float* W = args.in[4]; bf16* WT = (bf16*)(ws + WS_W + WO_MAIN) + (size_t)8192 * DM;
        for (int idx = gw * 64 + lane; idx < 256 * DM; idx += NGW * 64) {
            const int i = idx >> 12, k = idx & (DM - 1);
            float v = 0.f;
            if (i < 24) { const int col = i < 4 ? 6144 + i : (i < 8 ? 6148 + (i - 4) : 12296 + (i - 8)); v = W[(size_t)k * ABIN + col]; }
            WT[idx] = (bf16)f2bf(v);
        }
    }
    for (int r = gw; r < 2 * NMEM; r += NGW) {
        const int l = r >> 8, row = r & 255;
        const float* xr = args.in[1] + (size_t)row * DM; const float* g = args.in[16] + (size_t)l * DM;
        bf16* o = (bf16*)(ws + WS_MEMN) + (size_t)r * DM;
        f32x4 v[16]; float ss = 0.f;
#pragma unroll
        for (int j = 0; j < 16; ++j) { v[j] = *(const f32x4*)(xr + 4 * lane + 256 * j); ss += v[j].x * v[j].x + v[j].y * v[j].y + v[j].z * v[j].z + v[j].w * v[j].w; }
        const float rstd = rsqrtf(wave_sum(ss) * (1.f / DM) + EPS);
#pragma unroll
        for (int j = 0; j < 16; ++j) { const f32x4 gg = *(const f32x4*)(g + 4 * lane + 256 * j);
            v2u w; w.x = pk2(v[j].x * rstd * gg.x, v[j].y * rstd * gg.y); w.y = pk2(v[j].z * rstd * gg.z, v[j].w * rstd * gg.w);
            *(v2u*)(o + 4 * lane + 256 * j) = w; }
    }
}

#define LAUNDER8(a, o) asm volatile("" : "+v"(a[o].x), "+v"(a[o].y), "+v"(a[o+1].x), "+v"(a[o+1].y), "+v"(a[o+2].x), "+v"(a[o+2].y), "+v"(a[o+3].x), "+v"(a[o+3].y), \
    "+v"(a[o+4].x), "+v"(a[o+4].y), "+v"(a[o+5].x), "+v"(a[o+5].y), "+v"(a[o+6].x), "+v"(a[o+6].y), "+v"(a[o+7].x), "+v"(a[o+7].y))
#define LAUNDER_ROW(pw, hw) do { LAUNDER8(pw, 0); LAUNDER8(pw, 8); LAUNDER8(hw, 0); LAUNDER8(hw, 8); } while (0)
template <int MODE>
__device__ __forceinline__ void norm_rows(const float* xin, const bf16* hb, const float* gprev, const float* gpost, const float* gpre, float* xout, bf16* xn, float* rs,
                                          LAS unsigned char* lds, int gw, int NGW, int tid, int lane, bf16* xn_out = nullptr, float* rs_out = nullptr) {
    if (!xn_out) { xn_out = xn; rs_out = rs; }
    LAS float* GP = (LAS float*)lds; LAS float* GN = (LAS float*)(lds + 16384); LAS float* GI = (LAS float*)(lds + 32768);
    __syncthreads();
#pragma unroll
    for (int i = 0; i < 2; ++i) { const int o = 4 * (tid + NTHREADS * i);
        if (MODE != 0) { *(LAS f32x4*)(GP + o) = *(const f32x4*)(gpost + o); const f32x4 g = *(const f32x4*)(gprev + o); *(LAS f32x4*)(GI + o) = (f32x4){1.f / g.x, 1.f / g.y, 1.f / g.z, 1.f / g.w}; }
        if (MODE != 2) *(LAS f32x4*)(GN + o) = *(const f32x4*)(gpre + o); }
    __syncthreads();
    const int lo4 = 4 * lane;
#pragma unroll 1
    for (int row = gw; row < SEQ; row += NGW) {
        asm volatile("" ::: "memory");
        if (MODE == 0) {
            const float* xr = xin + (size_t)row * DM; bf16* nw = xn_out + (size_t)row * DM;
            f32x4 xv[16]; float ss = 0.f;
#pragma unroll
            for (int j = 0; j < 16; ++j) { xv[j] = *(const f32x4*)(xr + lo4 + 256 * j); ss += xv[j].x * xv[j].x + xv[j].y * xv[j].y + xv[j].z * xv[j].z + xv[j].w * xv[j].w; }
            const float rstd = rsqrtf(wave_sum(ss) * (1.f / DM) + EPS);
            if (lane == 0) rs_out[row] = rstd;
            asm volatile("" ::: "memory");
#pragma unroll
            for (int j = 0; j < 16; ++j) { const f32x4 g = *(const LAS f32x4*)(GN + lo4 + 256 * j);
                v2u w; w.x = pk2(xv[j].x * rstd * g.x, xv[j].y * rstd * g.y); w.y = pk2(xv[j].z * rstd * g.z, xv[j].w * rstd * g.w);
                *(v2u*)(nw + lo4 + 256 * j) = w; }
        } else {
            const bf16* pr = xn + (size_t)row * DM; bf16* pw_out = xn_out + (size_t)row * DM; const bf16* hr = hb + (size_t)row * DM;
            v2u pw[16], hw[16]; float ss = 0.f;
#pragma unroll
            for (int j = 0; j < 16; ++j) { pw[j] = *(const v2u*)(pr + lo4 + 256 * j); hw[j] = *(const v2u*)(hr + lo4 + 256 * j); }
            const float ri = 1.f / rs[row];
#pragma unroll
            for (int j = 0; j < 16; ++j) { const float a = bflo(hw[j].x), b = bfhi(hw[j].x), c = bflo(hw[j].y), d = bfhi(hw[j].y); ss += a * a + b * b + c * c + d * d; }
            const float rstd = rsqrtf(wave_sum(ss) * (1.f / DM) + EPS);
            asm volatile("" ::: "memory");
            LAUNDER_ROW(pw, hw);
            float ss2 = 0.f;
#pragma unroll
            for (int j = 0; j < 16; ++j) { const f32x4 g = *(const LAS f32x4*)(GP + lo4 + 256 * j), gi = *(const LAS f32x4*)(GI + lo4 + 256 * j);
                f32x4 x;
                x.x = bflo(pw[j].x) * ri * gi.x + bflo(hw[j].x) * rstd * g.x; x.y = bfhi(pw[j].x) * ri * gi.y + bfhi(hw[j].x) * rstd * g.y;
                x.z = bflo(pw[j].y) * ri * gi.z + bflo(hw[j].y) * rstd * g.z; x.w = bfhi(pw[j].y) * ri * gi.w + bfhi(hw[j].y) * rstd * g.w;
                if (MODE == 2) *(f32x4*)(xout + (size_t)row * DM + lo4 + 256 * j) = x;
                else ss2 += x.x * x.x + x.y * x.y + x.z * x.z + x.w * x.w;
                if (j & 1) __builtin_amdgcn_sched_barrier(0); }
            if (MODE == 1) {
                const float rstd2 = rsqrtf(wave_sum(ss2) * (1.f / DM) + EPS);
                if (lane == 0) rs_out[row] = rstd2;
                LAUNDER_ROW(pw, hw);
                float ri2 = ri, rstdb = rstd; asm volatile("" : "+v"(ri2), "+v"(rstdb) :: "memory");
#pragma unroll
                for (int j = 0; j < 16; ++j) { const f32x4 g = *(const LAS f32x4*)(GP + lo4 + 256 * j), gi = *(const LAS f32x4*)(GI + lo4 + 256 * j), gn = *(const LAS f32x4*)(GN + lo4 + 256 * j);
                    f32x4 x;
                    x.x = bflo(pw[j].x) * ri2 * gi.x + bflo(hw[j].x) * rstdb * g.x; x.y = bfhi(pw[j].x) * ri2 * gi.y + bfhi(hw[j].x) * rstdb * g.y;
                    x.z = bflo(pw[j].y) * ri2 * gi.z + bflo(hw[j].y) * rstdb * g.z; x.w = bfhi(pw[j].y) * ri2 * gi.w + bfhi(hw[j].y) * rstdb * g.w;
                    v2u w; w.x = pk2(x.x * rstd2 * gn.x, x.y * rstd2 * gn.y); w.y = pk2(x.z * rstd2 * gn.z, x.w * rstd2 * gn.w);
                    *(v2u*)(pw_out + lo4 + 256 * j) = w;
                    if (j & 1) __builtin_amdgcn_sched_barrier(0); }
            }
        }
    }
}

__device__ __forceinline__ void gates_minigemm(unsigned char* ws, LAS unsigned char* lds, int bx, int G, int tid, int wave, int lane) {
    const bf16* XNp = (const bf16*)(ws + WS_XN); const bf16* WG = (const bf16*)(ws + WS_W + WO_MAIN) + (size_t)8192 * DM; float* GT = (float*)(ws + WS_GATES);
    LAS f32x4* RED = (LAS f32x4*)lds;
#pragma unroll 1
    for (int blk = bx; blk < SEQ / 32; blk += G) {
        asm volatile("" : "+v"(lane));
        const int fr = lane & 15, fq = lane >> 4;
        const int t0 = 32 * blk;
        f32x4 acc[2][2];
#pragma unroll
        for (int a = 0; a < 2; ++a)
#pragma unroll
            for (int b = 0; b < 2; ++b) acc[a][b] = (f32x4){0.f, 0.f, 0.f, 0.f};
        const int lo = fr * DM + 8 * fq;
        const bf16* ap = (XNp + (size_t)t0 * DM + wave * 512) + lo; const bf16* bp = (WG + wave * 512) + lo;
#pragma unroll 4
        for (int ks = 0; ks < 16; ++ks) {
            const bf16x8 a0 = *(const bf16x8*)(ap + 32 * ks), a1 = *(const bf16x8*)(ap + (size_t)16 * DM + 32 * ks);
            const bf16x8 b0 = *(const bf16x8*)(bp + 32 * ks), b1 = *(const bf16x8*)(bp + (size_t)16 * DM + 32 * ks);
            acc[0][0] = mma(b0, a0, acc[0][0]); acc[0][1] = mma(b1, a0, acc[0][1]); acc[1][0] = mma(b0, a1, acc[1][0]); acc[1][1] = mma(b1, a1, acc[1][1]);
        }
        __syncthreads();
#pragma unroll
        for (int a = 0; a < 2; ++a)
#pragma unroll
            for (int b = 0; b < 2; ++b) RED[(wave * 4 + a * 2 + b) * 64 + lane] = acc[a][b];
        __syncthreads();
        if (tid < 256) { const int tile = tid >> 6, l = tid & 63, rt = tile >> 1, ct = tile & 1; f32x4 s = {0.f, 0.f, 0.f, 0.f};
#pragma unroll
            for (int w = 0; w < 8; ++w) s = s + RED[(w * 4 + tile) * 64 + l];
            *(f32x4*)(GT + (size_t)(t0 + 16 * rt + (l & 15)) * 32 + 16 * ct + 4 * (l >> 4)) = s; }
    }
}

__device__ __forceinline__ float scan_sum(float x, int lane) {
#pragma unroll
    for (int o = 1; o < 64; o <<= 1) { const float y = __shfl_up(x, o); if (lane >= o) x += y; }
    return x;
}
__device__ __forceinline__ float scan_max(float x, int lane) {
#pragma unroll
    for (int o = 1; o < 64; o <<= 1) { const float y = __shfl_up(x, o); if (lane >= o) x = fmaxf(x, y); }
    return x;
}
__device__ __forceinline__ void mlstm_local(const float* gates, float* mls, float bi, float bfb, int h, int c, int lane, LAS float* stash) {
    const int t = c * 64 + lane;
    const float mi = gates[(size_t)t * 32 + h], mf = gates[(size_t)t * 32 + 4 + h];
    const float li = 15.f * tanhf((mi + bi) * (1.f / 15.f)), fp = 15.f * tanhf((mf + bfb) * (1.f / 15.f));
    const float lf = logsig_acc(fp);
    const float bcum = scan_sum(lf, lane);
    const float a = li - bcum;
    const float pm = scan_max(a, lane);
    mls[MLS_A + h * SEQ + t] = a; mls[MLS_PM + h * SEQ + t] = pm; mls[MLS_BC + h * SEQ + t] = bcum;
    if (lane == 63) { mls[MLS_CHB + h * NCH + c] = bcum; mls[MLS_CHP + h * NCH + c] = pm; stash[64] = pm; stash[65] = bcum; }
    stash[lane] = a;
}

constexpr int TL = 264;
constexpr int NPAIR = 64;
__device__ __forceinline__ void gla_g_chunk(const Args& args, const float* gates, float* G, LAS float* GS, LAS float* GRS, int c, int head, int tid) {
    if (tid < 256) { const int t = tid >> 2, r4 = (tid & 3) * 4; *(LAS f32x4*)(GRS + t * 16 + r4) = *(const f32x4*)(gates + (size_t)(c * 64 + t) * 32 + 8 + r4); }
    __syncthreads();
    const int d = tid & 255, half = tid >> 8, col = head * 256 + d;
    float w[16];
#pragma unroll
    for (int r = 0; r < 16; ++r) w[r] = args.in[8][r * 1024 + col];
    const float b = args.in[9][col];
    float acc = 0.f;
#pragma unroll 4
    for (int tt = 0; tt < 32; ++tt) { const int t = 32 * half + tt;
        float z = b;
#pragma unroll
        for (int q4 = 0; q4 < 4; ++q4) { const f32x4 g4 = *(const LAS f32x4*)(GRS + t * 16 + 4 * q4); z += g4.x * w[4 * q4] + g4.y * w[4 * q4 + 1] + g4.z * w[4 * q4 + 2] + g4.w * w[4 * q4 + 3]; }
        acc += (fminf(z, 0.f) - 0.6931471805599453f * flog2(1.f + fexp2(-1.4426950408889634f * fabsf(z)))) * 0.0625f;
        GS[t * 256 + d] = acc; }
    __syncthreads();
    const float add = half ? GS[31 * 256 + d] : 0.f;
#pragma unroll 4
    for (int tt = 0; tt < 32; ++tt) { const int t = 32 * half + tt; const float gv = GS[t * 256 + d] + add;
        if (half) GS[t * 256 + d] = gv;
        G[(size_t)(c * 64 + t) * 1024 + col] = gv; }
    __syncthreads();
}
__device__ __forceinline__ void dc_unit(const Args& args, unsigned char* ws, LAS unsigned char* lds, int u, int tid, int wave, int lane) {
    asm volatile("" : "+v"(lane), "+v"(tid));
    const int mixer = u >> 8, pair = (u >> 2) & 63, head = u & 3;
    const bf16* PROJ = (const bf16*)(ws + WS_PROJ); const bf16* VT = (const bf16*)(ws + WS_VT);
    const float* gates = (const float*)(ws + WS_GATES);
    LAS bf16* KS = (LAS bf16*)lds;
    LAS float* GS = (LAS float*)(lds + 68608);
    LAS float* GRS = (LAS float*)(lds + 137216);
    LAS float* GLB = (LAS float*)(lds + 141312);
    const int kcol = (mixer ? 5120 : 1024) + head * 256;
    const int tok0 = 128 * pair;
    __syncthreads();
    if (mixer == 0) {
        if (wave < 2) mlstm_local(gates, (float*)(ws + WS_MLS), args.in[5][head], args.in[6][head], head, 2 * pair + wave, lane, GS + 128 * wave);
        __syncthreads();
        const float blA = GS[65], pmP = fmaxf(GS[64], GS[128 + 64] - blA);
#pragma unroll
        for (int i = 0; i < 8; ++i) {
            const int q = tid + 512 * i, s = q >> 5, d0 = (q & 31) * 8;
            const v4u kw = *(const v4u*)(PROJ + (size_t)(tok0 + s) * 8192 + kcol + d0);
            const float aa = (s < 64) ? GS[s] : (GS[128 + s - 64] - blA);
            const float w = fexp2(1.4426950408889634f * (aa - pmP)) * 0.0625f;
            v4u o; o.x = pk2(bflo(kw.x) * w, bfhi(kw.x) * w); o.y = pk2(bflo(kw.y) * w, bfhi(kw.y) * w); o.z = pk2(bflo(kw.z) * w, bfhi(kw.z) * w); o.w = pk2(bflo(kw.w) * w, bfhi(kw.w) * w);
            *(LAS v4u*)(KS + s * TL + d0) = o;
        }
    } else {
        float* G = (float*)(ws + WS_GG);
        gla_g_chunk(args, gates, G, GS, GRS, 2 * pair + 1, head, tid);
        if (tid < 256) GLB[tid] = GS[63 * 256 + tid];
#pragma unroll
        for (int i = 0; i < 4; ++i) {
            const int q = tid + 512 * i, s = q >> 5, d0 = (q & 31) * 8;
            const v4u kw = *(const v4u*)(PROJ + (size_t)(tok0 + 64 + s) * 8192 + kcol + d0);
            const f32x4 a0 = *(const LAS f32x4*)(GS + 63 * 256 + d0), a1 = *(const LAS f32x4*)(GS + 63 * 256 + d0 + 4), b0 = *(const LAS f32x4*)(GS + s * 256 + d0), b1 = *(const LAS f32x4*)(GS + s * 256 + d0 + 4);
            v4u o; o.x = pk2(bflo(kw.x) * __expf(a0.x - b0.x), bfhi(kw.x) * __expf(a0.y - b0.y)); o.y = pk2(bflo(kw.y) * __expf(a0.z - b0.z), bfhi(kw.y) * __expf(a0.w - b0.w));
            o.z = pk2(bflo(kw.z) * __expf(a1.x - b1.x), bfhi(kw.z) * __expf(a1.y - b1.y)); o.w = pk2(bflo(kw.w) * __expf(a1.z - b1.z), bfhi(kw.w) * __expf(a1.w - b1.w));
            *(LAS v4u*)(KS + (64 + s) * TL + d0) = o;
        }
        __syncthreads();
        gla_g_chunk(args, gates, G, GS, GRS, 2 * pair, head, tid);
#pragma unroll
        for (int i = 0; i < 4; ++i) {
            const int q = tid + 512 * i, s = q >> 5, d0 = (q & 31) * 8;
            const v4u kw = *(const v4u*)(PROJ + (size_t)(tok0 + s) * 8192 + kcol + d0);
            const f32x4 a0 = *(const LAS f32x4*)(GS + 63 * 256 + d0), a1 = *(const LAS f32x4*)(GS + 63 * 256 + d0 + 4), b0 = *(const LAS f32x4*)(GS + s * 256 + d0), b1 = *(const LAS f32x4*)(GS + s * 256 + d0 + 4);
            const f32x4 c0 = *(const LAS f32x4*)(GLB + d0), c1 = *(const LAS f32x4*)(GLB + d0 + 4);
            v4u o; o.x = pk2(bflo(kw.x) * __expf(a0.x - b0.x + c0.x), bfhi(kw.x) * __expf(a0.y - b0.y + c0.y)); o.y = pk2(bflo(kw.y) * __expf(a0.z - b0.z + c0.z), bfhi(kw.y) * __expf(a0.w - b0.w + c0.w));
            o.z = pk2(bflo(kw.z) * __expf(a1.x - b1.x + c1.x), bfhi(kw.z) * __expf(a1.y - b1.y + c1.y)); o.w = pk2(bflo(kw.w) * __expf(a1.z - b1.z + c1.z), bfhi(kw.w) * __expf(a1.w - b1.w + c1.w));
            *(LAS v4u*)(KS + s * TL + d0) = o;
        }
    }
    __syncthreads();
    const int fr = lane & 15, fq = lane >> 4;
    bf16* ST = (bf16*)(ws + WS_STATE) + ((size_t)((mixer * 4 + head) * NPAIR + pair)) * (512 * 256);
    const int vrow0 = mixer * 2048 + head * 512 + wave * 64;
    LAS bf16* OS = (LAS bf16*)(lds + 68608 + wave * 8448);
#pragma unroll 1
    for (int vt = 0; vt < 4; ++vt) {
        const bf16* vp = (VT + (size_t)(vrow0 + 16 * vt) * 8192 + tok0) + (fr * 8192 + 8 * fq);
        const bf16x8 b0 = *(const bf16x8*)vp, b1 = *(const bf16x8*)(vp + 32), b2 = *(const bf16x8*)(vp + 64), b3 = *(const bf16x8*)(vp + 96);
#pragma unroll 4
        for (int dt = 0; dt < 16; ++dt) {
            f32x4 acc = {0.f, 0.f, 0.f, 0.f};
            acc = mma(tr_frag(KS + 16 * dt, TL, lane), b0, acc); acc = mma(tr_frag(KS + 32 * TL + 16 * dt, TL, lane), b1, acc);
            acc = mma(tr_frag(KS + 64 * TL + 16 * dt, TL, lane), b2, acc); acc = mma(tr_frag(KS + 96 * TL + 16 * dt, TL, lane), b3, acc);
            v2u w; w.x = pk2(acc[0], acc[1]); w.y = pk2(acc[2], acc[3]);
            *(LAS v2u*)(OS + fr * 264 + 16 * dt + 4 * fq) = w;
        }
        LDS_WAIT(); asm volatile("" ::: "memory");
        bf16* op = ST + (size_t)(wave * 64 + 16 * vt) * 256;
#pragma unroll
        for (int i = 0; i < 8; ++i) { const int rr = 2 * i + (lane >> 5), cc = (lane & 31) * 8;
            *(v4u*)(op + rr * 256 + cc) = *(const LAS v4u*)(OS + rr * 264 + cc); }
        LDS_WAIT(); asm volatile("" ::: "memory");
    }
    if (mixer == 0 && tid < 256) {
        float s = 0.f;
#pragma unroll 8
        for (int t = 0; t < 128; ++t) s += __uint_as_float((unsigned)KS[t * TL + tid] << 16);
        ((float*)(ws + WS_NST))[(size_t)(head * NPAIR + pair) * 256 + tid] = s;
    }
}

__device__ __forceinline__ void scan_phase(unsigned char* ws, int T0, int TS, bf16* dummy_out = nullptr) {
    const float* G = (const float*)(ws + WS_GG); const float* mls = (const float*)(ws + WS_MLS); float* mlsw = (float*)(ws + WS_MLS);
#pragma unroll 1
    for (int T = T0; T < 131072; T += TS) {
        const int mixer = T >> 16, head = (T >> 14) & 3, v = (T >> 5) & 511, d0 = (T & 31) * 8;
        bf16* base = (bf16*)(ws + WS_STATE) + ((size_t)((mixer * 4 + head) * NPAIR)) * (512 * 256) + (size_t)v * 256 + d0;
        float C[8]; float mrun = 0.f;
#pragma unroll
        for (int e = 0; e < 8; ++e) C[e] = 0.f;
#pragma unroll 1
        for (int p0 = 0; p0 < NPAIR; p0 += 8) {
            v4u x[8]; float dec[8][8]; float cor[8] = {1.f, 1.f, 1.f, 1.f, 1.f, 1.f, 1.f, 1.f};
#pragma unroll
            for (int i = 0; i < 8; ++i) x[i] = *(const v4u*)(base + (size_t)(p0 + i) * (512 * 256));
#pragma unroll
            for (int i = 0; i < 8; ++i) { const int cA = 2 * (p0 + i);
                if (mixer == 0) { const float blA = mls[MLS_CHB + head * NCH + cA], blB = mls[MLS_CHB + head * NCH + cA + 1];
                    const float pmP = fmaxf(mls[MLS_CHP + head * NCH + cA], mls[MLS_CHP + head * NCH + cA + 1] - blA), m63 = fmaxf(pmP, mrun);
                    const float dd = __expf(mrun - m63); cor[i] = __expf(pmP - m63);
                    if (v == 0 && d0 == 0 && !dummy_out) mlsw[MLS_MC + head * NCH + p0 + i] = mrun;
                    mrun = (blA + blB) + m63;
#pragma unroll
                    for (int e = 0; e < 8; ++e) dec[i][e] = dd; }
                else { const float* ga = G + (size_t)(cA * 64 + 63) * 1024 + head * 256 + d0; const float* gb = ga + (size_t)64 * 1024;
                    const f32x4 a0 = *(const f32x4*)ga, a1 = *(const f32x4*)(ga + 4), b0 = *(const f32x4*)gb, b1 = *(const f32x4*)(gb + 4);
                    dec[i][0] = __expf(a0.x + b0.x); dec[i][1] = __expf(a0.y + b0.y); dec[i][2] = __expf(a0.z + b0.z); dec[i][3] = __expf(a0.w + b0.w);
                    dec[i][4] = __expf(a1.x + b1.x); dec[i][5] = __expf(a1.y + b1.y); dec[i][6] = __expf(a1.z + b1.z); dec[i][7] = __expf(a1.w + b1.w); }
            }
#pragma unroll
            for (int i = 0; i < 8; ++i) {
                v4u o; o.x = pk2(C[0], C[1]); o.y = pk2(C[2], C[3]); o.z = pk2(C[4], C[5]); o.w = pk2(C[6], C[7]);
                *(v4u*)((dummy_out ? dummy_out + (base - (bf16*)(ws + WS_STATE)) : base) + (size_t)(p0 + i) * (512 * 256)) = o;
                C[0] = dec[i][0] * C[0] + cor[i] * bflo(x[i].x); C[1] = dec[i][1] * C[1] + cor[i] * bfhi(x[i].x); C[2] = dec[i][2] * C[2] + cor[i] * bflo(x[i].y); C[3] = dec[i][3] * C[3] + cor[i] * bfhi(x[i].y);
                C[4] = dec[i][4] * C[4] + cor[i] * bflo(x[i].z); C[5] = dec[i][5] * C[5] + cor[i] * bfhi(x[i].z); C[6] = dec[i][6] * C[6] + cor[i] * bflo(x[i].w); C[7] = dec[i][7] * C[7] + cor[i] * bfhi(x[i].w);
            }
        }
    }
    if (!dummy_out) for (int T = T0; T < 1024; T += TS) {
        const int head = T >> 8, d = T & 255; float* np = (float*)(ws + WS_NST) + (size_t)head * NPAIR * 256 + d; float n = 0.f, mrun = 0.f;
#pragma unroll 1
        for (int p = 0; p < NPAIR; ++p) { const float x = np[p * 256]; np[p * 256] = n;
            const float blA = mls[MLS_CHB + head * NCH + 2 * p], blB = mls[MLS_CHB + head * NCH + 2 * p + 1];
            const float pmP = fmaxf(mls[MLS_CHP + head * NCH + 2 * p], mls[MLS_CHP + head * NCH + 2 * p + 1] - blA), m63 = fmaxf(pmP, mrun);
            n = __expf(mrun - m63) * n + __expf(pmP - m63) * x; mrun = (blA + blB) + m63; }
    }
}

constexpr int PLP = 136;
constexpr int HTP = 516;
__device__ __forceinline__ int mixout_chunk(int u) { int c = (u >> 2) & 127; c = (c & ~3) | ((c & 1) << 1) | ((c >> 1) & 1); return c ^ (c >> 6); }
template <bool ODD>
__device__ __forceinline__ void mixout_unit(const Args& args, unsigned char* ws, LAS unsigned char* lds, int u, int tid, int wave, int lane) {
    asm volatile("" : "+v"(lane), "+v"(tid));
    constexpr int NK = ODD ? 128 : 64, KOFF = ODD ? 64 : 0, NST2 = NK / 32;
    const int mixer = u >> 9, chunk = mixout_chunk(u), head = u & 3, pair = chunk >> 1;
    const bf16* PROJ = (const bf16*)(ws + WS_PROJ); const bf16* VT = (const bf16*)(ws + WS_VT);
    const float* G = (const float*)(ws + WS_GG); const float* mls = (const float*)(ws + WS_MLS);
    LAS bf16* KS = (LAS bf16*)lds; LAS bf16* QS = (LAS bf16*)(lds + 67584); LAS bf16* PS = (LAS bf16*)(lds + 101376);
    LAS float* HT = (LAS float*)lds;
    LAS float* RDEN = (LAS float*)(lds + 132096); LAS float* SSQ = (LAS float*)(lds + 132352); LAS float* NPREV = (LAS float*)(lds + 134400); LAS float* RSTD = (LAS float*)(lds + 135424);
    const int qcol = (mixer ? 4096 : 0) + head * 256, kcol = (mixer ? 5120 : 1024) + head * 256;
    const int fr = lane & 15, fq = lane >> 4;
    const int tok0 = chunk * 64, tokK0 = tok0 - KOFF;
    float mc = 0.f, minter = 0.f, blA = 0.f;
    if (mixer == 0) { const float mp = mls[MLS_MC + head * NCH + pair];
        if (ODD) { blA = mls[MLS_CHB + head * NCH + chunk - 1]; mc = blA + fmaxf(mls[MLS_CHP + head * NCH + chunk - 1], mp); minter = blA + mp; } else { mc = mp; minter = mp; } }
    __syncthreads();
#pragma unroll
    for (int i = 0; i < 4; ++i) {
        const int q = tid + 512 * i, s = q >> 5, d0 = (q & 31) * 8;
        const v4u kw = *(const v4u*)(PROJ + (size_t)(tok0 + s) * 8192 + kcol + d0);
        const v4u qw = *(const v4u*)(PROJ + (size_t)(tok0 + s) * 8192 + qcol + d0);
        float sk[8], sq[8];
        if (mixer == 0) {
#pragma unroll
            for (int e = 0; e < 8; ++e) { sk[e] = 0.0625f; sq[e] = 1.f; } }
        else { const float* gs = G + (size_t)(tok0 + s) * 1024 + head * 256 + d0; const f32x4 b0 = *(const f32x4*)gs, b1 = *(const f32x4*)(gs + 4);
            const float gg[8] = {b0.x, b0.y, b0.z, b0.w, b1.x, b1.y, b1.z, b1.w};
#pragma unroll
            for (int e = 0; e < 8; ++e) { sq[e] = __expf(gg[e]) * 0.0625f; sk[e] = __expf(-gg[e]); } }
        v4u o; o.x = pk2(bflo(kw.x) * sk[0], bfhi(kw.x) * sk[1]); o.y = pk2(bflo(kw.y) * sk[2], bfhi(kw.y) * sk[3]);
        o.z = pk2(bflo(kw.z) * sk[4], bfhi(kw.z) * sk[5]); o.w = pk2(bflo(kw.w) * sk[6], bfhi(kw.w) * sk[7]);
        *(LAS v4u*)(KS + (KOFF + s) * TL + d0) = o;
        v4u p; p.x = pk2(bflo(qw.x) * sq[0], bfhi(qw.x) * sq[1]); p.y = pk2(bflo(qw.y) * sq[2], bfhi(qw.y) * sq[3]);
        p.z = pk2(bflo(qw.z) * sq[4], bfhi(qw.z) * sq[5]); p.w = pk2(bflo(qw.w) * sq[6], bfhi(qw.w) * sq[7]);
        *(LAS v4u*)(QS + s * TL + d0) = p;
        if (ODD) {
            const v4u cw = *(const v4u*)(PROJ + (size_t)(tokK0 + s) * 8192 + kcol + d0);
            float sc[8];
            if (mixer == 0) {
#pragma unroll
                for (int e = 0; e < 8; ++e) sc[e] = 0.0625f; }
            else { const float* gl = G + (size_t)(tokK0 + 63) * 1024 + head * 256 + d0; const float* gs2 = G + (size_t)(tokK0 + s) * 1024 + head * 256 + d0;
                const f32x4 a0 = *(const f32x4*)gl, a1 = *(const f32x4*)(gl + 4), b0 = *(const f32x4*)gs2, b1 = *(const f32x4*)(gs2 + 4);
                sc[0] = __expf(a0.x - b0.x); sc[1] = __expf(a0.y - b0.y); sc[2] = __expf(a0.z - b0.z); sc[3] = __expf(a0.w - b0.w);
                sc[4] = __expf(a1.x - b1.x); sc[5] = __expf(a1.y - b1.y); sc[6] = __expf(a1.z - b1.z); sc[7] = __expf(a1.w - b1.w); }
            v4u c4; c4.x = pk2(bflo(cw.x) * sc[0], bfhi(cw.x) * sc[1]); c4.y = pk2(bflo(cw.y) * sc[2], bfhi(cw.y) * sc[3]);
            c4.z = pk2(bflo(cw.z) * sc[4], bfhi(cw.z) * sc[5]); c4.w = pk2(bflo(cw.w) * sc[6], bfhi(cw.w) * sc[7]);
            *(LAS v4u*)(KS + s * TL + d0) = c4;
        }
    }
    if (mixer == 0 && tid < 256) NPREV[tid] = ((const float*)(ws + WS_NST))[(size_t)(head * NPAIR + pair) * 256 + tid];
    __syncthreads();
    {
        const int tt = wave >> 1;
        const bool cross = ODD && ((wave & 1) == 0);
#pragma unroll
        for (int h2 = 0; h2 < NST2; ++h2) {
            const int st = NST2 * (wave & 1) + h2;
            f32x4 acc = {0.f, 0.f, 0.f, 0.f};
#pragma unroll
            for (int ks = 0; ks < 8; ++ks) {
                const bf16x8 a = *(const LAS bf16x8*)(KS + (16 * st + fr) * TL + 32 * ks + 8 * fq);
                const bf16x8 b = *(const LAS bf16x8*)(QS + (16 * tt + fr) * TL + 32 * ks + 8 * fq);
                acc = mma(a, b, acc);
            }
            const int t = 16 * tt + fr, r0 = 16 * st + 4 * fq;
            float f[4] = {1.f, 1.f, 1.f, 1.f};
            if (mixer == 0) { const float Mt = fmaxf(mls[MLS_PM + head * SEQ + tok0 + t], mc); const f32x4 av = *(const f32x4*)(mls + MLS_A + head * SEQ + tokK0 + r0);
                const float off = cross ? blA - Mt : -Mt;
                f[0] = __expf(av.x + off); f[1] = __expf(av.y + off); f[2] = __expf(av.z + off); f[3] = __expf(av.w + off); }
            float pv[4];
#pragma unroll
            for (int r = 0; r < 4; ++r) pv[r] = (cross || (r0 - KOFF + r <= t)) ? acc[r] * f[r] : 0.f;
            v2u w; w.x = pk2(pv[0], pv[1]); w.y = pk2(pv[2], pv[3]);
            *(LAS v2u*)(PS + t * PLP + r0) = w;
        }
    }
    __syncthreads();
    if (wave == 0) {
        float rd = 1.f;
        if (mixer == 0) {
            const int t = lane; float di = 0.f, qn = 0.f;
#pragma unroll 8
            for (int s = 0; s < NK; ++s) di += __uint_as_float((unsigned)PS[t * PLP + s] << 16);
#pragma unroll 8
            for (int d = 0; d < 256; ++d) qn += __uint_as_float((unsigned)QS[t * TL + d] << 16) * NPREV[d];
            const float Mt = fmaxf(mls[MLS_PM + head * SEQ + tok0 + t], mc);
            const float den = di + __expf(minter - Mt) * qn;
            rd = 1.f / fmaxf(fabsf(den), __expf(-(mls[MLS_BC + head * SEQ + tok0 + t] + Mt)));
        }
        RDEN[lane] = rd;
    }
    f32x4 acc[4][4];
#pragma unroll
    for (int a = 0; a < 4; ++a)
#pragma unroll
        for (int b = 0; b < 4; ++b) acc[a][b] = (f32x4){0.f, 0.f, 0.f, 0.f};
    const bf16* ST = (const bf16*)(ws + WS_STATE) + ((size_t)((mixer * 4 + head) * NPAIR + pair)) * (512 * 256);
#pragma unroll
    for (int vt = 0; vt < 4; ++vt) {
        bf16x8 af[8];
        const bf16* sp = (ST + (size_t)(wave * 64 + 16 * vt) * 256) + (fr * 256 + 8 * fq);
#pragma unroll
        for (int ks = 0; ks < 8; ++ks) af[ks] = *(const bf16x8*)(sp + 32 * ks);
        if (ODD && mixer == 1) {
            const float* gl = G + (size_t)(tokK0 + 63) * 1024 + head * 256 + 8 * fq;
#pragma unroll
            for (int ks = 0; ks < 8; ++ks) { const f32x4 e0 = *(const f32x4*)(gl + 32 * ks), e1 = *(const f32x4*)(gl + 32 * ks + 4);
                const v4u w = __builtin_bit_cast(v4u, af[ks]);
                v4u o; o.x = pk2(bflo(w.x) * __expf(e0.x), bfhi(w.x) * __expf(e0.y)); o.y = pk2(bflo(w.y) * __expf(e0.z), bfhi(w.y) * __expf(e0.w));
                o.z = pk2(bflo(w.z) * __expf(e1.x), bfhi(w.z) * __expf(e1.y)); o.w = pk2(bflo(w.w) * __expf(e1.z), bfhi(w.w) * __expf(e1.w));
                af[ks] = u4_as_frag(o); }
        }
#pragma unroll
        for (int tt = 0; tt < 4; ++tt)
#pragma unroll
            for (int ks = 0; ks < 8; ++ks) {
                const bf16x8 b = *(const LAS bf16x8*)(QS + (16 * tt + fr) * TL + 32 * ks + 8 * fq);
                acc[vt][tt] = mma(af[ks], b, acc[vt][tt]);
            }
    }
    if (mixer == 0) {
#pragma unroll
        for (int tt = 0; tt < 4; ++tt) { const float it = __expf(minter - fmaxf(mls[MLS_PM + head * SEQ + tok0 + 16 * tt + fr], mc));
#pragma unroll
            for (int vt = 0; vt < 4; ++vt) acc[vt][tt] = acc[vt][tt] * it; }
    }
    const int vrow0 = mixer * 2048 + head * 512 + wave * 64;
#pragma unroll
    for (int vt = 0; vt < 4; ++vt) {
        const bf16* vp = (VT + (size_t)(vrow0 + 16 * vt) * 8192 + tokK0) + (fr * 8192 + 8 * fq);
        bf16x8 a[NK / 32];
#pragma unroll
        for (int ks = 0; ks < NK / 32; ++ks) a[ks] = *(const bf16x8*)(vp + 32 * ks);
#pragma unroll
        for (int tt = 0; tt < 4; ++tt)
#pragma unroll
            for (int ks = 0; ks < NK / 32; ++ks)
                acc[vt][tt] = mma(a[ks], *(const LAS bf16x8*)(PS + (16 * tt + fr) * PLP + 32 * ks + 8 * fq), acc[vt][tt]);
    }
    __syncthreads();
#pragma unroll
    for (int tt = 0; tt < 4; ++tt) {
        const float rd = RDEN[16 * tt + fr]; float q = 0.f;
#pragma unroll
        for (int vt = 0; vt < 4; ++vt) { acc[vt][tt] = acc[vt][tt] * rd; q += acc[vt][tt][0] * acc[vt][tt][0] + acc[vt][tt][1] * acc[vt][tt][1] + acc[vt][tt][2] * acc[vt][tt][2] + acc[vt][tt][3] * acc[vt][tt][3];
            *(LAS f32x4*)(HT + (16 * tt + fr) * HTP + wave * 64 + 16 * vt + 4 * fq) = acc[vt][tt]; }
        q += __shfl_xor(q, 16); q += __shfl_xor(q, 32);
        if (fq == 0) SSQ[wave * 64 + 16 * tt + fr] = q;
    }
    __syncthreads();
    if (tid < 64) { float tot = 0.f;
#pragma unroll
        for (int w = 0; w < 8; ++w) tot += SSQ[w * 64 + tid];
        RSTD[tid] = rsqrtf(tot * (1.f / 512.f) + EPS); }
    __syncthreads();
    const float* hn = args.in[mixer ? 10 : 7] + head * 512;
    const bf16* gp = PROJ + (size_t)tok0 * 8192 + (mixer ? 6144 : 2048) + head * 512;
    bf16* hc = (bf16*)(ws + WS_HC) + (size_t)tok0 * DM + mixer * 2048 + head * 512;
#pragma unroll
    for (int i = 0; i < 8; ++i) {
        const int it = tid + NTHREADS * i, t = it >> 6, v0 = (it & 63) * 8;
        const f32x4 h0 = *(const LAS f32x4*)(HT + t * HTP + v0), h1 = *(const LAS f32x4*)(HT + t * HTP + v0 + 4);
        const f32x4 n0 = *(const f32x4*)(hn + v0), n1 = *(const f32x4*)(hn + v0 + 4);
        const v4u gw4 = *(const v4u*)(gp + (size_t)t * 8192 + v0);
        const float rstd = RSTD[t];
        float gt[8] = {bflo(gw4.x), bfhi(gw4.x), bflo(gw4.y), bfhi(gw4.y), bflo(gw4.z), bfhi(gw4.z), bflo(gw4.w), bfhi(gw4.w)};
#pragma unroll
        for (int r = 0; r < 8; ++r) { const float sg = sigmoid_fast(gt[r]); gt[r] = mixer ? gt[r] * sg : sg; }
        v4u w; w.x = pk2(h0[0] * rstd * n0[0] * gt[0], h0[1] * rstd * n0[1] * gt[1]); w.y = pk2(h0[2] * rstd * n0[2] * gt[2], h0[3] * rstd * n0[3] * gt[3]);
        w.z = pk2(h1[0] * rstd * n1[0] * gt[4], h1[1] * rstd * n1[1] * gt[5]); w.w = pk2(h1[2] * rstd * n1[2] * gt[6], h1[3] * rstd * n1[3] * gt[7]);
        *(v4u*)(hc + (size_t)t * DM + v0) = w;
    }
}

constexpr int SBK_P = 136, SBV_P = 72;
constexpr int SB_KS = 0, SB_VS = 17408, SB_BUF = 35840, SB_FLAGS = 8 * 16640;
__device__ __forceinline__ void stickbreak_phase(const Args& args, unsigned char* ws, LAS unsigned char* lds, int bx, int G, int tid, int wave, int lane) {
    const bf16* QK = (const bf16*)(ws + WS_PROJ); const bf16* VT = (const bf16*)(ws + WS_VT); bf16* HC = (bf16*)(ws + WS_HC);
    const float scale = 0.08838834764831845f * 1.4426950408889634f;
    volatile LAS int* FLAGS = (volatile LAS int*)(lds + SB_FLAGS);
    int iu = 0;
#pragma unroll 1
    for (int U = bx; U < 2048; U += G, ++iu) {
        asm volatile("" : "+v"(lane), "+v"(tid));
        const int fr = lane & 15, fq = lane >> 4;
        const bool rider = RIDER_ON && (G == 256) && (iu < 4);
        f32x4 rv[16]; Seg rsg; int rkb = 0, rnb = 0;
        if (rider) { const int gi = iu * 2048 + bx * NWAVES + wave; const int sI = gi < 4096 ? SEG_SB : SEG_SB + 1 + ((gi - 4096) >> 10); const int it = gi < 4096 ? gi : ((gi - 4096) & 1023);
            rsg = seg_at(sI); const int nblk = rsg.ncols / 64; rkb = it / nblk; rnb = it - rkb * nblk;
            tr_load(args.in[rsg.in_idx] + (size_t)rsg.src_l * rsg.K * rsg.N + (size_t)(64 * rkb) * rsg.N + rsg.scol + 64 * rnb, rsg.N, rv, lane); }
        const int kr0 = tid >> 4, kc0 = (tid & 15) * 8;
        const int vr0 = tid >> 3, vc0 = (tid & 7) * 8;
        const int head = U & 31, Q0 = (U >> 5) * 128, q0 = Q0 + 16 * wave, t = q0 + fr;
        bf16x8 qf[4];
#pragma unroll
        for (int ks = 0; ks < 4; ++ks) qf[ks] = *(const bf16x8*)(QK + (size_t)(q0 + fr) * 8192 + head * 128 + 32 * ks + 8 * fq);
        f32x4 o[8];
#pragma unroll
        for (int dt = 0; dt < 8; ++dt) o[dt] = (f32x4){0.f, 0.f, 0.f, 0.f};
        float carry = 0.f; bool done = false;
        const bf16* kg = QK + 4096 + head * 128 + kc0; const bf16* vg = VT + (size_t)(head * 128) * 8192 + vc0;
        const int KB0 = Q0 + 64;
        v4u kreg[2], vreg[2];
        kreg[0] = *(const v4u*)(kg + (size_t)(KB0 + kr0) * 8192); kreg[1] = *(const v4u*)(kg + (size_t)(KB0 + kr0 + 32) * 8192);
        vreg[0] = *(const v4u*)(vg + (size_t)vr0 * 8192 + KB0); vreg[1] = *(const v4u*)(vg + (size_t)(vr0 + 64) * 8192 + KB0);
        __syncthreads();
        { LAS bf16* KS = (LAS bf16*)(lds + SB_KS); LAS bf16* VS = (LAS bf16*)(lds + SB_VS);
          *(LAS v4u*)(KS + kr0 * SBK_P + kc0) = kreg[0]; *(LAS v4u*)(KS + (kr0 + 32) * SBK_P + kc0) = kreg[1];
          *(LAS v4u*)(VS + vr0 * SBV_P + vc0) = vreg[0]; *(LAS v4u*)(VS + (vr0 + 64) * SBV_P + vc0) = vreg[1]; }
        __syncthreads();
#pragma unroll 1
        for (int j = 0;; ++j) {
            const int kb = KB0 - 64 * j; const bool has_next = kb >= 64;
            if (has_next) { const int kn = kb - 64;
                kreg[0] = *(const v4u*)(kg + (size_t)(kn + kr0) * 8192); kreg[1] = *(const v4u*)(kg + (size_t)(kn + kr0 + 32) * 8192);
                vreg[0] = *(const v4u*)(vg + (size_t)vr0 * 8192 + kn); vreg[1] = *(const v4u*)(vg + (size_t)(vr0 + 64) * 8192 + kn); }
            const LAS bf16* KS = (const LAS bf16*)(lds + (j & 1) * SB_BUF + SB_KS); const LAS bf16* VS = (const LAS bf16*)(lds + (j & 1) * SB_BUF + SB_VS);
            if (!done && kb <= q0 + 15) {
                f32x4 sa[4];
#pragma unroll
                for (int i = 0; i < 4; ++i) { sa[i] = (f32x4){0.f, 0.f, 0.f, 0.f};
#pragma unroll
                    for (int ks = 0; ks < 4; ++ks) sa[i] = mma(*(const LAS bf16x8*)(KS + (16 * i + fr) * SBK_P + 32 * ks + 8 * fq), qf[ks], sa[i]); }
                float l1[4][4], lb[4][4], Tl[4];
                if (kb + 63 >= q0) {
#pragma unroll
                    for (int i = 0; i < 4; ++i) {
#pragma unroll
                        for (int r = 0; r < 4; ++r) { const float z = sa[i][r] * scale; const float sp = fmaxf(z, 0.f) + flog2(1.f + fexp2(-fabsf(z)));
                            const bool valid = (kb + 16 * i + 4 * fq + r) < t; l1[i][r] = valid ? -sp : 0.f; lb[i][r] = valid ? (z - sp) : -1e30f; }
                        Tl[i] = (l1[i][0] + l1[i][1]) + (l1[i][2] + l1[i][3]);
                    }
                } else {
#pragma unroll
                    for (int i = 0; i < 4; ++i) {
#pragma unroll
                        for (int r = 0; r < 4; ++r) { const float z = sa[i][r] * scale; const float sp = fmaxf(z, 0.f) + flog2(1.f + fexp2(-fabsf(z)));
                            l1[i][r] = -sp; lb[i][r] = z - sp; }
                        Tl[i] = (l1[i][0] + l1[i][1]) + (l1[i][2] + l1[i][3]);
                    }
                }
                float run = carry; float att[4][4];
#pragma unroll
                for (int i = 3; i >= 0; --i) {
                    const float T = Tl[i];
                    const float pb = xor16f(T, fq), pc = xor32f(T, fq), pd = xor32f(pb, fq);
                    const float sg = fq == 0 ? (pb + pc) + pd : (fq == 1 ? pc + pd : (fq == 2 ? pb : 0.f));
                    const float tot = (T + pb) + (pc + pd);
                    const float e3 = run + sg, e2 = e3 + l1[i][3], e1 = e2 + l1[i][2], e0 = e1 + l1[i][1];
                    att[i][0] = fexp2(lb[i][0] + e0); att[i][1] = fexp2(lb[i][1] + e1); att[i][2] = fexp2(lb[i][2] + e2); att[i][3] = fexp2(lb[i][3] + e3);
                    run += tot;
                }
                carry = run;
                bf16x8 pf[2];
#pragma unroll
                for (int s2 = 0; s2 < 2; ++s2) { v4u w; w.x = pk2(att[2 * s2][0], att[2 * s2][1]); w.y = pk2(att[2 * s2][2], att[2 * s2][3]);
                    w.z = pk2(att[2 * s2 + 1][0], att[2 * s2 + 1][1]); w.w = pk2(att[2 * s2 + 1][2], att[2 * s2 + 1][3]); pf[s2] = u4_as_frag(w); }
#pragma unroll
                for (int dt = 0; dt < 8; ++dt) {
                    const LAS bf16* vp = VS + (16 * dt + fr) * SBV_P + 4 * fq;
#pragma unroll
                    for (int s2 = 0; s2 < 2; ++s2) { const s16x4 lo = *(const LAS s16x4*)(vp + 32 * s2), hi = *(const LAS s16x4*)(vp + 32 * s2 + 16);
                        o[dt] = mma(cat8(lo, hi), pf[s2], o[dt]); }
                }
                if (__all(carry < -127.f)) done = true;
            }
            if (lane == 0) FLAGS[(j & 1) * 8 + wave] = done ? 1 : 0;
            if (has_next) { LAS bf16* KN = (LAS bf16*)(lds + ((j + 1) & 1) * SB_BUF + SB_KS); LAS bf16* VN = (LAS bf16*)(lds + ((j + 1) & 1) * SB_BUF + SB_VS);
                *(LAS v4u*)(KN + kr0 * SBK_P + kc0) = kreg[0]; *(LAS v4u*)(KN + (kr0 + 32) * SBK_P + kc0) = kreg[1];
                *(LAS v4u*)(VN + vr0 * SBV_P + vc0) = vreg[0]; *(LAS v4u*)(VN + (vr0 + 64) * SBV_P + vc0) = vreg[1]; }
            __syncthreads();
            int nd = 0;
#pragma unroll
            for (int w8 = 0; w8 < 8; ++w8) nd += FLAGS[(j & 1) * 8 + w8];
            if (!has_next || nd == 8) break;
        }
        { LAS bf16* OT = (LAS bf16*)(lds + wave * 16640);
#pragma unroll
          for (int dt = 0; dt < 8; ++dt) { v2u w; w.x = pk2(o[dt][0], o[dt][1]); w.y = pk2(o[dt][2], o[dt][3]);
              *(LAS v2u*)(OT + fr * SBK_P + 16 * dt + 4 * fq) = w; }
          LDS_WAIT(); asm volatile("" ::: "memory");
          bf16* hrow = HC + (size_t)q0 * DM + head * 128;
#pragma unroll
          for (int i = 0; i < 4; ++i) { const int rr = 4 * i + fq, cc = fr * 8;
              *(v4u*)(hrow + (size_t)rr * DM + cc) = *(const LAS v4u*)(OT + rr * SBK_P + cc); }
          LDS_WAIT(); asm volatile("" ::: "memory"); }
        if (rider) { LAS float* scr = (LAS float*)(lds + wave * 16640);
            tr_to_lds(rv, scr, lane);
            bf16* WT = (bf16*)(ws + WS_W + (size_t)rsg.layer * LAYER_W + (size_t)rsg.wsub_mib * MiB);
            tr_store(WT + (size_t)(rsg.drow + 64 * rnb) * rsg.K + 64 * rkb, rsg.K, scr, lane); }
    }
}

constexpr int XA_P = 264, XA_BUF = 64 * XA_P * 2;
__device__ __forceinline__ void xattn_phase(unsigned char* ws, LAS unsigned char* lds, int bx, int G, int tid, int wave, int lane) {
    const bf16* XQ = (const bf16*)(ws + WS_XQ); const bf16* KM = (const bf16*)(ws + WS_KMEM); const bf16* VTM = (const bf16*)(ws + WS_VTMEM); bf16* XO = (bf16*)(ws + WS_XO);
#pragma unroll 1
    for (int U = bx; U < 256; U += G) {
        asm volatile("" : "+v"(lane), "+v"(tid));
        const int fr = lane & 15, fq = lane >> 4;
        const int pr0 = tid >> 5, pc0 = (tid & 31) * 8;
        const int head = U & 3, q0 = (U >> 2) * 128 + 16 * wave;
        bf16x8 qf[8];
#pragma unroll
        for (int ks = 0; ks < 8; ++ks) qf[ks] = *(const bf16x8*)(XQ + (size_t)(q0 + fr) * XAW + head * 256 + 32 * ks + 8 * fq);
        f32x4 s[16]; bf16x8 pf[8]; float rs = 0.f;
        v4u preg[4];
        LAS bf16* OT = (LAS bf16*)(lds + 2 * XA_BUF + wave * 2304);
#define XA_LOAD(p) do { _Pragma("unroll") for (int i_ = 0; i_ < 4; ++i_) { const int r_ = pr0 + 16 * i_; \
            preg[i_] = ((p) < 4) ? *(const v4u*)(KM + (size_t)(64 * (p) + r_) * XAW + head * 256 + pc0) : *(const v4u*)(VTM + (size_t)(head * 256 + 64 * ((p) - 4) + r_) * NMEM + pc0); } } while (0)
#define XA_STORE(p) do { LAS bf16* B_ = (LAS bf16*)(lds + ((p) & 1) * XA_BUF); _Pragma("unroll") for (int i_ = 0; i_ < 4; ++i_) *(LAS v4u*)(B_ + (pr0 + 16 * i_) * XA_P + pc0) = preg[i_]; } while (0)
        XA_LOAD(0);
        __syncthreads();
        XA_STORE(0);
        __syncthreads();
#pragma unroll
        for (int p = 0; p < 8; ++p) {
            if (p < 7) XA_LOAD(p + 1);
            const LAS bf16* B = (const LAS bf16*)(lds + (p & 1) * XA_BUF);
            if (p < 4) {
#pragma unroll
                for (int i = 0; i < 4; ++i) { f32x4 a = {0.f, 0.f, 0.f, 0.f};
#pragma unroll
                    for (int ks = 0; ks < 8; ++ks) a = mma(*(const LAS bf16x8*)(B + (16 * i + fr) * XA_P + 32 * ks + 8 * fq), qf[ks], a);
                    s[4 * p + i] = a; }
                if (p == 3) {
                    float mx = -1e30f;
#pragma unroll
                    for (int i = 0; i < 16; ++i) { s[i] = s[i] * 0.0625f; mx = fmaxf(mx, fmaxf(fmaxf(s[i][0], s[i][1]), fmaxf(s[i][2], s[i][3]))); }
                    mx = fmaxf(mx, __shfl_xor(mx, 16)); mx = fmaxf(mx, __shfl_xor(mx, 32));
                    float sum = 0.f;
#pragma unroll
                    for (int i = 0; i < 16; ++i) { s[i][0] = __expf(s[i][0] - mx); s[i][1] = __expf(s[i][1] - mx); s[i][2] = __expf(s[i][2] - mx); s[i][3] = __expf(s[i][3] - mx);
                        sum += (s[i][0] + s[i][1]) + (s[i][2] + s[i][3]); }
                    sum += __shfl_xor(sum, 16); sum += __shfl_xor(sum, 32);
                    rs = 1.f / sum;
#pragma unroll
                    for (int s2 = 0; s2 < 8; ++s2) { v4u w; w.x = pk2(s[2 * s2][0], s[2 * s2][1]); w.y = pk2(s[2 * s2][2], s[2 * s2][3]);
                        w.z = pk2(s[2 * s2 + 1][0], s[2 * s2 + 1][1]); w.w = pk2(s[2 * s2 + 1][2], s[2 * s2 + 1][3]); pf[s2] = u4_as_frag(w); }
                }
            } else {
#pragma unroll
                for (int i = 0; i < 4; ++i) {
                    const LAS bf16* vp = B + (16 * i + fr) * XA_P + 4 * fq;
                    f32x4 o = {0.f, 0.f, 0.f, 0.f};
#pragma unroll
                    for (int s2 = 0; s2 < 8; ++s2) { const s16x4 lo = *(const LAS s16x4*)(vp + 32 * s2), hi = *(const LAS s16x4*)(vp + 32 * s2 + 16); o = mma(cat8(lo, hi), pf[s2], o); }
                    v2u w; w.x = pk2(o[0] * rs, o[1] * rs); w.y = pk2(o[2] * rs, o[3] * rs);
                    *(LAS v2u*)(OT + fr * 72 + 16 * i + 4 * fq) = w;
                }
                LDS_WAIT(); asm volatile("" ::: "memory");
                { bf16* xrow = XO + (size_t)q0 * XAW + head * 256 + 64 * (p - 4);
#pragma unroll
                  for (int i = 0; i < 2; ++i) { const int rr = 8 * i + (lane >> 3), cc = (lane & 7) * 8;
                      *(v4u*)(xrow + (size_t)rr * XAW + cc) = *(const LAS v4u*)(OT + rr * 72 + cc); } }
                LDS_WAIT(); asm volatile("" ::: "memory");
            }
            if (p < 7) XA_STORE(p + 1);
            __syncthreads();
        }
#undef XA_LOAD
#undef XA_STORE
    }
}

__device__ __forceinline__ void conv_fixup(const float* cw, const float* cb, unsigned char* ws, int T0, int TS) {
    const float* halo = (const float*)(ws + WS_HALO); bf16* H = (bf16*)(ws + WS_H);
#pragma unroll 1
    for (int T = T0; T < 64 * FF; T += TS) {
        const int pr = T / FF, f = T - pr * FF, pm = pr >> 1, rr = pr & 1;
        const float* hp = halo + (size_t)pm * 6 * FF + f;
        float p2 = 0.f, p3 = 0.f;
        if (pm > 0) { const float* hq = halo + (size_t)(pm - 1) * 6 * FF + f; p2 = hq[2 * FF]; p3 = hq[3 * FF]; }
        const float g0 = hp[rr * FF];
        float g1 = rr ? hp[0] : p3, g2 = rr ? p3 : p2;
        g1 = __uint_as_float(f2bf(g1) << 16); g2 = __uint_as_float(f2bf(g2) << 16);
        const float x = cb[f] + cw[f] * g2 + cw[FF + f] * g1 + cw[2 * FF + f] * g0;
        const float y = -2.3022081983651455f * (x + 0.044715f * x * x * x);
        H[(size_t)(256 * pm + rr) * FF + f] = (bf16)f2bf(x * frcp(1.f + fexp2(y)) * hp[(4 + rr) * FF]);
    }
}

#ifndef EN_MASK
#define EN_MASK 0xffffffffu
#endif
#define EN(k) ((EN_MASK >> (k)) & 1u)
#define STEP_ON (lo <= step && step < hi)
#define OPQ int olane; asm volatile("v_mbcnt_lo_u32_b32 %0, -1, 0\n\tv_mbcnt_hi_u32_b32 %0, -1, %0" : "=v"(olane)); const int otid = wave * 64 + olane
#define STEP_END do { if (MK_SINGLE && step + 1 < hi) xcd_barrier(bar); ++step; } while (0)
typedef pg8::bf16_t pb;
#define glds lds
#define xres (args.out)
#define XN ((bf16*)(ws + WS_XN))
#define HB ((bf16*)(ws + WS_HB))
#define RS ((float*)(ws + WS_RS))
#define HC ((bf16*)(ws + WS_HC))
#define wl (ws + WS_W + (size_t)layer * LAYER_W)
#define SITE size_t wz_ = 0; asm volatile("" : "+s"(wz_)); unsigned char* ws = args.ws + wz_

template <int LAYER>
__device__ __forceinline__ void layer_steps(const Args& args, LAS unsigned char* lds, const XcdBarrier& bar, const int lo, const int hi, int& step,
                                            const int G, const int bx, const int vcu, const int gw, const int NGW, const int wave) {
    constexpr int layer = LAYER;

        if (EN(1) && STEP_ON) { SITE;
            { pg8::Gemm g{(const pb*)XN, (const pb*)(wl + WO_MAIN), SEQ, 8192, DM, DM, DM}; pg8::StaticOrder S; S.init(g.M, g.N, G, bx);
              pg8::EpiStore E{(pb*)(ws + WS_PROJ), 8192, nullptr, -1};
              pg8::gemm_phase<pg8::EpiStore, pg8::StaticOrder, true, true>(glds, g, S, E, wave); }
            { pg8::Gemm g{(const pb*)(wl + WO_V), (const pb*)XN, DM, SEQ, DM, DM, DM}; pg8::StaticOrder S; S.init(g.M, g.N, G, bx);
              pg8::EpiStore E{(pb*)(ws + WS_VT), 8192, nullptr, -1};
              pg8::gemm_phase<pg8::EpiStore, pg8::StaticOrder, true, true>(glds, g, S, E, wave); }
            if (layer == 0) { OPQ; gates_minigemm(ws, lds, bx, G, otid, wave, olane); }
        }
        STEP_END;
        if (layer == 0) {
            if (EN(3) && STEP_ON) { SITE;
                OPQ;
#pragma unroll 1
                for (int u = bx; u < 512; u += G) dc_unit(args, ws, lds, u, otid, wave, olane);
            }
            STEP_END;
#ifdef SCAN_PROBE
            if (EN(4) && STEP_ON) { SITE; OPQ; for (int rep_ = 0; rep_ < SCAN_PROBE; ++rep_) scan_phase(ws, vcu * NTHREADS + otid, G * NTHREADS, (bf16*)(ws + WS_W + LAYER_W + WO_GU)); }
#endif
            if (EN(4) && STEP_ON) { SITE; OPQ; scan_phase(ws, vcu * NTHREADS + otid, G * NTHREADS); }
            STEP_END;
            if (EN(5) && STEP_ON) { SITE;
                OPQ;
#pragma unroll 1
                for (int u = bx; u < 1024; u += G) { if (mixout_chunk(u) & 1) mixout_unit<true>(args, ws, lds, u, otid, wave, olane); else mixout_unit<false>(args, ws, lds, u, otid, wave, olane); }
            }
            STEP_END;
        } else {
            if (EN(6) && STEP_ON) { SITE; OPQ; stickbreak_phase(args, ws, lds, bx, G, otid, wave, olane); }
            STEP_END;
        }
        if (EN(7) && STEP_ON) { SITE;
            pg8::Gemm g{(const pb*)HC, (const pb*)(wl + WO_OUT), SEQ, DM, DM, DM, DM}; pg8::StaticOrder S; S.init(g.M, g.N, G, bx);
            pg8::EpiStore E{(pb*)HB, DM, nullptr, -1};
            pg8::gemm_phase<pg8::EpiStore, pg8::StaticOrder, true, true>(glds, g, S, E, wave);
        }
        STEP_END;
#ifdef NORM_PROBE
        if (EN(8) && STEP_ON) { SITE; OPQ; for (int rep_ = 0; rep_ < NORM_PROBE; ++rep_) norm_rows<1>(nullptr, HB, args.in[2] + layer * DM, args.in[3] + layer * DM, args.in[14] + layer * DM, nullptr, XN, RS, lds, gw, NGW, otid, olane, HC, RS + 16384); }
#endif
        if (EN(8) && STEP_ON) { SITE; OPQ; norm_rows<1>(nullptr, HB, args.in[2] + layer * DM, args.in[3] + layer * DM, args.in[14] + layer * DM, nullptr, XN, RS, lds, gw, NGW, otid, olane); }
        STEP_END;
        if (EN(9) && STEP_ON) { SITE;
            { pg8::Gemm g{(const pb*)XN, (const pb*)(wl + WO_XQ), SEQ, XAW, DM, DM, DM}; pg8::StaticOrder S; S.init(g.M, g.N, G, bx);
              pg8::EpiStore E{(pb*)(ws + WS_XQ), XAW, nullptr, -1};
              pg8::gemm_phase<pg8::EpiStore, pg8::StaticOrder, true, true>(glds, g, S, E, wave); }
            { pg8::Gemm g{(const pb*)(ws + WS_MEMN) + (size_t)layer * NMEM * DM, (const pb*)(wl + WO_XK), NMEM, XAW, DM, DM, DM}; pg8::StaticOrder S; S.init(g.M, g.N, G, (bx + G - 128) % G);
              pg8::EpiStore E{(pb*)(ws + WS_KMEM), XAW, nullptr, -1};
              pg8::gemm_phase<pg8::EpiStore, pg8::StaticOrder, true, true>(glds, g, S, E, wave); }
            { pg8::Gemm g{(const pb*)(wl + WO_XV), (const pb*)(ws + WS_MEMN) + (size_t)layer * NMEM * DM, XAW, NMEM, DM, DM, DM}; pg8::StaticOrder S; S.init(g.M, g.N, G, (bx + G - 132) % G);
              pg8::EpiStore E{(pb*)(ws + WS_VTMEM), NMEM, nullptr, -1};
              pg8::gemm_phase<pg8::EpiStore, pg8::StaticOrder, true, true>(glds, g, S, E, wave); }
            if (G == 256 && bx >= XA_BUSY_WGS) { OPQ; convert_segments(args, ws, lds, SEG_DEFER, SEG_END, layer == 0 ? 0 : 1, layer == 0 ? 1 : 2, 2, (bx - XA_BUSY_WGS) * NWAVES + wave, (G - XA_BUSY_WGS) * NWAVES, wave, olane); }
        }
        STEP_END;
        if (EN(10) && STEP_ON) { SITE; OPQ; xattn_phase(ws, lds, bx, G, otid, wave, olane); }
        STEP_END;
        if (EN(11) && STEP_ON) { SITE;
            pg8::Gemm g{(const pb*)(ws + WS_XO), (const pb*)(wl + WO_XO), SEQ, DM, XAW, XAW, XAW}; pg8::StaticOrder S; S.init(g.M, g.N, G, bx);
            pg8::EpiStore E{(pb*)HB, DM, nullptr, -1};
            pg8::gemm_phase<pg8::EpiStore, pg8::StaticOrder, true, true>(glds, g, S, E, wave);
        }
        STEP_END;
        if (EN(12) && STEP_ON) { SITE; OPQ; norm_rows<1>(nullptr, HB, args.in[14] + layer * DM, args.in[15] + layer * DM, args.in[21] + layer * DM, nullptr, XN, RS, lds, gw, NGW, otid, olane); }
        STEP_END;
        if (EN(13) && STEP_ON) { SITE;
            pg8::Gemm g{(const pb*)XN, (const pb*)(wl + WO_GU), SEQ, 2 * FF, DM, DM, DM}; pg8::StaticOrder S; S.init(g.M, g.N, G, bx);
            pg8::EpiConvGelu E{(pb*)(ws + WS_H), FF, args.in[25] + (size_t)layer * 3 * FF, args.in[26] + (size_t)layer * FF, FF, (float*)(ws + WS_HALO), (PG8_LAS float*)(lds + 131072)};
            pg8::gemm_phase<pg8::EpiConvGelu, pg8::StaticOrder, true, true>(glds, g, S, E, wave);
        }
        STEP_END;
        if (EN(14) && STEP_ON) { SITE; OPQ; conv_fixup(args.in[25] + (size_t)layer * 3 * FF, args.in[26] + (size_t)layer * FF, ws, vcu * NTHREADS + otid, G * NTHREADS); }
        STEP_END;
        if (EN(15) && STEP_ON) { SITE;
            pg8::Gemm g{(const pb*)(ws + WS_H), (const pb*)(wl + WO_DOWN), SEQ, DM, FF, FF, FF}; pg8::StaticOrder S; S.init(g.M, g.N, G, bx);
            pg8::EpiStore E{(pb*)HB, DM, nullptr, -1};
            pg8::gemm_phase<pg8::EpiStore, pg8::StaticOrder, true, true>(glds, g, S, E, wave);
        }
        STEP_END;
        if (EN(16) && STEP_ON) { SITE;
            OPQ;
            if (layer == 0) norm_rows<1>(nullptr, HB, args.in[21], args.in[22], args.in[2] + DM, nullptr, XN, RS, lds, gw, NGW, otid, olane);
            else norm_rows<2>(nullptr, HB, args.in[21] + DM, args.in[22] + DM, nullptr, xres, XN, RS, lds, gw, NGW, otid, olane);
        }
        STEP_END;
}
__global__ void __launch_bounds__(NTHREADS, 2) mk_fwd(Args args) {
    extern __shared__ __attribute__((aligned(16))) unsigned char lds_raw[];
    LAS unsigned char* lds = (LAS unsigned char*)lds_raw;
    volatile LAS unsigned* MISC = (volatile LAS unsigned*)(lds + MISC_OFF);
    const int tid = threadIdx.x, wave = __builtin_amdgcn_readfirstlane(tid >> 6);
    const int G = gridDim.x, bx = blockIdx.x;
    const int vcu = (G % 8 == 0) ? (bx % 8) * (G / 8) + bx / 8 : bx;
    const int gw = vcu * NWAVES + wave, NGW = G * NWAVES;
    gu32* ctl = (gu32*)(args.ws + WS_CTL);
    for (int u = tid; u < (LDS_BYTES - LDSCTL_OFF) / 4; u += NTHREADS) ((LAS unsigned*)(lds + LDSCTL_OFF))[u] = 0u;
    __syncthreads();
    XcdBarrier bar; bar.bar = (unsigned*)(ctl + CW_BAR); bar.x = 0; bar.st = nullptr;
    if (MK_SINGLE) bar = xcd_barrier_post((unsigned*)(ctl + CW_BAR), MISC + 8);
    const int lo = args.ph_lo, hi = args.ph_hi;
    int step = 0;
    if (EN(0) && STEP_ON) { SITE;
        { OPQ; p0_prologue(args, ws, lds, gw, NGW, wave, olane, G == 256); }
        { OPQ; norm_rows<0>(args.in[0], nullptr, nullptr, nullptr, args.in[2], nullptr, XN, RS, lds, gw, NGW, otid, olane); }
    }
    STEP_END;

    layer_steps<0>(args, lds, bar, lo, hi, step, G, bx, vcu, gw, NGW, wave);
    layer_steps<1>(args, lds, bar, lo, hi, step, G, bx, vcu, gw, NGW, wave);
#undef STEP_ON
#undef STEP_END
}

extern "C" void kernel_launch(void* const* d_in, const int* in_sizes, int n_in, void* d_out, int out_size, void* d_ws, size_t ws_size, hipStream_t stream) {
    static int grid = 0;
    if (grid == 0) {
        if (n_in != 28 || out_size != SEQ * DM || ws_size < WS_END) { fprintf(stderr, "kernel_launch: built for 28 inputs, out %d floats, >= %zu bytes of workspace; got n_in %d, out %d, ws %zu; nothing launched\n", SEQ * DM, (size_t)WS_END, n_in, out_size, ws_size); grid = -1; return; }
        int dev = 0, cus = 0, per_cu = 0;
        if (hipGetDevice(&dev) != hipSuccess || hipDeviceGetAttribute(&cus, hipDeviceAttributeMultiprocessorCount, dev) != hipSuccess) { fprintf(stderr, "kernel_launch: device query failed\n"); grid = -1; return; }
        if (hipFuncSetAttribute((const void*)mk_fwd, hipFuncAttributeMaxDynamicSharedMemorySize, LDS_BYTES) != hipSuccess) { fprintf(stderr, "kernel_launch: hipFuncSetAttribute failed\n"); grid = -1; return; }
        if (hipOccupancyMaxActiveBlocksPerMultiprocessor(&per_cu, (const void*)mk_fwd, NTHREADS, LDS_BYTES) != hipSuccess || per_cu < 1)
            fprintf(stderr, "kernel_launch: note: occupancy query reports %d workgroups per CU\n", per_cu);
        (void)hipGetLastError();
        grid = cus;
    }
    if (grid < 0) return;
    if (hipMemsetAsync((char*)d_ws + WS_CTL, 0, CTL_ZERO_BYTES, stream) != hipSuccess) { fprintf(stderr, "kernel_launch: hipMemsetAsync failed\n"); return; }
    Args a{};
    for (int i = 0; i < 28; ++i) a.in[i] = (const float*)d_in[i];
    a.out = (float*)d_out; a.ws = (unsigned char*)d_ws;
#if MK_SINGLE
    a.ph_lo = 0; a.ph_hi = N_STEPS;
    hipLaunchKernelGGL(mk_fwd, dim3(grid), dim3(NTHREADS), LDS_BYTES, stream, a);
#else
#ifndef DUP_STEPS
#define DUP_STEPS 0u
#endif
#ifndef DUP_N
#define DUP_N 2
#endif
    for (int s = 0; s < N_STEPS; ++s) { a.ph_lo = s; a.ph_hi = s + 1;
        for (int rep = 0; rep < (((DUP_STEPS >> s) & 1u) ? DUP_N : 1); ++rep) hipLaunchKernelGGL(mk_fwd, dim3(grid), dim3(NTHREADS), LDS_BYTES, stream, a); }
#endif
    const hipError_t le = hipPeekAtLastError();
    if (le != hipSuccess) fprintf(stderr, "kernel_launch: launch failed: %s\n", hipGetErrorName(le));
}
```

```cpp
#include <hip/hip_runtime.h>
#include <cstdio>
#include <cstdint>
#define MK_SINGLE 1
namespace pg8 {
#define PG8_LAS __attribute__((address_space(3)))
typedef unsigned short bf16_t;
typedef short bf16x8 __attribute__((ext_vector_type(8)));
typedef float f32x4 __attribute__((ext_vector_type(4)));
typedef unsigned u32x4 __attribute__((ext_vector_type(4)));
constexpr int BM = 256, BK = 64, HALF = 128, HTB = HALF * BK * 2  , STAGE_BYTES = 8 * HTB, NXCD = 8, WGM = 8;

__host__ __device__ __forceinline__ int lds_byte(int r, int c) { const int st = (r >> 4) * 2 + (c >> 5), rr = r & 15, cc = c & 31, ob = rr * 64 + cc * 2; return st * 1024 + (ob ^ (((ob >> 9) & 1) << 5)); }
__host__ __device__ __forceinline__ void stage_rc(int b, int& R, int& C) { const int st = b / 1024, sb = b % 1024, swz = sb ^ (((sb >> 9) & 1) << 5); R = (st >> 1) * 16 + swz / 64; C = (st & 1) * 32 + (swz % 64) / 2; }
__host__ __device__ __forceinline__ int perm32(int rho) { const int n = rho >> 4, i = rho & 15; return 8 * (i >> 2) + 4 * n + (i & 3); }

struct Unit { int pm, pn; };
struct Gemm { const bf16_t* A; const bf16_t* Bt; int M, N, K, lda, ldb; };

struct StaticOrder {
    int nM, nN, nwg, G, c;
    __host__ __device__ void init(int M, int N, int G_, int c_) { nM = M / BM; nN = N / BM; nwg = nM * nN; G = G_; c = c_; }
    __host__ __device__ bool next(int i, Unit& u) const {
        const long L = (long)i * G + c; if (L >= nwg) return false;
        int wgid = (int)L; { const int q = nwg / NXCD, r = nwg % NXCD, xcd = wgid % NXCD, off = wgid / NXCD; wgid = (xcd < r ? xcd * (q + 1) : r * (q + 1) + (xcd - r) * q) + off; }
        const int nig = WGM * nN, gid = wgid / nig, fm = gid * WGM, gsz = (nM - fm) < WGM ? (nM - fm) : WGM;
        u.pm = fm + ((wgid % nig) % gsz); u.pn = (wgid % nig) / gsz; return true;
    }
    __device__ __forceinline__ void a_ready(const Unit&) const {}
    __device__ __forceinline__ void done(const Unit&) const {}
};

__device__ __forceinline__ unsigned cvt_pk_bf16(float lo, float hi) { unsigned r; asm volatile("v_cvt_pk_bf16_f32 %0, %1, %2" : "=v"(r) : "v"(lo), "v"(hi)); return r; }

struct EpiStore {
    static constexpr bool PERM = true, AFTER_DRAIN = false;
    bf16_t* O; int ldc; float* gates; int gate_pn;
    __device__ __forceinline__ void operator()(const f32x4 (&acc)[2][2][4][2], const Unit& u, int wr, int wc, int fr, int fq) const {
        const int row0 = u.pm * BM + wr * 64 + fr;
        if (u.pn == gate_pn) {
            if (wc == 0) {
#pragma unroll
                for (int ai = 0; ai < 2; ++ai)
#pragma unroll
                    for (int m = 0; m < 4; ++m) { float* gp = gates + (size_t)(row0 + ai * HALF + m * 16) * 32 + 8 * fq;
                        *(f32x4*)(gp) = acc[ai][0][m][0]; *(f32x4*)(gp + 4) = acc[ai][0][m][1]; }
            }
            return;
        }
        const int col0 = u.pn * BM + wc * 32 + 8 * fq;
#pragma unroll
        for (int ai = 0; ai < 2; ++ai)
#pragma unroll
            for (int m = 0; m < 4; ++m) { bf16_t* rowp = O + (size_t)(row0 + ai * HALF + m * 16) * ldc + col0;
#pragma unroll
                for (int bj = 0; bj < 2; ++bj) { const f32x4 v0 = acc[ai][bj][m][0], v1 = acc[ai][bj][m][1];
                    u32x4 w; w.x = cvt_pk_bf16(v0[0], v0[1]); w.y = cvt_pk_bf16(v0[2], v0[3]); w.z = cvt_pk_bf16(v1[0], v1[1]); w.w = cvt_pk_bf16(v1[2], v1[3]);
                    *(u32x4*)(rowp + bj * HALF) = w; } }
    }
};

__device__ __forceinline__ float gelu_tanh_f(float x) { const float y = -2.3022081983651455f * (x + 0.044715f * x * x * x); return x * __builtin_amdgcn_rcpf(1.f + __builtin_amdgcn_exp2f(y)); }
struct EpiConvGelu {
    static constexpr bool PERM = true, AFTER_DRAIN = false;
    bf16_t* H; int ldh; const float* cw; const float* cb; int ff; float* halo; PG8_LAS float* X;
    __device__ __forceinline__ void operator()(const f32x4 (&acc)[2][2][4][2], const Unit& u, int wr, int wc, int fr, int fq) const {
        const int cl = 32 * wc + 8 * fq;
        const int f0 = 128 * u.pn + cl;
        if (fr >= 14) {
#pragma unroll
            for (int ai = 0; ai < 2; ++ai) { PG8_LAS float* xp = X + ((2 * ai + wr) * 2 + (fr - 14)) * 128 + cl;
                *(PG8_LAS f32x4*)xp = acc[ai][0][3][0]; *(PG8_LAS f32x4*)(xp + 4) = acc[ai][0][3][1]; }
        }
        asm volatile("s_waitcnt lgkmcnt(0)" ::: "memory"); __builtin_amdgcn_s_barrier(); asm volatile("" ::: "memory");
        float w0[8], w1[8], w2[8], bb[8];
#pragma unroll
        for (int h = 0; h < 2; ++h) { const f32x4 a = *(const f32x4*)(cw + f0 + 4 * h), b = *(const f32x4*)(cw + ff + f0 + 4 * h), c = *(const f32x4*)(cw + 2 * ff + f0 + 4 * h), d = *(const f32x4*)(cb + f0 + 4 * h);
#pragma unroll
            for (int j = 0; j < 4; ++j) { w0[4 * h + j] = a[j]; w1[4 * h + j] = b[j]; w2[4 * h + j] = c[j]; bb[4 * h + j] = d[j]; } }
        float* hp = halo + (size_t)u.pm * 6 * ff + f0;
#pragma unroll
        for (int ai = 0; ai < 2; ++ai) {
            const int slab = 2 * ai + wr;
            unsigned l14[4], l15[4];
            if (slab > 0) { const PG8_LAS float* xp = X + ((slab - 1) * 2) * 128 + cl;
                const f32x4 a0 = *(const PG8_LAS f32x4*)xp, a1 = *(const PG8_LAS f32x4*)(xp + 4), b0 = *(const PG8_LAS f32x4*)(xp + 128), b1 = *(const PG8_LAS f32x4*)(xp + 132);
                l14[0] = cvt_pk_bf16(a0[0], a0[1]); l14[1] = cvt_pk_bf16(a0[2], a0[3]); l14[2] = cvt_pk_bf16(a1[0], a1[1]); l14[3] = cvt_pk_bf16(a1[2], a1[3]);
                l15[0] = cvt_pk_bf16(b0[0], b0[1]); l15[1] = cvt_pk_bf16(b0[2], b0[3]); l15[2] = cvt_pk_bf16(b1[0], b1[1]); l15[3] = cvt_pk_bf16(b1[2], b1[3]); }
            else { l14[0] = l14[1] = l14[2] = l14[3] = 0u; l15[0] = l15[1] = l15[2] = l15[3] = 0u; }
#pragma unroll
            for (int m = 0; m < 4; ++m) {
                const int row = u.pm * BM + ai * HALF + wr * 64 + m * 16 + fr;
                unsigned pk[4];
                pk[0] = cvt_pk_bf16(acc[ai][0][m][0][0], acc[ai][0][m][0][1]); pk[1] = cvt_pk_bf16(acc[ai][0][m][0][2], acc[ai][0][m][0][3]);
                pk[2] = cvt_pk_bf16(acc[ai][0][m][1][0], acc[ai][0][m][1][1]); pk[3] = cvt_pk_bf16(acc[ai][0][m][1][2], acc[ai][0][m][1][3]);
                float hv[8];
#pragma unroll
                for (int q = 0; q < 4; ++q) {
                    unsigned g1 = (unsigned)__shfl_up((int)pk[q], 1, 16), g2 = (unsigned)__shfl_up((int)pk[q], 2, 16);
                    if (fr == 0) { g1 = l15[q]; g2 = l14[q]; } else if (fr == 1) { g2 = l15[q]; }
                    const unsigned n14 = (unsigned)__shfl((int)pk[q], 14, 16), n15 = (unsigned)__shfl((int)pk[q], 15, 16);
                    l14[q] = n14; l15[q] = n15;
                    const int n = q >> 1, j = (q & 1) * 2, e = 2 * q;
                    const float x0 = bb[e] + w0[e] * __uint_as_float(g2 << 16) + w1[e] * __uint_as_float(g1 << 16) + w2[e] * acc[ai][0][m][n][j];
                    const float x1 = bb[e + 1] + w0[e + 1] * __uint_as_float(g2 & 0xffff0000u) + w1[e + 1] * __uint_as_float(g1 & 0xffff0000u) + w2[e + 1] * acc[ai][0][m][n][j + 1];
                    hv[e] = gelu_tanh_f(x0) * acc[ai][1][m][n][j]; hv[e + 1] = gelu_tanh_f(x1) * acc[ai][1][m][n][j + 1];
                }
                const bool first2 = (slab == 0 && m == 0 && fr < 2);
                if (!first2) { u32x4 w; w.x = cvt_pk_bf16(hv[0], hv[1]); w.y = cvt_pk_bf16(hv[2], hv[3]); w.z = cvt_pk_bf16(hv[4], hv[5]); w.w = cvt_pk_bf16(hv[6], hv[7]);
                    *(u32x4*)(H + (size_t)row * ldh + f0) = w; }
                else { float* p = hp + (size_t)fr * ff; *(f32x4*)p = acc[0][0][0][0]; *(f32x4*)(p + 4) = acc[0][0][0][1];
                    float* pu = hp + (size_t)(4 + fr) * ff; *(f32x4*)pu = acc[0][1][0][0]; *(f32x4*)(pu + 4) = acc[0][1][0][1]; }
                if (slab == 3 && m == 3 && fr >= 14) { float* p = hp + (size_t)(2 + fr - 14) * ff; *(f32x4*)p = acc[1][0][3][0]; *(f32x4*)(p + 4) = acc[1][0][3][1]; }
            }
        }
    }
};
template <class Epi, class Sched, bool ALIGN_EPI = false, bool SP2 = false>
__device__ __forceinline__ void gemm_phase(PG8_LAS unsigned char* lds, const Gemm g, const Sched& S, const Epi& E, const int wv  ) {
    int tid_o; asm volatile("v_mbcnt_lo_u32_b32 %0, -1, 0\n\tv_mbcnt_hi_u32_b32 %0, -1, %0" : "=v"(tid_o)); tid_o += wv * 64;
    const int tid = tid_o, wid = __builtin_amdgcn_readfirstlane(tid >> 6), lane = tid & 63, wr = wid >> 2, wc = wid & 3, fr = lane & 15, fq = lane >> 4;
    const int K = g.K, nt = K / BK;
    unsigned voffA[2], voffB[2];
#pragma unroll
    for (int i = 0; i < 2; ++i) { int R, C; stage_rc(tid * 16 + i * 8192, R, C); const int Rb = Epi::PERM ? ((R & ~31) + perm32(R & 31)) : R;
        voffA[i] = (unsigned)(R * g.lda + C) * 2u; voffB[i] = (unsigned)(Rb * g.ldb + C) * 2u; }
    const size_t kstep = (size_t)(BK * 2);
    const size_t hstepA = (size_t)HALF * g.lda * 2, hstepB = (size_t)HALF * g.ldb * 2;
    const size_t tstepA = 2 * hstepA, tstepB = 2 * hstepB;
    const unsigned ldsw = (unsigned)wid * 1024u;
    const int aoff = lds_byte(wr * 64 + fr, fq * 8), boff = lds_byte(wc * 32 + fr, fq * 8);
#define PG8_SA(b, h) (((b) * 2 + (h)) * HTB)
#define PG8_SB(b, h) ((4 + (b) * 2 + (h)) * HTB)
#define PG8_STAGE(bufoff, gbase, voff) do { _Pragma("unroll") for (int _i = 0; _i < 2; ++_i) \
        __builtin_amdgcn_global_load_lds((const unsigned*)((const char*)(gbase) + (voff)[_i]), (PG8_LAS unsigned*)(lds + (bufoff) + ldsw + _i * 8192), 16, 0, 0); } while (0)
#define PG8_LDA(dst, b, h) do { _Pragma("unroll") for (int m = 0; m < 4; ++m) _Pragma("unroll") for (int k = 0; k < 2; ++k) dst[m][k] = *(const PG8_LAS bf16x8*)(lds + PG8_SA(b, h) + aoff + m * 2048 + k * 1024); } while (0)
#define PG8_LDB(dst, b, h) do { _Pragma("unroll") for (int n = 0; n < 2; ++n) _Pragma("unroll") for (int k = 0; k < 2; ++k) dst[n][k] = *(const PG8_LAS bf16x8*)(lds + PG8_SB(b, h) + boff + n * 2048 + k * 1024); } while (0)
#define PG8_MMA(ai, bj, At, Bt) do { __builtin_amdgcn_s_setprio(1); _Pragma("unroll") for (int m = 0; m < 4; ++m) _Pragma("unroll") for (int n = 0; n < 2; ++n) _Pragma("unroll") for (int k = 0; k < 2; ++k) \
        acc[ai][bj][m][n] = __builtin_amdgcn_mfma_f32_16x16x32_bf16(Bt[n][k], At[m][k], acc[ai][bj][m][n], 0, 0, 0); __builtin_amdgcn_s_setprio(0); } while (0)
#define PG8_WAIT_V(n) asm volatile("s_waitcnt vmcnt(" #n ")" ::: "memory")
#define PG8_WAIT_L(n) asm volatile("s_waitcnt lgkmcnt(" #n ")" ::: "memory")
#define PG8_BAR __builtin_amdgcn_s_barrier()
#define PG8_SCHED __builtin_amdgcn_sched_barrier(0)
    Unit cur, nxt; int ui = 0;
    if (!S.next(0, cur)) return;
    f32x4 acc[2][2][4][2];
#pragma unroll
    for (int a = 0; a < 2; ++a)
#pragma unroll
        for (int b = 0; b < 2; ++b)
#pragma unroll
            for (int m = 0; m < 4; ++m)
#pragma unroll
                for (int n = 0; n < 2; ++n) acc[a][b][m][n] = (f32x4){0.f, 0.f, 0.f, 0.f};
    bf16x8 At[4][2], B0[2][2], B1[2][2];
    const char* cA = (const char*)g.A + (size_t)cur.pm * tstepA; const char* cB = (const char*)g.Bt + (size_t)cur.pn * tstepB;
    S.a_ready(cur);
    if constexpr (SP2) {
        PG8_STAGE(PG8_SB(0, 0), cB, voffB); PG8_STAGE(PG8_SB(0, 1), cB + hstepB, voffB); PG8_STAGE(PG8_SA(0, 0), cA, voffA); PG8_STAGE(PG8_SA(0, 1), cA + hstepA, voffA);
        if (wr == 1) PG8_BAR;
        PG8_WAIT_V(2); PG8_BAR;
        PG8_STAGE(PG8_SB(1, 0), cB + kstep, voffB); PG8_STAGE(PG8_SA(1, 0), cA + kstep, voffA); PG8_STAGE(PG8_SB(1, 1), cB + hstepB + kstep, voffB);
        PG8_WAIT_V(6); PG8_BAR;
    } else {
        PG8_STAGE(PG8_SB(0, 0), cB, voffB); PG8_STAGE(PG8_SA(0, 0), cA, voffA); PG8_STAGE(PG8_SB(0, 1), cB + hstepB, voffB); PG8_STAGE(PG8_SA(0, 1), cA + hstepA, voffA);
        if (wr == 1) PG8_BAR;
        PG8_WAIT_V(4); PG8_BAR;
        PG8_STAGE(PG8_SB(1, 0), cB + kstep, voffB); PG8_STAGE(PG8_SA(1, 0), cA + kstep, voffA); PG8_STAGE(PG8_SB(1, 1), cB + hstepB + kstep, voffB);
        PG8_WAIT_V(6); PG8_BAR;
    }
    for (;;) {
        const bool has_next = S.next(ui + 1, nxt);
        const char* nA = has_next ? (const char*)g.A + (size_t)nxt.pm * tstepA : cA; const char* nB = has_next ? (const char*)g.Bt + (size_t)nxt.pn * tstepB : cB;
        for (int t = 0; t < nt; t += 2) {
            const bool last = (t == nt - 2);
            const char* a1 = cA + (size_t)(t + 1) * kstep;
            const char* a2 = last ? nA : cA + (size_t)(t + 2) * kstep; const char* b2 = last ? nB : cB + (size_t)(t + 2) * kstep;
            const char* a3 = a2 + kstep; const char* b3 = b2 + kstep;
            if (last && has_next) S.a_ready(nxt);
            if constexpr (SP2) {
            PG8_LDB(B0, 0, 0); PG8_LDB(B1, 0, 1); PG8_SCHED; PG8_LDA(At, 0, 0); PG8_STAGE(PG8_SA(1, 1), a1 + hstepA, voffA);
            PG8_WAIT_V(8); PG8_WAIT_L(0); PG8_BAR; PG8_MMA(0, 0, At, B0); PG8_MMA(0, 1, At, B1); PG8_BAR; PG8_SCHED;
            PG8_LDA(At, 0, 1); PG8_STAGE(PG8_SB(0, 0), b2, voffB); PG8_STAGE(PG8_SB(0, 1), b2 + hstepB, voffB); PG8_STAGE(PG8_SA(0, 0), a2, voffA);
            PG8_WAIT_V(8); PG8_WAIT_L(0); PG8_BAR; PG8_MMA(1, 0, At, B0); PG8_MMA(1, 1, At, B1); PG8_BAR; PG8_SCHED;
            PG8_LDB(B0, 1, 0); PG8_LDB(B1, 1, 1); PG8_SCHED; PG8_LDA(At, 1, 0); PG8_STAGE(PG8_SA(0, 1), a2 + hstepA, voffA);
            PG8_WAIT_V(8); PG8_WAIT_L(0); PG8_BAR; PG8_MMA(0, 0, At, B0); PG8_MMA(0, 1, At, B1); PG8_BAR; PG8_SCHED;
            PG8_LDA(At, 1, 1); PG8_STAGE(PG8_SB(1, 0), b3, voffB); PG8_STAGE(PG8_SB(1, 1), b3 + hstepB, voffB); PG8_STAGE(PG8_SA(1, 0), a3, voffA);
            PG8_WAIT_V(8); PG8_WAIT_L(0); PG8_BAR; PG8_MMA(1, 0, At, B0); PG8_MMA(1, 1, At, B1); PG8_BAR; PG8_SCHED;
            } else {
            PG8_LDB(B0, 0, 0); PG8_SCHED; PG8_LDA(At, 0, 0); PG8_STAGE(PG8_SA(1, 1), a1 + hstepA, voffA);
            PG8_WAIT_L(8); PG8_BAR; PG8_WAIT_L(0); PG8_MMA(0, 0, At, B0); PG8_BAR; PG8_SCHED;
            PG8_LDB(B1, 0, 1); PG8_STAGE(PG8_SB(0, 0), b2, voffB);
            PG8_BAR; PG8_WAIT_L(0); PG8_MMA(0, 1, At, B1); PG8_BAR;
            PG8_LDA(At, 0, 1); PG8_STAGE(PG8_SA(0, 0), a2, voffA);
            PG8_BAR; PG8_WAIT_L(0); PG8_MMA(1, 0, At, B0); PG8_BAR; PG8_SCHED;
            PG8_STAGE(PG8_SB(0, 1), b2 + hstepB, voffB);
            PG8_WAIT_V(6); PG8_BAR; PG8_MMA(1, 1, At, B1); PG8_BAR;
            PG8_LDB(B0, 1, 0); PG8_SCHED; PG8_LDA(At, 1, 0); PG8_STAGE(PG8_SA(0, 1), a2 + hstepA, voffA);
            PG8_WAIT_L(8); PG8_BAR; PG8_WAIT_L(0); PG8_MMA(0, 0, At, B0); PG8_BAR; PG8_SCHED;
            PG8_LDB(B1, 1, 1); PG8_STAGE(PG8_SB(1, 0), b3, voffB);
            PG8_BAR; PG8_WAIT_L(0); PG8_MMA(0, 1, At, B1); PG8_BAR;
            PG8_LDA(At, 1, 1); PG8_STAGE(PG8_SA(1, 0), a3, voffA);
            PG8_BAR; PG8_WAIT_L(0); PG8_MMA(1, 0, At, B0); PG8_BAR; PG8_SCHED;
            PG8_STAGE(PG8_SB(1, 1), b3 + hstepB, voffB);
            PG8_WAIT_V(6); PG8_BAR; PG8_MMA(1, 1, At, B1); PG8_BAR;
            }
        }
        if constexpr (ALIGN_EPI) { if (wr == 0) PG8_BAR; }
        if constexpr (!Epi::AFTER_DRAIN) { E(acc, cur, wr, wc, fr, fq); S.done(cur); }
        if (!has_next) break;
#pragma unroll
        for (int a = 0; a < 2; ++a)
#pragma unroll
            for (int b = 0; b < 2; ++b)
#pragma unroll
                for (int m = 0; m < 4; ++m)
#pragma unroll
                    for (int n = 0; n < 2; ++n) acc[a][b][m][n] = (f32x4){0.f, 0.f, 0.f, 0.f};
        cur = nxt; cA = nA; cB = nB; ++ui;
        if constexpr (ALIGN_EPI) { if (wr == 1) PG8_BAR; }
    }
    PG8_WAIT_V(0);
    if constexpr (!ALIGN_EPI) { if (wr == 0) PG8_BAR; }
    PG8_BAR;
    if constexpr (Epi::AFTER_DRAIN) { E.fused(acc, cur, wr, wc, fr, fq, lds, wid, lane); S.done(cur); }
#undef PG8_SA
#undef PG8_SB
#undef PG8_STAGE
#undef PG8_LDA
#undef PG8_LDB
#undef PG8_MMA
#undef PG8_WAIT_V
#undef PG8_WAIT_L
#undef PG8_BAR
#undef PG8_SCHED
}
}

constexpr int SEQ = 8192, DM = 4096, NMEM = 256, FF = 11008, XAW = 1024, ABIN = 12312;
constexpr int NCH = 128;
constexpr float EPS = 1e-6f;
constexpr int NWAVES = 8, NTHREADS = 512;
#ifndef MK_SINGLE
#define MK_SINGLE 1
#endif
constexpr int N_STEPS = 27;

constexpr size_t MiB = 1u << 20;
constexpr size_t WS_CTL = 0, CTL_ZERO_BYTES = 1 * MiB;
constexpr size_t WS_GATES = 1 * MiB;
constexpr size_t WS_MLS = 2 * MiB;
constexpr size_t WS_RS = 2 * MiB + 768 * 1024;
constexpr size_t WS_NST = 3 * MiB;
constexpr size_t WS_MEMN = 4 * MiB;
constexpr size_t WS_KMEM = 8 * MiB;
constexpr size_t WS_VTMEM = 8 * MiB + 512 * 1024;
constexpr size_t WS_XQ = 16 * MiB;
constexpr size_t WS_XO = 32 * MiB;
constexpr size_t WS_XN = 48 * MiB;
constexpr size_t WS_HB = 112 * MiB;
constexpr size_t WS_HC = 176 * MiB;
constexpr size_t WS_GG = 240 * MiB;
constexpr size_t WS_BIG = 272 * MiB;
constexpr size_t WS_PROJ = WS_BIG;
constexpr size_t WS_VT = WS_BIG + 132 * MiB;
constexpr size_t WS_STATE = WS_BIG + 196 * MiB;
constexpr size_t WS_H = WS_BIG;
constexpr size_t WS_HALO = WS_GG;
constexpr size_t WS_W = 724 * MiB;
constexpr size_t LAYER_W = 420 * MiB;
constexpr size_t WO_MAIN = 0, WO_V = 66 * MiB, WO_OUT = 98 * MiB, WO_XQ = 130 * MiB, WO_XK = 138 * MiB, WO_XV = 146 * MiB, WO_XO = 154 * MiB, WO_GU = 162 * MiB, WO_DOWN = 334 * MiB;
constexpr size_t WS_END = WS_W + 2 * LAYER_W;
constexpr int CW_TMO = 0, CW_CODE = 1, CW_BAR = 4096;
constexpr int MLS_A = 0, MLS_PM = 4 * SEQ, MLS_BC = 8 * SEQ, MLS_CHB = 12 * SEQ, MLS_CHP = 12 * SEQ + 4 * NCH, MLS_MC = 12 * SEQ + 8 * NCH;

constexpr int SCR_BYTES = 143360;
constexpr int LDSCTL_OFF = SCR_BYTES, MISC_OFF = LDSCTL_OFF + 320;
constexpr int LDS_BYTES = 147456;

#define GAS __attribute__((address_space(1)))
#define LAS __attribute__((address_space(3)))
typedef unsigned short bf16;
typedef unsigned v4u __attribute__((ext_vector_type(4)));
typedef unsigned v2u __attribute__((ext_vector_type(2)));
typedef float f32x4 __attribute__((ext_vector_type(4)));
typedef short bf16x8 __attribute__((ext_vector_type(8)));
typedef short s16x4 __attribute__((ext_vector_type(4)));
typedef GAS unsigned gu32;
#define RLX_AGENT __ATOMIC_RELAXED, __HIP_MEMORY_SCOPE_AGENT
#define LDS_WAIT() asm volatile("s_waitcnt lgkmcnt(0)" ::: "memory")
#define VM_WAIT() asm volatile("s_waitcnt vmcnt(0)" ::: "memory")
typedef float f32x2c __attribute__((ext_vector_type(2)));
typedef __bf16 bf16x2c __attribute__((ext_vector_type(2)));
__device__ __forceinline__ unsigned pk2(float lo, float hi) { const f32x2c v = {lo, hi}; return __builtin_bit_cast(unsigned, __builtin_convertvector(v, bf16x2c)); }
__device__ __forceinline__ unsigned f2bf(float f) { return pk2(f, 0.f) & 0xffffu; }
__device__ __forceinline__ float bflo(unsigned w) { return __uint_as_float(w << 16); }
__device__ __forceinline__ float bfhi(unsigned w) { return __uint_as_float(w & 0xffff0000u); }
__device__ __forceinline__ f32x4 mma(bf16x8 a, bf16x8 b, f32x4 c) { return __builtin_amdgcn_mfma_f32_16x16x32_bf16(a, b, c, 0, 0, 0); }
__device__ __forceinline__ bf16x8 cat8(s16x4 lo, s16x4 hi) { return __builtin_shufflevector(lo, hi, 0, 1, 2, 3, 4, 5, 6, 7); }
__device__ __forceinline__ bf16x8 u4_as_frag(v4u w) { return __builtin_bit_cast(bf16x8, w); }
__device__ __forceinline__ float wave_sum(float v) {
#pragma unroll
    for (int o = 1; o < 64; o <<= 1) v += __shfl_xor(v, o);
    return v;
}
__device__ __forceinline__ float logsig_acc(float x) { return fminf(x, 0.f) - log1pf(expf(-fabsf(x))); }
__device__ __forceinline__ float logsig_fast(float x) { return fminf(x, 0.f) - __logf(1.f + __expf(-fabsf(x))); }
__device__ __forceinline__ float fexp2(float x) { return __builtin_amdgcn_exp2f(x); }
__device__ __forceinline__ float flog2(float x) { return __builtin_amdgcn_logf(x); }
__device__ __forceinline__ float frcp(float x) { return __builtin_amdgcn_rcpf(x); }
__device__ __forceinline__ float fexpf(float x) { return __builtin_amdgcn_exp2f(1.4426950408889634f * x); }
__device__ __forceinline__ float sigmoid_fast(float x) { return frcp(1.f + fexp2(-1.4426950408889634f * x)); }
__device__ __forceinline__ float xor16f(float x, int fq) { const unsigned u = __float_as_uint(x); const auto r = __builtin_amdgcn_permlane16_swap(u, u, false, false); return __uint_as_float((fq & 1) ? r[0] : r[1]); }
__device__ __forceinline__ float xor32f(float x, int fq) { const unsigned u = __float_as_uint(x); const auto r = __builtin_amdgcn_permlane32_swap(u, u, false, false); return __uint_as_float((fq & 2) ? r[0] : r[1]); }
__device__ __forceinline__ bf16x8 tr_frag(const LAS bf16* tile, int ld, int lane) {
    const int g = lane >> 4, li = lane & 15, q = li >> 2, p = li & 3;
    const LAS bf16* a = tile + (8 * g + q) * ld + 4 * p;
    const s16x4 lo = __builtin_amdgcn_ds_read_tr16_b64_v4i16((LAS s16x4*)a);
    const s16x4 hi = __builtin_amdgcn_ds_read_tr16_b64_v4i16((LAS s16x4*)(a + 4 * ld));
    return cat8(lo, hi);
}
struct Args { const float* in[28]; float* out; unsigned char* ws; int ph_lo, ph_hi; };
#define XB_TMO      128
#define XB_XCNT(j)  (256  + 64 * (j))
#define XB_XSUB(j)  (1280 + 64 * (j))
#define XB_XGEN(j)  (2304 + 64 * (j))
#define XB_TOP      3328
#define XB_TOPGEN   3392
#define XCD_BAR_WORDS 3456
#define XB_SPIN_CAP (1u << 18)

__device__ __forceinline__ unsigned xb_ld(unsigned* p)              { return __hip_atomic_load(p, __ATOMIC_RELAXED, __HIP_MEMORY_SCOPE_AGENT); }
__device__ __forceinline__ unsigned xb_add(unsigned* p, unsigned v) { return __hip_atomic_fetch_add(p, v, __ATOMIC_RELAXED, __HIP_MEMORY_SCOPE_AGENT); }
__device__ __forceinline__ unsigned xb_xcc_id() { return (unsigned)__builtin_amdgcn_s_getreg((3 << 11) | 20) & 0xFu; }
#define XB_SPIN(cond, bar) do { unsigned _sp = 0; while (cond) { __builtin_amdgcn_s_sleep(1); \
    if ((++_sp & 255u) == 0u) { if (xb_ld(&(bar)[XB_TMO])) break; if (_sp > XB_SPIN_CAP) { atomicAdd(&(bar)[XB_TMO], 1u); break; } } } } while (0)

struct XcdBarrier {
    unsigned* bar; unsigned x;
    volatile LAS unsigned* st;
};

__device__ __forceinline__ XcdBarrier xcd_barrier_post(unsigned* bar, volatile LAS unsigned* st) {
    XcdBarrier b; b.bar = bar; b.x = xb_xcc_id(); b.st = st;
    if (threadIdx.x == 0) (void)xb_add(&bar[XB_XCNT(b.x)], 1u);
    return b;
}
__device__ __forceinline__ void xcd_barrier_complete(unsigned* bar, unsigned x, unsigned& nloc, unsigned& nx) {
    const unsigned G = gridDim.x * gridDim.y * gridDim.z;
    unsigned sum, cnt, mine, sp = 0u;
    for (;;) {
        sum = 0u; cnt = 0u; mine = 0u;
#pragma unroll
        for (unsigned j = 0; j < 16; ++j) { const unsigned c = xb_ld(&bar[XB_XCNT(j)]); sum += c; cnt += (c > 0u) ? 1u : 0u; mine = (j == x) ? c : mine; }
        if (sum == G) break;
        __builtin_amdgcn_s_sleep(1);
        if ((++sp & 255u) == 0u) { if (xb_ld(&bar[XB_TMO])) break; if (sp > XB_SPIN_CAP) { atomicAdd(&bar[XB_TMO], 1u); break; } }
    }
    nloc = mine > 0u ? mine : 1u; nx = cnt > 0u ? cnt : 1u;
}

__device__ __forceinline__ void xcd_barrier(const XcdBarrier& b) {
    asm volatile("s_waitcnt vmcnt(0)" ::: "memory");
    __syncthreads();
    if (threadIdx.x == 0) {
        unsigned* bar = b.bar;
        __builtin_amdgcn_s_waitcnt(0);
        unsigned nloc = b.st[0], nx = b.st[1];
        if (nloc == 0u) { xcd_barrier_complete(bar, b.x, nloc, nx); b.st[0] = nloc; b.st[1] = nx; }
        const unsigned old = xb_add(&bar[XB_XSUB(b.x)], 1u);
        const unsigned gen = old / nloc;
        if (old + 1u == (gen + 1u) * nloc) {
            __builtin_amdgcn_fence(__ATOMIC_RELEASE, "agent");
            asm volatile("s_waitcnt vmcnt(0)" ::: "memory");
            const unsigned og = xb_add(&bar[XB_TOP], 1u);
            const unsigned tg = og / nx;
            if (og + 1u == (tg + 1u) * nx) xb_add(&bar[XB_TOPGEN], 1u);
            else XB_SPIN(xb_ld(&bar[XB_TOPGEN]) == tg, bar);
            __builtin_amdgcn_fence(__ATOMIC_ACQUIRE, "agent");
            xb_add(&bar[XB_XGEN(b.x)], 1u);
            asm volatile("s_waitcnt vmcnt(0)" ::: "memory");
        } else {
            XB_SPIN(xb_ld(&bar[XB_XGEN(b.x)]) == gen, bar);
            __builtin_amdgcn_fence(__ATOMIC_ACQUIRE, "agent");
            asm volatile("s_waitcnt vmcnt(0)" ::: "memory");
        }
    }
    __syncthreads();
}


__device__ __forceinline__ void tr_load(const float* src, int N, f32x4 (&v)[16], int lane) {
    const int r4 = lane >> 4, c4 = (lane & 15) * 4;
#pragma unroll
    for (int i = 0; i < 16; ++i) v[i] = *(const f32x4*)(src + (size_t)(4 * i + r4) * N + c4);
}
__device__ __forceinline__ void tr_to_lds(const f32x4 (&v)[16], LAS float* scr, int lane) {
    const int r4 = lane >> 4, c4 = (lane & 15) * 4;
#pragma unroll
    for (int i = 0; i < 16; ++i) { LAS float* s = scr + (4 * i + r4) * 65 + c4; s[0] = v[i].x; s[1] = v[i].y; s[2] = v[i].z; s[3] = v[i].w; }
    LDS_WAIT(); asm volatile("" ::: "memory");
}
__device__ __forceinline__ void tr_store(bf16* dst, int K, const LAS float* scr, int lane) {
    const int c = lane & 7;
#pragma unroll
    for (int j = 0; j < 8; ++j) { const int n = (lane >> 3) + 8 * j; const LAS float* s = scr + (8 * c) * 65 + n;
        v4u o; o.x = pk2(s[0], s[65]); o.y = pk2(s[130], s[195]); o.z = pk2(s[260], s[325]); o.w = pk2(s[390], s[455]);
        *(v4u*)(dst + (size_t)n * K + 8 * c) = o; }
    LDS_WAIT(); asm volatile("" ::: "memory");
}
struct Seg { int in_idx, src_l, N, K, scol, ncols, layer, wsub_mib, drow, ilv; };
__device__ __forceinline__ Seg seg_at(int i) {
    constexpr Seg segs[26] = {
        {4, 0, ABIN, DM, 0, 1024, 0, 0, 0, 0}, {4, 0, ABIN, DM, 1024, 1024, 0, 0, 1024, 0}, {4, 0, ABIN, DM, 4096, 2048, 0, 0, 2048, 0},
        {4, 0, ABIN, DM, 6152, 1024, 0, 0, 4096, 0}, {4, 0, ABIN, DM, 7176, 1024, 0, 0, 5120, 0}, {4, 0, ABIN, DM, 10248, 2048, 0, 0, 6144, 0},
        {4, 0, ABIN, DM, 2048, 2048, 0, 66, 0, 0}, {4, 0, ABIN, DM, 8200, 2048, 0, 66, 2048, 0},
        {11, 0, DM, DM, 0, DM, 0, 98, 0, 0},
        {17, 0, XAW, DM, 0, XAW, 0, 130, 0, 0}, {18, 0, XAW, DM, 0, XAW, 0, 138, 0, 0}, {19, 0, XAW, DM, 0, XAW, 0, 146, 0, 0}, {20, 0, DM, XAW, 0, DM, 0, 154, 0, 0},
        {23, 0, FF, DM, 0, FF, 0, 162, 0, 1}, {24, 0, FF, DM, 0, FF, 0, 162, 128, 1}, {27, 0, DM, FF, 0, DM, 0, 334, 0, 0},
        {12, 0, 3 * DM, DM, 0, 2 * DM, 1, 0, 0, 0}, {12, 0, 3 * DM, DM, 2 * DM, DM, 1, 66, 0, 0},
        {13, 0, DM, DM, 0, DM, 1, 98, 0, 0},
        {17, 1, XAW, DM, 0, XAW, 1, 130, 0, 0}, {18, 1, XAW, DM, 0, XAW, 1, 138, 0, 0}, {19, 1, XAW, DM, 0, XAW, 1, 146, 0, 0}, {20, 1, DM, XAW, 0, DM, 1, 154, 0, 0},
        {23, 1, FF, DM, 0, FF, 1, 162, 0, 1}, {24, 1, FF, DM, 0, FF, 1, 162, 128, 1}, {27, 1, DM, FF, 0, DM, 1, 334, 0, 0}};
    return segs[i];
}
__device__ __forceinline__ void convert_segments(const Args& args, unsigned char* ws, LAS unsigned char* lds, int seg_lo, int seg_hi, int part_lo, int part_hi, int nparts, int wid, int nw, int wave, int lane) {
    LAS float* scr = (LAS float*)(lds + wave * 16640);
#pragma unroll 1
    for (int sI = seg_lo; sI < seg_hi; ++sI) {
        const Seg sg = seg_at(sI);
        const int nblk = sg.ncols / 64, nit = (sg.K / 64) * nblk;
        const float* W = args.in[sg.in_idx] + (size_t)sg.src_l * sg.K * sg.N;
        bf16* WT = (bf16*)(ws + WS_W + (size_t)sg.layer * LAYER_W + (size_t)sg.wsub_mib * MiB);
        const int it_lo = (int)((long)nit * part_lo / nparts), it_hi = (int)((long)nit * part_hi / nparts);
        int it = it_lo + wid;
        f32x4 v[16];
        if (it < it_hi) { const int kb = it / nblk, nb = it - kb * nblk; tr_load(W + (size_t)(64 * kb) * sg.N + sg.scol + 64 * nb, sg.N, v, lane); }
#pragma unroll 1
        for (; it < it_hi; it += nw) {
            const int kb = it / nblk, nb = it - kb * nblk;
            const int drow = sg.ilv ? (256 * (nb >> 1) + 64 * (nb & 1) + sg.drow) : (sg.drow + 64 * nb);
            tr_to_lds(v, scr, lane);
            const int itn = it + nw;
            if (itn < it_hi) { const int kbn = itn / nblk, nbn = itn - kbn * nblk; tr_load(W + (size_t)(64 * kbn) * sg.N + sg.scol + 64 * nbn, sg.N, v, lane); }
            tr_store(WT + (size_t)drow * sg.K + 64 * kb, sg.K, scr, lane);
        }
    }
}
#ifndef RIDER_ON
#define RIDER_ON 1
#endif
constexpr int SEG_SB = 18, SEG_DEFER = 23, SEG_END = 26, XA_BUSY_WGS = 136, GU_BUSY_WGS = 192;
__device__ __forceinline__ void p0_prologue(const Args& args, unsigned char* ws, LAS unsigned char* lds, int gw, int NGW, int wave, int lane, bool defer) {
    convert_segments(args, ws, lds, 0, defer ? (RIDER_ON ? SEG_SB : SEG_DEFER) : SEG_END, 0, 1, 1, gw, NGW, wave, lane);
    {
        const float* W = args.in[4]; bf16* WT = (bf16*)(ws + WS_W + WO_MAIN) + (size_t)8192 * DM;
        for (int idx = gw * 64 + lane; idx < 256 * DM; idx += NGW * 64) {
            const int i = idx >> 12, k = idx & (DM - 1);
            float v = 0.f;
            if (i < 24) { const int col = i < 4 ? 6144 + i : (i < 8 ? 6148 + (i - 4) : 12296 + (i - 8)); v = W[(size_t)k * ABIN + col]; }
            WT[idx] = (bf16)f2bf(v);
        }
    }
    for (int r = gw; r < 2 * NMEM; r += NGW) {
        const int l = r >> 8, row = r & 255;
        const float* xr = args.in[1] + (size_t)row * DM; const float* g = args.in[16] + (size_t)l * DM;
        bf16* o = (bf16*)(ws + WS_MEMN) + (size_t)r * DM;
        f32x4 v[16]; float ss = 0.f;
#pragma unroll
        for (int j = 0; j < 16; ++j) { v[j] = *(const f32x4*)(xr + 4 * lane + 256 * j); ss += v[j].x * v[j].x + v[j].y * v[j].y + v[j].z * v[j].z + v[j].w * v[j].w; }
        const float rstd = rsqrtf(wave_sum(ss) * (1.f / DM) + EPS);
#pragma unroll
        for (int j = 0; j < 16; ++j) { const f32x4 gg = *(const f32x4*)(g + 4 * lane + 256 * j);
            v2u w; w.x = pk2(v[j].x * rstd * gg.x, v[j].y * rstd * gg.y); w.y = pk2(v[j].z * rstd * gg.z, v[j].w * rstd * gg.w);
            *(v2u*)(o + 4 * lane + 256 * j) = w; }
    }
}

#define LAUNDER8(a, o) asm volatile("" : "+v"(a[o].x), "+v"(a[o].y), "+v"(a[o+1].x), "+v"(a[o+1].y), "+v"(a[o+2].x), "+v"(a[o+2].y), "+v"(a[o+3].x), "+v"(a[o+3].y), \
    "+v"(a[o+4].x), "+v"(a[o+4].y), "+v"(a[o+5].x), "+v"(a[o+5].y), "+v"(a[o+6].x), "+v"(a[o+6].y), "+v"(a[o+7].x), "+v"(a[o+7].y))
#define LAUNDER_ROW(pw, hw) do { LAUNDER8(pw, 0); LAUNDER8(pw, 8); LAUNDER8(hw, 0); LAUNDER8(hw, 8); } while (0)
template <int MODE>
__device__ __forceinline__ void norm_rows(const float* xin, const bf16* hb, const float* gprev, const float* gpost, const float* gpre, float* xout, bf16* xn, float* rs,
                                          LAS unsigned char* lds, int gw, int NGW, int tid, int lane, bf16* xn_out = nullptr, float* rs_out = nullptr) {
    if (!xn_out) { xn_out = xn; rs_out = rs; }
    LAS float* GP = (LAS float*)lds; LAS float* GN = (LAS float*)(lds + 16384); LAS float* GI = (LAS float*)(lds + 32768);
    __syncthreads();
#pragma unroll
    for (int i = 0; i < 2; ++i) { const int o = 4 * (tid + NTHREADS * i);
        if (MODE != 0) { *(LAS f32x4*)(GP + o) = *(const f32x4*)(gpost + o); const f32x4 g = *(const f32x4*)(gprev + o); *(LAS f32x4*)(GI + o) = (f32x4){1.f / g.x, 1.f / g.y, 1.f / g.z, 1.f / g.w}; }
        if (MODE != 2) *(LAS f32x4*)(GN + o) = *(const f32x4*)(gpre + o); }
    __syncthreads();
    const int lo4 = 4 * lane;
#pragma unroll 1
    for (int row = gw; row < SEQ; row += NGW) {
        asm volatile("" ::: "memory");
        if (MODE == 0) {
            const float* xr = xin + (size_t)row * DM; bf16* nw = xn_out + (size_t)row * DM;
            f32x4 xv[16]; float ss = 0.f;
#pragma unroll
            for (int j = 0; j < 16; ++j) { xv[j] = *(const f32x4*)(xr + lo4 + 256 * j); ss += xv[j].x * xv[j].x + xv[j].y * xv[j].y + xv[j].z * xv[j].z + xv[j].w * xv[j].w; }
            const float rstd = rsqrtf(wave_sum(ss) * (1.f / DM) + EPS);
            if (lane == 0) rs_out[row] = rstd;
            asm volatile("" ::: "memory");
#pragma unroll
            for (int j = 0; j < 16; ++j) { const f32x4 g = *(const LAS f32x4*)(GN + lo4 + 256 * j);
                v2u w; w.x = pk2(xv[j].x * rstd * g.x, xv[j].y * rstd * g.y); w.y = pk2(xv[j].z * rstd * g.z, xv[j].w * rstd * g.w);
                *(v2u*)(nw + lo4 + 256 * j) = w; }
        } else {
            const bf16* pr = xn + (size_t)row * DM; bf16* pw_out = xn_out + (size_t)row * DM; const bf16* hr = hb + (size_t)row * DM;
            v2u pw[16], hw[16]; float ss = 0.f;
#pragma unroll
            for (int j = 0; j < 16; ++j) { pw[j] = *(const v2u*)(pr + lo4 + 256 * j); hw[j] = *(const v2u*)(hr + lo4 + 256 * j); }
            const float ri = 1.f / rs[row];
#pragma unroll
            for (int j = 0; j < 16; ++j) { const float a = bflo(hw[j].x), b = bfhi(hw[j].x), c = bflo(hw[j].y), d = bfhi(hw[j].y); ss += a * a + b * b + c * c + d * d; }
            const float rstd = rsqrtf(wave_sum(ss) * (1.f / DM) + EPS);
            asm volatile("" ::: "memory");
            LAUNDER_ROW(pw, hw);
            float ss2 = 0.f;
#pragma unroll
            for (int j = 0; j < 16; ++j) { const f32x4 g = *(const LAS f32x4*)(GP + lo4 + 256 * j), gi = *(const LAS f32x4*)(GI + lo4 + 256 * j);
                f32x4 x;
                x.x = bflo(pw[j].x) * ri * gi.x + bflo(hw[j].x) * rstd * g.x; x.y = bfhi(pw[j].x) * ri * gi.y + bfhi(hw[j].x) * rstd * g.y;
                x.z = bflo(pw[j].y) * ri * gi.z + bflo(hw[j].y) * rstd * g.z; x.w = bfhi(pw[j].y) * ri * gi.w + bfhi(hw[j].y) * rstd * g.w;
                if (MODE == 2) *(f32x4*)(xout + (size_t)row * DM + lo4 + 256 * j) = x;
                else ss2 += x.x * x.x + x.y * x.y + x.z * x.z + x.w * x.w;
                if (j & 1) __builtin_amdgcn_sched_barrier(0); }
            if (MODE == 1) {
                const float rstd2 = rsqrtf(wave_sum(ss2) * (1.f / DM) + EPS);
                if (lane == 0) rs_out[row] = rstd2;
                LAUNDER_ROW(pw, hw);
                float ri2 = ri, rstdb = rstd; asm volatile("" : "+v"(ri2), "+v"(rstdb) :: "memory");
#pragma unroll
                for (int j = 0; j < 16; ++j) { const f32x4 g = *(const LAS f32x4*)(GP + lo4 + 256 * j), gi = *(const LAS f32x4*)(GI + lo4 + 256 * j), gn = *(const LAS f32x4*)(GN + lo4 + 256 * j);
                    f32x4 x;
                    x.x = bflo(pw[j].x) * ri2 * gi.x + bflo(hw[j].x) * rstdb * g.x; x.y = bfhi(pw[j].x) * ri2 * gi.y + bfhi(hw[j].x) * rstdb * g.y;
                    x.z = bflo(pw[j].y) * ri2 * gi.z + bflo(hw[j].y) * rstdb * g.z; x.w = bfhi(pw[j].y) * ri2 * gi.w + bfhi(hw[j].y) * rstdb * g.w;
                    v2u w; w.x = pk2(x.x * rstd2 * gn.x, x.y * rstd2 * gn.y); w.y = pk2(x.z * rstd2 * gn.z, x.w * rstd2 * gn.w);
                    *(v2u*)(pw_out + lo4 + 256 * j) = w;
                    if (j & 1) __builtin_amdgcn_sched_barrier(0); }
            }
        }
    }
}

__device__ __forceinline__ void gates_minigemm(unsigned char* ws, LAS unsigned char* lds, int bx, int G, int tid, int wave, int lane) {
    const bf16* XNp = (const bf16*)(ws + WS_XN); const bf16* WG = (const bf16*)(ws + WS_W + WO_MAIN) + (size_t)8192 * DM; float* GT = (float*)(ws + WS_GATES);
    LAS f32x4* RED = (LAS f32x4*)lds;
#pragma unroll 1
    for (int blk = bx; blk < SEQ / 32; blk += G) {
        asm volatile("" : "+v"(lane));
        const int fr = lane & 15, fq = lane >> 4;
        const int t0 = 32 * blk;
        f32x4 acc[2][2];
#pragma unroll
        for (int a = 0; a < 2; ++a)
#pragma unroll
            for (int b = 0; b < 2; ++b) acc[a][b] = (f32x4){0.f, 0.f, 0.f, 0.f};
        const int lo = fr * DM + 8 * fq;
        const bf16* ap = (XNp + (size_t)t0 * DM + wave * 512) + lo; const bf16* bp = (WG + wave * 512) + lo;
#pragma unroll 4
        for (int ks = 0; ks < 16; ++ks) {
            const bf16x8 a0 = *(const bf16x8*)(ap + 32 * ks), a1 = *(const bf16x8*)(ap + (size_t)16 * DM + 32 * ks);
            const bf16x8 b0 = *(const bf16x8*)(bp + 32 * ks), b1 = *(const bf16x8*)(bp + (size_t)16 * DM + 32 * ks);
            acc[0][0] = mma(b0, a0, acc[0][0]); acc[0][1] = mma(b1, a0, acc[0][1]); acc[1][0] = mma(b0, a1, acc[1][0]); acc[1][1] = mma(b1, a1, acc[1][1]);
        }
        __syncthreads();
#pragma unroll
        for (int a = 0; a < 2; ++a)
#pragma unroll
            for (int b = 0; b < 2; ++b) RED[(wave * 4 + a * 2 + b) * 64 + lane] = acc[a][b];
        __syncthreads();
        if (tid < 256) { const int tile = tid >> 6, l = tid & 63, rt = tile >> 1, ct = tile & 1; f32x4 s = {0.f, 0.f, 0.f, 0.f};
#pragma unroll
            for (int w = 0; w < 8; ++w) s = s + RED[(w * 4 + tile) * 64 + l];
            *(f32x4*)(GT + (size_t)(t0 + 16 * rt + (l & 15)) * 32 + 16 * ct + 4 * (l >> 4)) = s; }
    }
}

__device__ __forceinline__ float scan_sum(float x, int lane) {
#pragma unroll
    for (int o = 1; o < 64; o <<= 1) { const float y = __shfl_up(x, o); if (lane >= o) x += y; }
    return x;
}
__device__ __forceinline__ float scan_max(float x, int lane) {
#pragma unroll
    for (int o = 1; o < 64; o <<= 1) { const float y = __shfl_up(x, o); if (lane >= o) x = fmaxf(x, y); }
    return x;
}
__device__ __forceinline__ void mlstm_local(const float* gates, float* mls, float bi, float bfb, int h, int c, int lane, LAS float* stash) {
    const int t = c * 64 + lane;
    const float mi = gates[(size_t)t * 32 + h], mf = gates[(size_t)t * 32 + 4 + h];
    const float li = 15.f * tanhf((mi + bi) * (1.f / 15.f)), fp = 15.f * tanhf((mf + bfb) * (1.f / 15.f));
    const float lf = logsig_acc(fp);
    const float bcum = scan_sum(lf, lane);
    const float a = li - bcum;
    const float pm = scan_max(a, lane);
    mls[MLS_A + h * SEQ + t] = a; mls[MLS_PM + h * SEQ + t] = pm; mls[MLS_BC + h * SEQ + t] = bcum;
    if (lane == 63) { mls[MLS_CHB + h * NCH + c] = bcum; mls[MLS_CHP + h * NCH + c] = pm; stash[64] = pm; stash[65] = bcum; }
    stash[lane] = a;
}

constexpr int TL = 264;
constexpr int NPAIR = 64;
__device__ __forceinline__ void gla_g_chunk(const Args& args, const float* gates, float* G, LAS float* GS, LAS float* GRS, int c, int head, int tid) {
    if (tid < 256) { const int t = tid >> 2, r4 = (tid & 3) * 4; *(LAS f32x4*)(GRS + t * 16 + r4) = *(const f32x4*)(gates + (size_t)(c * 64 + t) * 32 + 8 + r4); }
    __syncthreads();
    const int d = tid & 255, half = tid >> 8, col = head * 256 + d;
    float w[16];
#pragma unroll
    for (int r = 0; r < 16; ++r) w[r] = args.in[8][r * 1024 + col];
    const float b = args.in[9][col];
    float acc = 0.f;
#pragma unroll 4
    for (int tt = 0; tt < 32; ++tt) { const int t = 32 * half + tt;
        float z = b;
#pragma unroll
        for (int q4 = 0; q4 < 4; ++q4) { const f32x4 g4 = *(const LAS f32x4*)(GRS + t * 16 + 4 * q4); z += g4.x * w[4 * q4] + g4.y * w[4 * q4 + 1] + g4.z * w[4 * q4 + 2] + g4.w * w[4 * q4 + 3]; }
        acc += (fminf(z, 0.f) - 0.6931471805599453f * flog2(1.f + fexp2(-1.4426950408889634f * fabsf(z)))) * 0.0625f;
        GS[t * 256 + d] = acc; }
    __syncthreads();
    const float add = half ? GS[31 * 256 + d] : 0.f;
#pragma unroll 4
    for (int tt = 0; tt < 32; ++tt) { const int t = 32 * half + tt; const float gv = GS[t * 256 + d] + add;
        if (half) GS[t * 256 + d] = gv;
        G[(size_t)(c * 64 + t) * 1024 + col] = gv; }
    __syncthreads();
}
__device__ __forceinline__ void dc_unit(const Args& args, unsigned char* ws, LAS unsigned char* lds, int u, int tid, int wave, int lane) {
    asm volatile("" : "+v"(lane), "+v"(tid));
    const int mixer = u >> 8, pair = (u >> 2) & 63, head = u & 3;
    const bf16* PROJ = (const bf16*)(ws + WS_PROJ); const bf16* VT = (const bf16*)(ws + WS_VT);
    const float* gates = (const float*)(ws + WS_GATES);
    LAS bf16* KS = (LAS bf16*)lds;
    LAS float* GS = (LAS float*)(lds + 68608);
    LAS float* GRS = (LAS float*)(lds + 137216);
    LAS float* GLB = (LAS float*)(lds + 141312);
    const int kcol = (mixer ? 5120 : 1024) + head * 256;
    const int tok0 = 128 * pair;
    __syncthreads();
    if (mixer == 0) {
        if (wave < 2) mlstm_local(gates, (float*)(ws + WS_MLS), args.in[5][head], args.in[6][head], head, 2 * pair + wave, lane, GS + 128 * wave);
        __syncthreads();
        const float blA = GS[65], pmP = fmaxf(GS[64], GS[128 + 64] - blA);
#pragma unroll
        for (int i = 0; i < 8; ++i) {
            const int q = tid + 512 * i, s = q >> 5, d0 = (q & 31) * 8;
            const v4u kw = *(const v4u*)(PROJ + (size_t)(tok0 + s) * 8192 + kcol + d0);
            const float aa = (s < 64) ? GS[s] : (GS[128 + s - 64] - blA);
            const float w = fexp2(1.4426950408889634f * (aa - pmP)) * 0.0625f;
            v4u o; o.x = pk2(bflo(kw.x) * w, bfhi(kw.x) * w); o.y = pk2(bflo(kw.y) * w, bfhi(kw.y) * w); o.z = pk2(bflo(kw.z) * w, bfhi(kw.z) * w); o.w = pk2(bflo(kw.w) * w, bfhi(kw.w) * w);
            *(LAS v4u*)(KS + s * TL + d0) = o;
        }
    } else {
        float* G = (float*)(ws + WS_GG);
        gla_g_chunk(args, gates, G, GS, GRS, 2 * pair + 1, head, tid);
        if (tid < 256) GLB[tid] = GS[63 * 256 + tid];
#pragma unroll
        for (int i = 0; i < 4; ++i) {
            const int q = tid + 512 * i, s = q >> 5, d0 = (q & 31) * 8;
            const v4u kw = *(const v4u*)(PROJ + (size_t)(tok0 + 64 + s) * 8192 + kcol + d0);
            const f32x4 a0 = *(const LAS f32x4*)(GS + 63 * 256 + d0), a1 = *(const LAS f32x4*)(GS + 63 * 256 + d0 + 4), b0 = *(const LAS f32x4*)(GS + s * 256 + d0), b1 = *(const LAS f32x4*)(GS + s * 256 + d0 + 4);
            v4u o; o.x = pk2(bflo(kw.x) * fexpf(a0.x - b0.x), bfhi(kw.x) * fexpf(a0.y - b0.y)); o.y = pk2(bflo(kw.y) * fexpf(a0.z - b0.z), bfhi(kw.y) * fexpf(a0.w - b0.w));
            o.z = pk2(bflo(kw.z) * fexpf(a1.x - b1.x), bfhi(kw.z) * fexpf(a1.y - b1.y)); o.w = pk2(bflo(kw.w) * fexpf(a1.z - b1.z), bfhi(kw.w) * fexpf(a1.w - b1.w));
            *(LAS v4u*)(KS + (64 + s) * TL + d0) = o;
        }
        __syncthreads();
        gla_g_chunk(args, gates, G, GS, GRS, 2 * pair, head, tid);
#pragma unroll
        for (int i = 0; i < 4; ++i) {
            const int q = tid + 512 * i, s = q >> 5, d0 = (q & 31) * 8;
            const v4u kw = *(const v4u*)(PROJ + (size_t)(tok0 + s) * 8192 + kcol + d0);
            const f32x4 a0 = *(const LAS f32x4*)(GS + 63 * 256 + d0), a1 = *(const LAS f32x4*)(GS + 63 * 256 + d0 + 4), b0 = *(const LAS f32x4*)(GS + s * 256 + d0), b1 = *(const LAS f32x4*)(GS + s * 256 + d0 + 4);
            const f32x4 c0 = *(const LAS f32x4*)(GLB + d0), c1 = *(const LAS f32x4*)(GLB + d0 + 4);
            v4u o; o.x = pk2(bflo(kw.x) * fexpf(a0.x - b0.x + c0.x), bfhi(kw.x) * fexpf(a0.y - b0.y + c0.y)); o.y = pk2(bflo(kw.y) * fexpf(a0.z - b0.z + c0.z), bfhi(kw.y) * fexpf(a0.w - b0.w + c0.w));
            o.z = pk2(bflo(kw.z) * fexpf(a1.x - b1.x + c1.x), bfhi(kw.z) * fexpf(a1.y - b1.y + c1.y)); o.w = pk2(bflo(kw.w) * fexpf(a1.z - b1.z + c1.z), bfhi(kw.w) * fexpf(a1.w - b1.w + c1.w));
            *(LAS v4u*)(KS + s * TL + d0) = o;
        }
    }
    __syncthreads();
    const int fr = lane & 15, fq = lane >> 4;
    bf16* ST = (bf16*)(ws + WS_STATE) + ((size_t)((mixer * 4 + head) * NPAIR + pair)) * (512 * 256);
    const int vrow0 = mixer * 2048 + head * 512 + wave * 64;
    LAS bf16* OS = (LAS bf16*)(lds + 68608 + wave * 8448);
#pragma unroll 1
    for (int vt = 0; vt < 4; ++vt) {
        const bf16* vp = (VT + (size_t)(vrow0 + 16 * vt) * 8192 + tok0) + (fr * 8192 + 8 * fq);
        const bf16x8 b0 = *(const bf16x8*)vp, b1 = *(const bf16x8*)(vp + 32), b2 = *(const bf16x8*)(vp + 64), b3 = *(const bf16x8*)(vp + 96);
#pragma unroll 4
        for (int dt = 0; dt < 16; ++dt) {
            f32x4 acc = {0.f, 0.f, 0.f, 0.f};
            acc = mma(tr_frag(KS + 16 * dt, TL, lane), b0, acc); acc = mma(tr_frag(KS + 32 * TL + 16 * dt, TL, lane), b1, acc);
            acc = mma(tr_frag(KS + 64 * TL + 16 * dt, TL, lane), b2, acc); acc = mma(tr_frag(KS + 96 * TL + 16 * dt, TL, lane), b3, acc);
            v2u w; w.x = pk2(acc[0], acc[1]); w.y = pk2(acc[2], acc[3]);
            *(LAS v2u*)(OS + fr * 264 + 16 * dt + 4 * fq) = w;
        }
        LDS_WAIT(); asm volatile("" ::: "memory");
        bf16* op = ST + (size_t)(wave * 64 + 16 * vt) * 256;
#pragma unroll
        for (int i = 0; i < 8; ++i) { const int rr = 2 * i + (lane >> 5), cc = (lane & 31) * 8;
            *(v4u*)(op + rr * 256 + cc) = *(const LAS v4u*)(OS + rr * 264 + cc); }
        LDS_WAIT(); asm volatile("" ::: "memory");
    }
    if (mixer == 0 && tid < 256) {
        float s = 0.f;
#pragma unroll 8
        for (int t = 0; t < 128; ++t) s += __uint_as_float((unsigned)KS[t * TL + tid] << 16);
        ((float*)(ws + WS_NST))[(size_t)(head * NPAIR + pair) * 256 + tid] = s;
    }
}

__device__ __forceinline__ void scan_phase(unsigned char* ws, int T0, int TS, bf16* dummy_out = nullptr) {
    const float* G = (const float*)(ws + WS_GG); const float* mls = (const float*)(ws + WS_MLS); float* mlsw = (float*)(ws + WS_MLS);
#pragma unroll 1
    for (int T = T0; T < 131072; T += TS) {
        const int mixer = T >> 16, head = (T >> 14) & 3, v = (T >> 5) & 511, d0 = (T & 31) * 8;
        bf16* base = (bf16*)(ws + WS_STATE) + ((size_t)((mixer * 4 + head) * NPAIR)) * (512 * 256) + (size_t)v * 256 + d0;
        float C[8]; float mrun = 0.f;
#pragma unroll
        for (int e = 0; e < 8; ++e) C[e] = 0.f;
#pragma unroll 1
        for (int p0 = 0; p0 < NPAIR; p0 += 8) {
            v4u x[8]; float dec[8][8]; float cor[8] = {1.f, 1.f, 1.f, 1.f, 1.f, 1.f, 1.f, 1.f};
#pragma unroll
            for (int i = 0; i < 8; ++i) x[i] = *(const v4u*)(base + (size_t)(p0 + i) * (512 * 256));
#pragma unroll
            for (int i = 0; i < 8; ++i) { const int cA = 2 * (p0 + i);
                if (mixer == 0) { const float blA = mls[MLS_CHB + head * NCH + cA], blB = mls[MLS_CHB + head * NCH + cA + 1];
                    const float pmP = fmaxf(mls[MLS_CHP + head * NCH + cA], mls[MLS_CHP + head * NCH + cA + 1] - blA), m63 = fmaxf(pmP, mrun);
                    const float dd = fexpf(mrun - m63); cor[i] = fexpf(pmP - m63);
                    if (v == 0 && d0 == 0 && !dummy_out) mlsw[MLS_MC + head * NCH + p0 + i] = mrun;
                    mrun = (blA + blB) + m63;
#pragma unroll
                    for (int e = 0; e < 8; ++e) dec[i][e] = dd; }
                else { const float* ga = G + (size_t)(cA * 64 + 63) * 1024 + head * 256 + d0; const float* gb = ga + (size_t)64 * 1024;
                    const f32x4 a0 = *(const f32x4*)ga, a1 = *(const f32x4*)(ga + 4), b0 = *(const f32x4*)gb, b1 = *(const f32x4*)(gb + 4);
                    dec[i][0] = fexpf(a0.x + b0.x); dec[i][1] = fexpf(a0.y + b0.y); dec[i][2] = fexpf(a0.z + b0.z); dec[i][3] = fexpf(a0.w + b0.w);
                    dec[i][4] = fexpf(a1.x + b1.x); dec[i][5] = fexpf(a1.y + b1.y); dec[i][6] = fexpf(a1.z + b1.z); dec[i][7] = fexpf(a1.w + b1.w); }
            }
#pragma unroll
            for (int i = 0; i < 8; ++i) {
                v4u o; o.x = pk2(C[0], C[1]); o.y = pk2(C[2], C[3]); o.z = pk2(C[4], C[5]); o.w = pk2(C[6], C[7]);
                *(v4u*)((dummy_out ? dummy_out + (base - (bf16*)(ws + WS_STATE)) : base) + (size_t)(p0 + i) * (512 * 256)) = o;
                C[0] = dec[i][0] * C[0] + cor[i] * bflo(x[i].x); C[1] = dec[i][1] * C[1] + cor[i] * bfhi(x[i].x); C[2] = dec[i][2] * C[2] + cor[i] * bflo(x[i].y); C[3] = dec[i][3] * C[3] + cor[i] * bfhi(x[i].y);
                C[4] = dec[i][4] * C[4] + cor[i] * bflo(x[i].z); C[5] = dec[i][5] * C[5] + cor[i] * bfhi(x[i].z); C[6] = dec[i][6] * C[6] + cor[i] * bflo(x[i].w); C[7] = dec[i][7] * C[7] + cor[i] * bfhi(x[i].w);
            }
        }
    }
    if (!dummy_out) for (int T = T0; T < 1024; T += TS) {
        const int head = T >> 8, d = T & 255; float* np = (float*)(ws + WS_NST) + (size_t)head * NPAIR * 256 + d; float n = 0.f, mrun = 0.f;
#pragma unroll 1
        for (int p = 0; p < NPAIR; ++p) { const float x = np[p * 256]; np[p * 256] = n;
            const float blA = mls[MLS_CHB + head * NCH + 2 * p], blB = mls[MLS_CHB + head * NCH + 2 * p + 1];
            const float pmP = fmaxf(mls[MLS_CHP + head * NCH + 2 * p], mls[MLS_CHP + head * NCH + 2 * p + 1] - blA), m63 = fmaxf(pmP, mrun);
            n = fexpf(mrun - m63) * n + fexpf(pmP - m63) * x; mrun = (blA + blB) + m63; }
    }
}

constexpr int PLP = 136;
constexpr int HTP = 516;
__device__ __forceinline__ int mixout_chunk(int u) { int c = (u >> 2) & 127; c = (c & ~3) | ((c & 1) << 1) | ((c >> 1) & 1); return c ^ (c >> 6); }
template <bool ODD>
__device__ __forceinline__ void mixout_unit(const Args& args, unsigned char* ws, LAS unsigned char* lds, int u, int tid, int wave, int lane) {
    asm volatile("" : "+v"(lane), "+v"(tid));
    constexpr int NK = ODD ? 128 : 64, KOFF = ODD ? 64 : 0, NST2 = NK / 32;
    const int mixer = u >> 9, chunk = mixout_chunk(u), head = u & 3, pair = chunk >> 1;
    const bf16* PROJ = (const bf16*)(ws + WS_PROJ); const bf16* VT = (const bf16*)(ws + WS_VT);
    const float* G = (const float*)(ws + WS_GG); const float* mls = (const float*)(ws + WS_MLS);
    LAS bf16* KS = (LAS bf16*)lds; LAS bf16* QS = (LAS bf16*)(lds + 67584); LAS bf16* PS = (LAS bf16*)(lds + 101376);
    LAS float* HT = (LAS float*)lds;
    LAS float* RDEN = (LAS float*)(lds + 132096); LAS float* SSQ = (LAS float*)(lds + 132352); LAS float* NPREV = (LAS float*)(lds + 134400); LAS float* RSTD = (LAS float*)(lds + 135424);
    const int qcol = (mixer ? 4096 : 0) + head * 256, kcol = (mixer ? 5120 : 1024) + head * 256;
    const int fr = lane & 15, fq = lane >> 4;
    const int tok0 = chunk * 64, tokK0 = tok0 - KOFF;
    float mc = 0.f, minter = 0.f, blA = 0.f;
    if (mixer == 0) { const float mp = mls[MLS_MC + head * NCH + pair];
        if (ODD) { blA = mls[MLS_CHB + head * NCH + chunk - 1]; mc = blA + fmaxf(mls[MLS_CHP + head * NCH + chunk - 1], mp); minter = blA + mp; } else { mc = mp; minter = mp; } }
    __syncthreads();
#pragma unroll
    for (int i = 0; i < 4; ++i) {
        const int q = tid + 512 * i, s = q >> 5, d0 = (q & 31) * 8;
        const v4u kw = *(const v4u*)(PROJ + (size_t)(tok0 + s) * 8192 + kcol + d0);
        const v4u qw = *(const v4u*)(PROJ + (size_t)(tok0 + s) * 8192 + qcol + d0);
        float sk[8], sq[8];
        if (mixer == 0) {
#pragma unroll
            for (int e = 0; e < 8; ++e) { sk[e] = 0.0625f; sq[e] = 1.f; } }
        else { const float* gs = G + (size_t)(tok0 + s) * 1024 + head * 256 + d0; const f32x4 b0 = *(const f32x4*)gs, b1 = *(const f32x4*)(gs + 4);
            const float gg[8] = {b0.x, b0.y, b0.z, b0.w, b1.x, b1.y, b1.z, b1.w};
#pragma unroll
            for (int e = 0; e < 8; ++e) { sq[e] = fexpf(gg[e]) * 0.0625f; sk[e] = fexpf(-gg[e]); } }
        v4u o; o.x = pk2(bflo(kw.x) * sk[0], bfhi(kw.x) * sk[1]); o.y = pk2(bflo(kw.y) * sk[2], bfhi(kw.y) * sk[3]);
        o.z = pk2(bflo(kw.z) * sk[4], bfhi(kw.z) * sk[5]); o.w = pk2(bflo(kw.w) * sk[6], bfhi(kw.w) * sk[7]);
        *(LAS v4u*)(KS + (KOFF + s) * TL + d0) = o;
        v4u p; p.x = pk2(bflo(qw.x) * sq[0], bfhi(qw.x) * sq[1]); p.y = pk2(bflo(qw.y) * sq[2], bfhi(qw.y) * sq[3]);
        p.z = pk2(bflo(qw.z) * sq[4], bfhi(qw.z) * sq[5]); p.w = pk2(bflo(qw.w) * sq[6], bfhi(qw.w) * sq[7]);
        *(LAS v4u*)(QS + s * TL + d0) = p;
        if (ODD) {
            const v4u cw = *(const v4u*)(PROJ + (size_t)(tokK0 + s) * 8192 + kcol + d0);
            float sc[8];
            if (mixer == 0) {
#pragma unroll
                for (int e = 0; e < 8; ++e) sc[e] = 0.0625f; }
            else { const float* gl = G + (size_t)(tokK0 + 63) * 1024 + head * 256 + d0; const float* gs2 = G + (size_t)(tokK0 + s) * 1024 + head * 256 + d0;
                const f32x4 a0 = *(const f32x4*)gl, a1 = *(const f32x4*)(gl + 4), b0 = *(const f32x4*)gs2, b1 = *(const f32x4*)(gs2 + 4);
                sc[0] = fexpf(a0.x - b0.x); sc[1] = fexpf(a0.y - b0.y); sc[2] = fexpf(a0.z - b0.z); sc[3] = fexpf(a0.w - b0.w);
                sc[4] = fexpf(a1.x - b1.x); sc[5] = fexpf(a1.y - b1.y); sc[6] = fexpf(a1.z - b1.z); sc[7] = fexpf(a1.w - b1.w); }
            v4u c4; c4.x = pk2(bflo(cw.x) * sc[0], bfhi(cw.x) * sc[1]); c4.y = pk2(bflo(cw.y) * sc[2], bfhi(cw.y) * sc[3]);
            c4.z = pk2(bflo(cw.z) * sc[4], bfhi(cw.z) * sc[5]); c4.w = pk2(bflo(cw.w) * sc[6], bfhi(cw.w) * sc[7]);
            *(LAS v4u*)(KS + s * TL + d0) = c4;
        }
    }
    if (mixer == 0 && tid < 256) NPREV[tid] = ((const float*)(ws + WS_NST))[(size_t)(head * NPAIR + pair) * 256 + tid];
    __syncthreads();
    {
        const int tt = wave >> 1;
        const bool cross = ODD && ((wave & 1) == 0);
#pragma unroll
        for (int h2 = 0; h2 < NST2; ++h2) {
            const int st = NST2 * (wave & 1) + h2;
            f32x4 acc = {0.f, 0.f, 0.f, 0.f};
#pragma unroll
            for (int ks = 0; ks < 8; ++ks) {
                const bf16x8 a = *(const LAS bf16x8*)(KS + (16 * st + fr) * TL + 32 * ks + 8 * fq);
                const bf16x8 b = *(const LAS bf16x8*)(QS + (16 * tt + fr) * TL + 32 * ks + 8 * fq);
                acc = mma(a, b, acc);
            }
            const int t = 16 * tt + fr, r0 = 16 * st + 4 * fq;
            float f[4] = {1.f, 1.f, 1.f, 1.f};
            if (mixer == 0) { const float Mt = fmaxf(mls[MLS_PM + head * SEQ + tok0 + t], mc); const f32x4 av = *(const f32x4*)(mls + MLS_A + head * SEQ + tokK0 + r0);
                const float off = cross ? blA - Mt : -Mt;
                f[0] = fexpf(av.x + off); f[1] = fexpf(av.y + off); f[2] = fexpf(av.z + off); f[3] = fexpf(av.w + off); }
            float pv[4];
#pragma unroll
            for (int r = 0; r < 4; ++r) pv[r] = (cross || (r0 - KOFF + r <= t)) ? acc[r] * f[r] : 0.f;
            v2u w; w.x = pk2(pv[0], pv[1]); w.y = pk2(pv[2], pv[3]);
            *(LAS v2u*)(PS + t * PLP + r0) = w;
        }
    }
    __syncthreads();
    if (wave == 0) {
        float rd = 1.f;
        if (mixer == 0) {
            const int t = lane; float di = 0.f, qn = 0.f;
#pragma unroll 8
            for (int s = 0; s < NK; ++s) di += __uint_as_float((unsigned)PS[t * PLP + s] << 16);
#pragma unroll 8
            for (int d = 0; d < 256; ++d) qn += __uint_as_float((unsigned)QS[t * TL + d] << 16) * NPREV[d];
            const float Mt = fmaxf(mls[MLS_PM + head * SEQ + tok0 + t], mc);
            const float den = di + fexpf(minter - Mt) * qn;
            rd = 1.f / fmaxf(fabsf(den), fexpf(-(mls[MLS_BC + head * SEQ + tok0 + t] + Mt)));
        }
        RDEN[lane] = rd;
    }
    f32x4 acc[4][4];
#pragma unroll
    for (int a = 0; a < 4; ++a)
#pragma unroll
        for (int b = 0; b < 4; ++b) acc[a][b] = (f32x4){0.f, 0.f, 0.f, 0.f};
    const bf16* ST = (const bf16*)(ws + WS_STATE) + ((size_t)((mixer * 4 + head) * NPAIR + pair)) * (512 * 256);
#pragma unroll
    for (int vt = 0; vt < 4; ++vt) {
        bf16x8 af[8];
        const bf16* sp = (ST + (size_t)(wave * 64 + 16 * vt) * 256) + (fr * 256 + 8 * fq);
#pragma unroll
        for (int ks = 0; ks < 8; ++ks) af[ks] = *(const bf16x8*)(sp + 32 * ks);
        if (ODD && mixer == 1) {
            const float* gl = G + (size_t)(tokK0 + 63) * 1024 + head * 256 + 8 * fq;
#pragma unroll
            for (int ks = 0; ks < 8; ++ks) { const f32x4 e0 = *(const f32x4*)(gl + 32 * ks), e1 = *(const f32x4*)(gl + 32 * ks + 4);
                const v4u w = __builtin_bit_cast(v4u, af[ks]);
                v4u o; o.x = pk2(bflo(w.x) * fexpf(e0.x), bfhi(w.x) * fexpf(e0.y)); o.y = pk2(bflo(w.y) * fexpf(e0.z), bfhi(w.y) * fexpf(e0.w));
                o.z = pk2(bflo(w.z) * fexpf(e1.x), bfhi(w.z) * fexpf(e1.y)); o.w = pk2(bflo(w.w) * fexpf(e1.z), bfhi(w.w) * fexpf(e1.w));
                af[ks] = u4_as_frag(o); }
        }
#pragma unroll
        for (int tt = 0; tt < 4; ++tt)
#pragma unroll
            for (int ks = 0; ks < 8; ++ks) {
                const bf16x8 b = *(const LAS bf16x8*)(QS + (16 * tt + fr) * TL + 32 * ks + 8 * fq);
                acc[vt][tt] = mma(af[ks], b, acc[vt][tt]);
            }
    }
    if (mixer == 0) {
#pragma unroll
        for (int tt = 0; tt < 4; ++tt) { const float it = fexpf(minter - fmaxf(mls[MLS_PM + head * SEQ + tok0 + 16 * tt + fr], mc));
#pragma unroll
            for (int vt = 0; vt < 4; ++vt) acc[vt][tt] = acc[vt][tt] * it; }
    }
    const int vrow0 = mixer * 2048 + head * 512 + wave * 64;
#pragma unroll
    for (int vt = 0; vt < 4; ++vt) {
        const bf16* vp = (VT + (size_t)(vrow0 + 16 * vt) * 8192 + tokK0) + (fr * 8192 + 8 * fq);
        bf16x8 a[NK / 32];
#pragma unroll
        for (int ks = 0; ks < NK / 32; ++ks) a[ks] = *(const bf16x8*)(vp + 32 * ks);
#pragma unroll
        for (int tt = 0; tt < 4; ++tt)
#pragma unroll
            for (int ks = 0; ks < NK / 32; ++ks)
                acc[vt][tt] = mma(a[ks], *(const LAS bf16x8*)(PS + (16 * tt + fr) * PLP + 32 * ks + 8 * fq), acc[vt][tt]);
    }
    __syncthreads();
#pragma unroll
    for (int tt = 0; tt < 4; ++tt) {
        const float rd = RDEN[16 * tt + fr]; float q = 0.f;
#pragma unroll
        for (int vt = 0; vt < 4; ++vt) { acc[vt][tt] = acc[vt][tt] * rd; q += acc[vt][tt][0] * acc[vt][tt][0] + acc[vt][tt][1] * acc[vt][tt][1] + acc[vt][tt][2] * acc[vt][tt][2] + acc[vt][tt][3] * acc[vt][tt][3];
            *(LAS f32x4*)(HT + (16 * tt + fr) * HTP + wave * 64 + 16 * vt + 4 * fq) = acc[vt][tt]; }
        q += __shfl_xor(q, 16); q += __shfl_xor(q, 32);
        if (fq == 0) SSQ[wave * 64 + 16 * tt + fr] = q;
    }
    __syncthreads();
    if (tid < 64) { float tot = 0.f;
#pragma unroll
        for (int w = 0; w < 8; ++w) tot += SSQ[w * 64 + tid];
        RSTD[tid] = rsqrtf(tot * (1.f / 512.f) + EPS); }
    __syncthreads();
    const float* hn = args.in[mixer ? 10 : 7] + head * 512;
    const bf16* gp = PROJ + (size_t)tok0 * 8192 + (mixer ? 6144 : 2048) + head * 512;
    bf16* hc = (bf16*)(ws + WS_HC) + (size_t)tok0 * DM + mixer * 2048 + head * 512;
#pragma unroll
    for (int i = 0; i < 8; ++i) {
        const int it = tid + NTHREADS * i, t = it >> 6, v0 = (it & 63) * 8;
        const f32x4 h0 = *(const LAS f32x4*)(HT + t * HTP + v0), h1 = *(const LAS f32x4*)(HT + t * HTP + v0 + 4);
        const f32x4 n0 = *(const f32x4*)(hn + v0), n1 = *(const f32x4*)(hn + v0 + 4);
        const v4u gw4 = *(const v4u*)(gp + (size_t)t * 8192 + v0);
        const float rstd = RSTD[t];
        float gt[8] = {bflo(gw4.x), bfhi(gw4.x), bflo(gw4.y), bfhi(gw4.y), bflo(gw4.z), bfhi(gw4.z), bflo(gw4.w), bfhi(gw4.w)};
#pragma unroll
        for (int r = 0; r < 8; ++r) { const float sg = sigmoid_fast(gt[r]); gt[r] = mixer ? gt[r] * sg : sg; }
        v4u w; w.x = pk2(h0[0] * rstd * n0[0] * gt[0], h0[1] * rstd * n0[1] * gt[1]); w.y = pk2(h0[2] * rstd * n0[2] * gt[2], h0[3] * rstd * n0[3] * gt[3]);
        w.z = pk2(h1[0] * rstd * n1[0] * gt[4], h1[1] * rstd * n1[1] * gt[5]); w.w = pk2(h1[2] * rstd * n1[2] * gt[6], h1[3] * rstd * n1[3] * gt[7]);
        *(v4u*)(hc + (size_t)t * DM + v0) = w;
    }
}

constexpr int SBK_P = 136, SBV_P = 72;
constexpr int SB_KS = 0, SB_VS = 17408, SB_BUF = 35840, SB_FLAGS = 8 * 16640;
__device__ __forceinline__ void stickbreak_phase(const Args& args, unsigned char* ws, LAS unsigned char* lds, int bx, int G, int tid, int wave, int lane) {
    const bf16* QK = (const bf16*)(ws + WS_PROJ); const bf16* VT = (const bf16*)(ws + WS_VT); bf16* HC = (bf16*)(ws + WS_HC);
    const float scale = 0.08838834764831845f * 1.4426950408889634f;
    volatile LAS int* FLAGS = (volatile LAS int*)(lds + SB_FLAGS);
    int iu = 0;
#pragma unroll 1
    for (int U = bx; U < 2048; U += G, ++iu) {
        asm volatile("" : "+v"(lane), "+v"(tid));
        const int fr = lane & 15, fq = lane >> 4;
        const bool rider = RIDER_ON && (G == 256) && (iu < 4);
        f32x4 rv[16]; Seg rsg; int rkb = 0, rnb = 0;
        if (rider) { const int gi = iu * 2048 + bx * NWAVES + wave; const int sI = gi < 4096 ? SEG_SB : SEG_SB + 1 + ((gi - 4096) >> 10); const int it = gi < 4096 ? gi : ((gi - 4096) & 1023);
            rsg = seg_at(sI); const int nblk = rsg.ncols / 64; rkb = it / nblk; rnb = it - rkb * nblk;
            tr_load(args.in[rsg.in_idx] + (size_t)rsg.src_l * rsg.K * rsg.N + (size_t)(64 * rkb) * rsg.N + rsg.scol + 64 * rnb, rsg.N, rv, lane); }
        const int kr0 = tid >> 4, kc0 = (tid & 15) * 8;
        const int vr0 = tid >> 3, vc0 = (tid & 7) * 8;
        const int head = U & 31, Q0 = (U >> 5) * 128, q0 = Q0 + 16 * wave, t = q0 + fr;
        bf16x8 qf[4];
#pragma unroll
        for (int ks = 0; ks < 4; ++ks) qf[ks] = *(const bf16x8*)(QK + (size_t)(q0 + fr) * 8192 + head * 128 + 32 * ks + 8 * fq);
        f32x4 o[8];
#pragma unroll
        for (int dt = 0; dt < 8; ++dt) o[dt] = (f32x4){0.f, 0.f, 0.f, 0.f};
        float carry = 0.f; bool done = false;
        const bf16* kg = QK + 4096 + head * 128 + kc0; const bf16* vg = VT + (size_t)(head * 128) * 8192 + vc0;
        const int KB0 = Q0 + 64;
        v4u kreg[2], vreg[2];
        kreg[0] = *(const v4u*)(kg + (size_t)(KB0 + kr0) * 8192); kreg[1] = *(const v4u*)(kg + (size_t)(KB0 + kr0 + 32) * 8192);
        vreg[0] = *(const v4u*)(vg + (size_t)vr0 * 8192 + KB0); vreg[1] = *(const v4u*)(vg + (size_t)(vr0 + 64) * 8192 + KB0);
        __syncthreads();
        { LAS bf16* KS = (LAS bf16*)(lds + SB_KS); LAS bf16* VS = (LAS bf16*)(lds + SB_VS);
          *(LAS v4u*)(KS + kr0 * SBK_P + kc0) = kreg[0]; *(LAS v4u*)(KS + (kr0 + 32) * SBK_P + kc0) = kreg[1];
          *(LAS v4u*)(VS + vr0 * SBV_P + vc0) = vreg[0]; *(LAS v4u*)(VS + (vr0 + 64) * SBV_P + vc0) = vreg[1]; }
        __syncthreads();
#pragma unroll 1
        for (int j = 0;; ++j) {
            const int kb = KB0 - 64 * j; const bool has_next = kb >= 64;
            if (has_next) { const int kn = kb - 64;
                kreg[0] = *(const v4u*)(kg + (size_t)(kn + kr0) * 8192); kreg[1] = *(const v4u*)(kg + (size_t)(kn + kr0 + 32) * 8192);
                vreg[0] = *(const v4u*)(vg + (size_t)vr0 * 8192 + kn); vreg[1] = *(const v4u*)(vg + (size_t)(vr0 + 64) * 8192 + kn); }
            const LAS bf16* KS = (const LAS bf16*)(lds + (j & 1) * SB_BUF + SB_KS); const LAS bf16* VS = (const LAS bf16*)(lds + (j & 1) * SB_BUF + SB_VS);
            if (!done && kb <= q0 + 15) {
                f32x4 sa[4];
#pragma unroll
                for (int i = 0; i < 4; ++i) { sa[i] = (f32x4){0.f, 0.f, 0.f, 0.f};
#pragma unroll
                    for (int ks = 0; ks < 4; ++ks) sa[i] = mma(*(const LAS bf16x8*)(KS + (16 * i + fr) * SBK_P + 32 * ks + 8 * fq), qf[ks], sa[i]); }
                float l1[4][4], lb[4][4], Tl[4];
                if (kb + 63 >= q0) {
#pragma unroll
                    for (int i = 0; i < 4; ++i) {
#pragma unroll
                        for (int r = 0; r < 4; ++r) { const float z = sa[i][r] * scale; const float sp = fmaxf(z, 0.f) + flog2(1.f + fexp2(-fabsf(z)));
                            const bool valid = (kb + 16 * i + 4 * fq + r) < t; l1[i][r] = valid ? -sp : 0.f; lb[i][r] = valid ? (z - sp) : -1e30f; }
                        Tl[i] = (l1[i][0] + l1[i][1]) + (l1[i][2] + l1[i][3]);
                    }
                } else {
#pragma unroll
                    for (int i = 0; i < 4; ++i) {
#pragma unroll
                        for (int r = 0; r < 4; ++r) { const float z = sa[i][r] * scale; const float sp = fmaxf(z, 0.f) + flog2(1.f + fexp2(-fabsf(z)));
                            l1[i][r] = -sp; lb[i][r] = z - sp; }
                        Tl[i] = (l1[i][0] + l1[i][1]) + (l1[i][2] + l1[i][3]);
                    }
                }
                float run = carry; float att[4][4];
#pragma unroll
                for (int i = 3; i >= 0; --i) {
                    const float T = Tl[i];
                    const float pb = xor16f(T, fq), pc = xor32f(T, fq), pd = xor32f(pb, fq);
                    const float sg = fq == 0 ? (pb + pc) + pd : (fq == 1 ? pc + pd : (fq == 2 ? pb : 0.f));
                    const float tot = (T + pb) + (pc + pd);
                    const float e3 = run + sg, e2 = e3 + l1[i][3], e1 = e2 + l1[i][2], e0 = e1 + l1[i][1];
                    att[i][0] = fexp2(lb[i][0] + e0); att[i][1] = fexp2(lb[i][1] + e1); att[i][2] = fexp2(lb[i][2] + e2); att[i][3] = fexp2(lb[i][3] + e3);
                    run += tot;
                }
                carry = run;
                bf16x8 pf[2];
#pragma unroll
                for (int s2 = 0; s2 < 2; ++s2) { v4u w; w.x = pk2(att[2 * s2][0], att[2 * s2][1]); w.y = pk2(att[2 * s2][2], att[2 * s2][3]);
                    w.z = pk2(att[2 * s2 + 1][0], att[2 * s2 + 1][1]); w.w = pk2(att[2 * s2 + 1][2], att[2 * s2 + 1][3]); pf[s2] = u4_as_frag(w); }
#pragma unroll
                for (int dt = 0; dt < 8; ++dt) {
                    const LAS bf16* vp = VS + (16 * dt + fr) * SBV_P + 4 * fq;
#pragma unroll
                    for (int s2 = 0; s2 < 2; ++s2) { const s16x4 lo = *(const LAS s16x4*)(vp + 32 * s2), hi = *(const LAS s16x4*)(vp + 32 * s2 + 16);
                        o[dt] = mma(cat8(lo, hi), pf[s2], o[dt]); }
                }
                if (__all(carry < -127.f)) done = true;
            }
            if (lane == 0) FLAGS[(j & 1) * 8 + wave] = done ? 1 : 0;
            if (has_next) { LAS bf16* KN = (LAS bf16*)(lds + ((j + 1) & 1) * SB_BUF + SB_KS); LAS bf16* VN = (LAS bf16*)(lds + ((j + 1) & 1) * SB_BUF + SB_VS);
                *(LAS v4u*)(KN + kr0 * SBK_P + kc0) = kreg[0]; *(LAS v4u*)(KN + (kr0 + 32) * SBK_P + kc0) = kreg[1];
                *(LAS v4u*)(VN + vr0 * SBV_P + vc0) = vreg[0]; *(LAS v4u*)(VN + (vr0 + 64) * SBV_P + vc0) = vreg[1]; }
            __syncthreads();
            int nd = 0;
#pragma unroll
            for (int w8 = 0; w8 < 8; ++w8) nd += FLAGS[(j & 1) * 8 + w8];
            if (!has_next || nd == 8) break;
        }
        { LAS bf16* OT = (LAS bf16*)(lds + wave * 16640);
#pragma unroll
          for (int dt = 0; dt < 8; ++dt) { v2u w; w.x = pk2(o[dt][0], o[dt][1]); w.y = pk2(o[dt][2], o[dt][3]);
              *(LAS v2u*)(OT + fr * SBK_P + 16 * dt + 4 * fq) = w; }
          LDS_WAIT(); asm volatile("" ::: "memory");
          bf16* hrow = HC + (size_t)q0 * DM + head * 128;
#pragma unroll
          for (int i = 0; i < 4; ++i) { const int rr = 4 * i + fq, cc = fr * 8;
              *(v4u*)(hrow + (size_t)rr * DM + cc) = *(const LAS v4u*)(OT + rr * SBK_P + cc); }
          LDS_WAIT(); asm volatile("" ::: "memory"); }
        if (rider) { LAS float* scr = (LAS float*)(lds + wave * 16640);
            tr_to_lds(rv, scr, lane);
            bf16* WT = (bf16*)(ws + WS_W + (size_t)rsg.layer * LAYER_W + (size_t)rsg.wsub_mib * MiB);
            tr_store(WT + (size_t)(rsg.drow + 64 * rnb) * rsg.K + 64 * rkb, rsg.K, scr, lane); }
    }
}

constexpr int XA_P = 264, XA_BUF = 64 * XA_P * 2;
__device__ __forceinline__ void xattn_phase(unsigned char* ws, LAS unsigned char* lds, int bx, int G, int tid, int wave, int lane) {
    const bf16* XQ = (const bf16*)(ws + WS_XQ); const bf16* KM = (const bf16*)(ws + WS_KMEM); const bf16* VTM = (const bf16*)(ws + WS_VTMEM); bf16* XO = (bf16*)(ws + WS_XO);
#pragma unroll 1
    for (int U = bx; U < 256; U += G) {
        asm volatile("" : "+v"(lane), "+v"(tid));
        const int fr = lane & 15, fq = lane >> 4;
        const int pr0 = tid >> 5, pc0 = (tid & 31) * 8;
        const int head = U & 3, q0 = (U >> 2) * 128 + 16 * wave;
        bf16x8 qf[8];
#pragma unroll
        for (int ks = 0; ks < 8; ++ks) qf[ks] = *(const bf16x8*)(XQ + (size_t)(q0 + fr) * XAW + head * 256 + 32 * ks + 8 * fq);
        f32x4 s[16]; bf16x8 pf[8]; float rs = 0.f;
        v4u preg[4];
        LAS bf16* OT = (LAS bf16*)(lds + 2 * XA_BUF + wave * 2304);
#define XA_LOAD(p) do { _Pragma("unroll") for (int i_ = 0; i_ < 4; ++i_) { const int r_ = pr0 + 16 * i_; \
            preg[i_] = ((p) < 4) ? *(const v4u*)(KM + (size_t)(64 * (p) + r_) * XAW + head * 256 + pc0) : *(const v4u*)(VTM + (size_t)(head * 256 + 64 * ((p) - 4) + r_) * NMEM + pc0); } } while (0)
#define XA_STORE(p) do { LAS bf16* B_ = (LAS bf16*)(lds + ((p) & 1) * XA_BUF); _Pragma("unroll") for (int i_ = 0; i_ < 4; ++i_) *(LAS v4u*)(B_ + (pr0 + 16 * i_) * XA_P + pc0) = preg[i_]; } while (0)
        XA_LOAD(0);
        __syncthreads();
        XA_STORE(0);
        __syncthreads();
#pragma unroll
        for (int p = 0; p < 8; ++p) {
            if (p < 7) XA_LOAD(p + 1);
            const LAS bf16* B = (const LAS bf16*)(lds + (p & 1) * XA_BUF);
            if (p < 4) {
#pragma unroll
                for (int i = 0; i < 4; ++i) { f32x4 a = {0.f, 0.f, 0.f, 0.f};
#pragma unroll
                    for (int ks = 0; ks < 8; ++ks) a = mma(*(const LAS bf16x8*)(B + (16 * i + fr) * XA_P + 32 * ks + 8 * fq), qf[ks], a);
                    s[4 * p + i] = a; }
                if (p == 3) {
                    float mx = -1e30f;
#pragma unroll
                    for (int i = 0; i < 16; ++i) { s[i] = s[i] * 0.0625f; mx = fmaxf(mx, fmaxf(fmaxf(s[i][0], s[i][1]), fmaxf(s[i][2], s[i][3]))); }
                    mx = fmaxf(mx, __shfl_xor(mx, 16)); mx = fmaxf(mx, __shfl_xor(mx, 32));
                    float sum = 0.f;
#pragma unroll
                    for (int i = 0; i < 16; ++i) { s[i][0] = fexpf(s[i][0] - mx); s[i][1] = fexpf(s[i][1] - mx); s[i][2] = fexpf(s[i][2] - mx); s[i][3] = fexpf(s[i][3] - mx);
                        sum += (s[i][0] + s[i][1]) + (s[i][2] + s[i][3]); }
                    sum += __shfl_xor(sum, 16); sum += __shfl_xor(sum, 32);
                    rs = 1.f / sum;
#pragma unroll
                    for (int s2 = 0; s2 < 8; ++s2) { v4u w; w.x = pk2(s[2 * s2][0], s[2 * s2][1]); w.y = pk2(s[2 * s2][2], s[2 * s2][3]);
                        w.z = pk2(s[2 * s2 + 1][0], s[2 * s2 + 1][1]); w.w = pk2(s[2 * s2 + 1][2], s[2 * s2 + 1][3]); pf[s2] = u4_as_frag(w); }
                }
            } else {
#pragma unroll
                for (int i = 0; i < 4; ++i) {
                    const LAS bf16* vp = B + (16 * i + fr) * XA_P + 4 * fq;
                    f32x4 o = {0.f, 0.f, 0.f, 0.f};
#pragma unroll
                    for (int s2 = 0; s2 < 8; ++s2) { const s16x4 lo = *(const LAS s16x4*)(vp + 32 * s2), hi = *(const LAS s16x4*)(vp + 32 * s2 + 16); o = mma(cat8(lo, hi), pf[s2], o); }
                    v2u w; w.x = pk2(o[0] * rs, o[1] * rs); w.y = pk2(o[2] * rs, o[3] * rs);
                    *(LAS v2u*)(OT + fr * 72 + 16 * i + 4 * fq) = w;
                }
                LDS_WAIT(); asm volatile("" ::: "memory");
                { bf16* xrow = XO + (size_t)q0 * XAW + head * 256 + 64 * (p - 4);
#pragma unroll
                  for (int i = 0; i < 2; ++i) { const int rr = 8 * i + (lane >> 3), cc = (lane & 7) * 8;
                      *(v4u*)(xrow + (size_t)rr * XAW + cc) = *(const LAS v4u*)(OT + rr * 72 + cc); } }
                LDS_WAIT(); asm volatile("" ::: "memory");
            }
            if (p < 7) XA_STORE(p + 1);
            __syncthreads();
        }
#undef XA_LOAD
#undef XA_STORE
    }
}

__device__ __forceinline__ void conv_fixup(const float* cw, const float* cb, unsigned char* ws, int T0, int TS) {
    const float* halo = (const float*)(ws + WS_HALO); bf16* H = (bf16*)(ws + WS_H);
#pragma unroll 1
    for (int T = T0; T < 64 * FF; T += TS) {
        const int pr = T / FF, f = T - pr * FF, pm = pr >> 1, rr = pr & 1;
        const float* hp = halo + (size_t)pm * 6 * FF + f;
        float p2 = 0.f, p3 = 0.f;
        if (pm > 0) { const float* hq = halo + (size_t)(pm - 1) * 6 * FF + f; p2 = hq[2 * FF]; p3 = hq[3 * FF]; }
        const float g0 = hp[rr * FF];
        float g1 = rr ? hp[0] : p3, g2 = rr ? p3 : p2;
        g1 = __uint_as_float(f2bf(g1) << 16); g2 = __uint_as_float(f2bf(g2) << 16);
        const float x = cb[f] + cw[f] * g2 + cw[FF + f] * g1 + cw[2 * FF + f] * g0;
        const float y = -2.3022081983651455f * (x + 0.044715f * x * x * x);
        H[(size_t)(256 * pm + rr) * FF + f] = (bf16)f2bf(x * frcp(1.f + fexp2(y)) * hp[(4 + rr) * FF]);
    }
}

#ifndef EN_MASK
#define EN_MASK 0xffffffffu
#endif
#define EN(k) ((EN_MASK >> (k)) & 1u)
#define STEP_ON (lo <= step && step < hi)
#define OPQ int olane; asm volatile("v_mbcnt_lo_u32_b32 %0, -1, 0\n\tv_mbcnt_hi_u32_b32 %0, -1, %0" : "=v"(olane)); const int otid = wave * 64 + olane
#define STEP_END do { if (MK_SINGLE && step + 1 < hi) xcd_barrier(bar); ++step; } while (0)
typedef pg8::bf16_t pb;
#define glds lds
#define xres (args.out)
#define XN ((bf16*)(ws + WS_XN))
#define HB ((bf16*)(ws + WS_HB))
#define RS ((float*)(ws + WS_RS))
#define HC ((bf16*)(ws + WS_HC))
#define wl (ws + WS_W + (size_t)layer * LAYER_W)
#define SITE size_t wz_ = 0; asm volatile("" : "+s"(wz_)); unsigned char* ws = args.ws + wz_

template <int LAYER>
__device__ __forceinline__ void layer_steps(const Args& args, LAS unsigned char* lds, const XcdBarrier& bar, const int lo, const int hi, int& step,
                                            const int G, const int bx, const int vcu, const int gw, const int NGW, const int wave) {
    constexpr int layer = LAYER;

        if (EN(1) && STEP_ON) { SITE;
            { pg8::Gemm g{(const pb*)XN, (const pb*)(wl + WO_MAIN), SEQ, 8192, DM, DM, DM}; pg8::StaticOrder S; S.init(g.M, g.N, G, bx);
              pg8::EpiStore E{(pb*)(ws + WS_PROJ), 8192, nullptr, -1};
              pg8::gemm_phase<pg8::EpiStore, pg8::StaticOrder, true, true>(glds, g, S, E, wave); }
            { pg8::Gemm g{(const pb*)(wl + WO_V), (const pb*)XN, DM, SEQ, DM, DM, DM}; pg8::StaticOrder S; S.init(g.M, g.N, G, bx);
              pg8::EpiStore E{(pb*)(ws + WS_VT), 8192, nullptr, -1};
              pg8::gemm_phase<pg8::EpiStore, pg8::StaticOrder, true, true>(glds, g, S, E, wave); }
            if (layer == 0) { OPQ; gates_minigemm(ws, lds, bx, G, otid, wave, olane); }
        }
        STEP_END;
        if (layer == 0) {
            if (EN(3) && STEP_ON) { SITE;
                OPQ;
#pragma unroll 1
                for (int u = bx; u < 512; u += G) dc_unit(args, ws, lds, u, otid, wave, olane);
            }
            STEP_END;
#ifdef SCAN_PROBE
            if (EN(4) && STEP_ON) { SITE; OPQ; for (int rep_ = 0; rep_ < SCAN_PROBE; ++rep_) scan_phase(ws, vcu * NTHREADS + otid, G * NTHREADS, (bf16*)(ws + WS_W + LAYER_W + WO_GU)); }
#endif
            if (EN(4) && STEP_ON) { SITE; OPQ; scan_phase(ws, vcu * NTHREADS + otid, G * NTHREADS); }
            STEP_END;
            if (EN(5) && STEP_ON) { SITE;
                OPQ;
#pragma unroll 1
                for (int u = bx; u < 1024; u += G) { if (mixout_chunk(u) & 1) mixout_unit<true>(args, ws, lds, u, otid, wave, olane); else mixout_unit<false>(args, ws, lds, u, otid, wave, olane); }
            }
            STEP_END;
        } else {
            if (EN(6) && STEP_ON) { SITE; OPQ; stickbreak_phase(args, ws, lds, bx, G, otid, wave, olane); }
            STEP_END;
        }
        if (EN(7) && STEP_ON) { SITE;
            pg8::Gemm g{(const pb*)HC, (const pb*)(wl + WO_OUT), SEQ, DM, DM, DM, DM}; pg8::StaticOrder S; S.init(g.M, g.N, G, bx);
            pg8::EpiStore E{(pb*)HB, DM, nullptr, -1};
            pg8::gemm_phase<pg8::EpiStore, pg8::StaticOrder, true, true>(glds, g, S, E, wave);
        }
        STEP_END;
#ifdef NORM_PROBE
        if (EN(8) && STEP_ON) { SITE; OPQ; for (int rep_ = 0; rep_ < NORM_PROBE; ++rep_) norm_rows<1>(nullptr, HB, args.in[2] + layer * DM, args.in[3] + layer * DM, args.in[14] + layer * DM, nullptr, XN, RS, lds, gw, NGW, otid, olane, HC, RS + 16384); }
#endif
        if (EN(8) && STEP_ON) { SITE; OPQ; norm_rows<1>(nullptr, HB, args.in[2] + layer * DM, args.in[3] + layer * DM, args.in[14] + layer * DM, nullptr, XN, RS, lds, gw, NGW, otid, olane); }
        STEP_END;
        if (EN(9) && STEP_ON) { SITE;
            { pg8::Gemm g{(const pb*)XN, (const pb*)(wl + WO_XQ), SEQ, XAW, DM, DM, DM}; pg8::StaticOrder S; S.init(g.M, g.N, G, bx);
              pg8::EpiStore E{(pb*)(ws + WS_XQ), XAW, nullptr, -1};
              pg8::gemm_phase<pg8::EpiStore, pg8::StaticOrder, true, true>(glds, g, S, E, wave); }
            { pg8::Gemm g{(const pb*)(ws + WS_MEMN) + (size_t)layer * NMEM * DM, (const pb*)(wl + WO_XK), NMEM, XAW, DM, DM, DM}; pg8::StaticOrder S; S.init(g.M, g.N, G, (bx + G - 128) % G);
              pg8::EpiStore E{(pb*)(ws + WS_KMEM), XAW, nullptr, -1};
              pg8::gemm_phase<pg8::EpiStore, pg8::StaticOrder, true, true>(glds, g, S, E, wave); }
            { pg8::Gemm g{(const pb*)(wl + WO_XV), (const pb*)(ws + WS_MEMN) + (size_t)layer * NMEM * DM, XAW, NMEM, DM, DM, DM}; pg8::StaticOrder S; S.init(g.M, g.N, G, (bx + G - 132) % G);
              pg8::EpiStore E{(pb*)(ws + WS_VTMEM), NMEM, nullptr, -1};
              pg8::gemm_phase<pg8::EpiStore, pg8::StaticOrder, true, true>(glds, g, S, E, wave); }
            if (G == 256 && bx >= XA_BUSY_WGS) { OPQ; convert_segments(args, ws, lds, SEG_DEFER, SEG_END, layer == 0 ? 0 : 1, layer == 0 ? 1 : 2, 2, (bx - XA_BUSY_WGS) * NWAVES + wave, (G - XA_BUSY_WGS) * NWAVES, wave, olane); }
        }
        STEP_END;
        if (EN(10) && STEP_ON) { SITE; OPQ; xattn_phase(ws, lds, bx, G, otid, wave, olane); }
        STEP_END;
        if (EN(11) && STEP_ON) { SITE;
            pg8::Gemm g{(const pb*)(ws + WS_XO), (const pb*)(wl + WO_XO), SEQ, DM, XAW, XAW, XAW}; pg8::StaticOrder S; S.init(g.M, g.N, G, bx);
            pg8::EpiStore E{(pb*)HB, DM, nullptr, -1};
            pg8::gemm_phase<pg8::EpiStore, pg8::StaticOrder, true, true>(glds, g, S, E, wave);
        }
        STEP_END;
        if (EN(12) && STEP_ON) { SITE; OPQ; norm_rows<1>(nullptr, HB, args.in[14] + layer * DM, args.in[15] + layer * DM, args.in[21] + layer * DM, nullptr, XN, RS, lds, gw, NGW, otid, olane); }
        STEP_END;
        if (EN(13) && STEP_ON) { SITE;
            pg8::Gemm g{(const pb*)XN, (const pb*)(wl + WO_GU), SEQ, 2 * FF, DM, DM, DM}; pg8::StaticOrder S; S.init(g.M, g.N, G, bx);
            pg8::EpiConvGelu E{(pb*)(ws + WS_H), FF, args.in[25] + (size_t)layer * 3 * FF, args.in[26] + (size_t)layer * FF, FF, (float*)(ws + WS_HALO), (PG8_LAS float*)(lds + 131072)};
            pg8::gemm_phase<pg8::EpiConvGelu, pg8::StaticOrder, true, true>(glds, g, S, E, wave);
        }
        STEP_END;
        if (EN(14) && STEP_ON) { SITE; OPQ; conv_fixup(args.in[25] + (size_t)layer * 3 * FF, args.in[26] + (size_t)layer * FF, ws, vcu * NTHREADS + otid, G * NTHREADS); }
        STEP_END;
        if (EN(15) && STEP_ON) { SITE;
            pg8::Gemm g{(const pb*)(ws + WS_H), (const pb*)(wl + WO_DOWN), SEQ, DM, FF, FF, FF}; pg8::StaticOrder S; S.init(g.M, g.N, G, bx);
            pg8::EpiStore E{(pb*)HB, DM, nullptr, -1};
            pg8::gemm_phase<pg8::EpiStore, pg8::StaticOrder, true, true>(glds, g, S, E, wave);
        }
        STEP_END;
        if (EN(16) && STEP_ON) { SITE;
            OPQ;
            if (layer == 0) norm_rows<1>(nullptr, HB, args.in[21], args.in[22], args.in[2] + DM, nullptr, XN, RS, lds, gw, NGW, otid, olane);
            else norm_rows<2>(nullptr, HB, args.in[21] + DM, args.in[22] + DM, nullptr, xres, XN, RS, lds, gw, NGW, otid, olane);
        }
        STEP_END;
}
__global__ void __launch_bounds__(NTHREADS, 2) mk_fwd(Args args) {
    extern __shared__ __attribute__((aligned(16))) unsigned char lds_raw[];
    LAS unsigned char* lds = (LAS unsigned char*)lds_raw;
    volatile LAS unsigned* MISC = (volatile LAS unsigned*)(lds + MISC_OFF);
    const int tid = threadIdx.x, wave = __builtin_amdgcn_readfirstlane(tid >> 6);
    const int G = gridDim.x, bx = blockIdx.x;
    const int vcu = (G % 8 == 0) ? (bx % 8) * (G / 8) + bx / 8 : bx;
    const int gw = vcu * NWAVES + wave, NGW = G * NWAVES;
    gu32* ctl = (gu32*)(args.ws + WS_CTL);
    for (int u = tid; u < (LDS_BYTES - LDSCTL_OFF) / 4; u += NTHREADS) ((LAS unsigned*)(lds + LDSCTL_OFF))[u] = 0u;
    __syncthreads();
    XcdBarrier bar; bar.bar = (unsigned*)(ctl + CW_BAR); bar.x = 0; bar.st = nullptr;
    if (MK_SINGLE) bar = xcd_barrier_post((unsigned*)(ctl + CW_BAR), MISC + 8);
    const int lo = args.ph_lo, hi = args.ph_hi;
    int step = 0;
    if (EN(0) && STEP_ON) { SITE;
        { OPQ; p0_prologue(args, ws, lds, gw, NGW, wave, olane, G == 256); }
        { OPQ; norm_rows<0>(args.in[0], nullptr, nullptr, nullptr, args.in[2], nullptr, XN, RS, lds, gw, NGW, otid, olane); }
    }
    STEP_END;

    layer_steps<0>(args, lds, bar, lo, hi, step, G, bx, vcu, gw, NGW, wave);
    layer_steps<1>(args, lds, bar, lo, hi, step, G, bx, vcu, gw, NGW, wave);
#undef STEP_ON
#undef STEP_END
}

extern "C" void kernel_launch(void* const* d_in, const int* in_sizes, int n_in, void* d_out, int out_size, void* d_ws, size_t ws_size, hipStream_t stream) {
    static int grid = 0;
    if (grid == 0) {
        if (n_in != 28 || out_size != SEQ * DM || ws_size < WS_END) { fprintf(stderr, "kernel_launch: built for 28 inputs, out %d floats, >= %zu bytes of workspace; got n_in %d, out %d, ws %zu; nothing launched\n", SEQ * DM, (size_t)WS_END, n_in, out_size, ws_size); grid = -1; return; }
        int dev = 0, cus = 0, per_cu = 0;
        if (hipGetDevice(&dev) != hipSuccess || hipDeviceGetAttribute(&cus, hipDeviceAttributeMultiprocessorCount, dev) != hipSuccess) { fprintf(stderr, "kernel_launch: device query failed\n"); grid = -1; return; }
        if (hipFuncSetAttribute((const void*)mk_fwd, hipFuncAttributeMaxDynamicSharedMemorySize, LDS_BYTES) != hipSuccess) { fprintf(stderr, "kernel_launch: hipFuncSetAttribute failed\n"); grid = -1; return; }
        if (hipOccupancyMaxActiveBlocksPerMultiprocessor(&per_cu, (const void*)mk_fwd, NTHREADS, LDS_BYTES) != hipSuccess || per_cu < 1)
            fprintf(stderr, "kernel_launch: note: occupancy query reports %d workgroups per CU\n", per_cu);
        (void)hipGetLastError();
        grid = cus;
    }
    if (grid < 0) return;
    if (hipMemsetAsync((char*)d_ws + WS_CTL, 0, CTL_ZERO_BYTES, stream) != hipSuccess) { fprintf(stderr, "kernel_launch: hipMemsetAsync failed\n"); return; }
    Args a{};
    for (int i = 0; i < 28; ++i) a.in[i] = (const float*)d_in[i];
    a.out = (float*)d_out; a.ws = (unsigned char*)d_ws;
#if MK_SINGLE
    a.ph_lo = 0; a.ph_hi = N_STEPS;
    hipLaunchKernelGGL(mk_fwd, dim3(grid), dim3(NTHREADS), LDS_BYTES, stream, a);
#else
#ifndef DUP_STEPS
#define DUP_STEPS 0u
#endif
#ifndef DUP_N
#define DUP_N 2
#endif
    for (int s = 0; s < N_STEPS; ++s) { a.ph_lo = s; a.ph_hi = s + 1;
        for (int rep = 0; rep < (((DUP_STEPS >> s) & 1u) ? DUP_N : 1); ++rep) hipLaunchKernelGGL(mk_fwd, dim3(grid), dim3(NTHREADS), LDS_BYTES, stream, a); }
#endif
    const hipError_t le = hipPeekAtLastError();
    if (le != hipSuccess) fprintf(stderr, "kernel_launch: launch failed: %s\n", hipGetErrorName(le));
}
```
